# Optimizing an MI355X kernel written in HIP

```python
import jax, jax.numpy as jnp
from jax import lax
import numpy as np

D_MODEL = 1024
BATCH = 8
SEQ = 2048
DEPTH = 1

RET_HEADS = 4
RET_HEAD_DIM = 128
RET_WIDTH = RET_HEADS * RET_HEAD_DIM
RET_CHUNK = 128
ROPE_BASE = 10000.0
SGU_GROUPS = 4
SGU_GROUP_DIM = 128
SGU_WIDTH = SGU_GROUPS * SGU_GROUP_DIM
SGU_CHUNK = 128
MIX_WIDTH = RET_WIDTH + SGU_WIDTH
PROJ_WIDTH = 4 * RET_WIDTH + 2 * SGU_WIDTH
D_FF = 2816
CONV_WIDTH = 3
EPS = 1e-6

kernel_name = "hymba_style_retention_sgu_convffn"


def rmsnorm(x, g):
    xf = x.astype(jnp.float32)
    y = xf * lax.rsqrt(jnp.mean(xf * xf, axis=-1, keepdims=True) + EPS)
    return (y * g.astype(jnp.float32)).astype(x.dtype)


def layernorm(x, g, b):
    xf = x.astype(jnp.float32)
    mu = jnp.mean(xf, axis=-1, keepdims=True)
    xc = xf - mu
    y = xc * lax.rsqrt(jnp.mean(xc * xc, axis=-1, keepdims=True) + EPS)
    return (y * g.astype(jnp.float32) + b.astype(jnp.float32)).astype(x.dtype)


def rotary(x, cos, sin):
    half = x.shape[-1] // 2
    x1, x2 = x[..., :half], x[..., half:]
    c = cos[None, :, None, :]
    s = sin[None, :, None, :]
    return jnp.concatenate([x1 * c - x2 * s, x2 * c + x1 * s], axis=-1)


def retention_chunkwise(q, k, v):
    B, S, H, D = q.shape
    C = RET_CHUNK
    N = S // C
    dt = q.dtype
    log_gamma = jnp.log(1.0 - jnp.power(2.0, -5.0 - jnp.arange(H, dtype=jnp.float32)))
    pos = jnp.arange(C, dtype=jnp.float32)
    diff = pos[:, None] - pos[None, :]
    decay_mask = jnp.where(diff >= 0.0,
                           jnp.exp(log_gamma[:, None, None] * jnp.maximum(diff, 0.0)[None]),
                           0.0).astype(dt)
    k_decay = jnp.exp(log_gamma[:, None] * (C - 1.0 - pos)[None]).astype(dt)
    q_decay = jnp.exp(log_gamma[:, None] * (pos + 1.0)[None]).astype(dt)
    chunk_decay = jnp.exp(log_gamma * C).astype(dt)

    def to_chunks(t):
        return t.reshape(B, N, C, H, D).transpose(0, 3, 1, 2, 4)

    qc, kc, vc = to_chunks(q), to_chunks(k), to_chunks(v)
    scores = jnp.einsum('bhnqd,bhnkd->bhnqk', qc, kc) * decay_mask[None, :, None]
    intra = jnp.einsum('bhnqk,bhnkd->bhnqd', scores, vc)
    kv = jnp.einsum('bhnkd,bhnke->bhnde', kc * k_decay[None, :, None, :, None], vc)

    def step(state, kv_n):
        return state * chunk_decay[None, :, None, None] + kv_n, state

    init = jnp.zeros((B, H, D, D), dtype=kv.dtype)
    _, s_prev = lax.scan(step, init, jnp.moveaxis(kv, 2, 0))
    s_prev = jnp.moveaxis(s_prev, 0, 2)
    cross = jnp.einsum('bhnqd,bhnde->bhnqe', qc * q_decay[None, :, None, :, None], s_prev)
    out = intra + cross
    return out.transpose(0, 2, 3, 1, 4).reshape(B, S, H, D)


def spatial_gating_chunked(u, v, ln_g, ln_b, w_s, b_s):
    B, S, _ = u.shape
    C = SGU_CHUNK
    N = S // C
    G, dg = SGU_GROUPS, SGU_GROUP_DIM
    vn = layernorm(v.reshape(B, N, C, G, dg), ln_g, ln_b)
    causal = jnp.tril(jnp.ones((C, C), dtype=w_s.dtype))
    w = w_s * causal[None]
    mixed = jnp.einsum('gts,bnsgd->bntgd', w, vn) + b_s.T[None, None, :, :, None]
    return u * mixed.reshape(B, S, G * dg)


def causal_depthwise_conv(h, w, b):
    S = h.shape[1]
    hp = jnp.pad(h, ((0, 0), (CONV_WIDTH - 1, 0), (0, 0)))
    y = hp[:, 0:S] * w[0]
    for j in range(1, CONV_WIDTH):
        y = y + hp[:, j:j + S] * w[j]
    return y + b


def setup_inputs(seed: int = 0) -> dict:
    key = jax.random.key(seed)
    ks = jax.random.split(key, 16)
    f32 = jnp.float32
    nrm = lambda k, shape, scale: jax.random.normal(k, shape, f32) * scale
    return {
        "x": nrm(ks[0], (BATCH, SEQ, D_MODEL), 1.0),
        "mix_norm_g": 1.0 + nrm(ks[1], (DEPTH, D_MODEL), 0.01),
        "w_in": nrm(ks[2], (DEPTH, D_MODEL, PROJ_WIDTH), D_MODEL ** -0.5),
        "ret_norm_g": 1.0 + nrm(ks[3], (DEPTH, RET_WIDTH), 0.01),
        "sgu_ln_g": 1.0 + nrm(ks[4], (DEPTH, SGU_GROUPS, SGU_GROUP_DIM), 0.01),
        "sgu_ln_b": nrm(ks[5], (DEPTH, SGU_GROUPS, SGU_GROUP_DIM), 0.01),
        "sgu_w_s": nrm(ks[6], (DEPTH, SGU_GROUPS, SGU_CHUNK, SGU_CHUNK), SGU_CHUNK ** -0.5),
        "sgu_b_s": 1.0 + nrm(ks[7], (DEPTH, SGU_GROUPS, SGU_CHUNK), 0.01),
        "w_out": nrm(ks[8], (DEPTH, MIX_WIDTH, D_MODEL), MIX_WIDTH ** -0.5),
        "ffn_norm_g": 1.0 + nrm(ks[9], (DEPTH, D_MODEL), 0.01),
        "w_up": nrm(ks[10], (DEPTH, D_MODEL, 2 * D_FF), D_MODEL ** -0.5),
        "conv_w": nrm(ks[11], (DEPTH, CONV_WIDTH, 2 * D_FF), CONV_WIDTH ** -0.5),
        "conv_b": nrm(ks[12], (DEPTH, 2 * D_FF), 0.01),
        "w_down": nrm(ks[13], (DEPTH, D_FF, D_MODEL), D_FF ** -0.5),
        "final_norm_g": 1.0 + nrm(ks[14], (D_MODEL,), 0.01),
    }


def reference(x, mix_norm_g, w_in, ret_norm_g, sgu_ln_g, sgu_ln_b, sgu_w_s, sgu_b_s,
              w_out, ffn_norm_g, w_up, conv_w, conv_b, w_down, final_norm_g):
    B, S, _ = x.shape
    half = RET_HEAD_DIM // 2
    inv_freq = jnp.power(ROPE_BASE, -jnp.arange(half, dtype=jnp.float32) / half)
    ang = jnp.arange(S, dtype=jnp.float32)[:, None] * inv_freq[None, :]
    cos, sin = jnp.cos(ang).astype(x.dtype), jnp.sin(ang).astype(x.dtype)
    splits = [RET_WIDTH, 2 * RET_WIDTH, 3 * RET_WIDTH, 4 * RET_WIDTH, 4 * RET_WIDTH + SGU_WIDTH]

    for l in range(DEPTH):
        h = rmsnorm(x, mix_norm_g[l])
        proj = h @ w_in[l]
        q, k, v, g, u, sv = jnp.split(proj, splits, axis=-1)
        q = rotary(q.reshape(B, S, RET_HEADS, RET_HEAD_DIM), cos, sin)
        k = rotary(k.reshape(B, S, RET_HEADS, RET_HEAD_DIM), cos, sin) * (RET_HEAD_DIM ** -0.5)
        v = v.reshape(B, S, RET_HEADS, RET_HEAD_DIM)
        ret = retention_chunkwise(q, k, v)
        ret = rmsnorm(ret, ret_norm_g[l].reshape(RET_HEADS, RET_HEAD_DIM)).reshape(B, S, RET_WIDTH)
        ret = jax.nn.silu(g) * ret
        sgu = spatial_gating_chunked(jax.nn.gelu(u, approximate=False),
                                     jax.nn.gelu(sv, approximate=False),
                                     sgu_ln_g[l], sgu_ln_b[l], sgu_w_s[l], sgu_b_s[l])
        mixed = jnp.concatenate([ret, sgu], axis=-1) @ w_out[l]
        x = x + mixed
        h = rmsnorm(x, ffn_norm_g[l])
        up = causal_depthwise_conv(h @ w_up[l], conv_w[l], conv_b[l])
        a, bgate = jnp.split(up, [D_FF], axis=-1)
        x = x + (jax.nn.silu(a) * bgate) @ w_down[l]

    return rmsnorm(x, final_norm_g)
```

```cpp
#include <hip/hip_runtime.h>
#include <hip/hip_cooperative_groups.h>
#include <cstdio>
#include <cstdint>
namespace cg = cooperative_groups;

namespace pg8 {
#define PG8_LAS __attribute__((address_space(3)))
typedef unsigned short bf16_t;
typedef short bf16x8 __attribute__((ext_vector_type(8)));
typedef float f32x4 __attribute__((ext_vector_type(4)));
typedef float f32x2 __attribute__((ext_vector_type(2)));
typedef unsigned u32x4 __attribute__((ext_vector_type(4)));
typedef unsigned u32x2 __attribute__((ext_vector_type(2)));
constexpr int BM = 256, BK = 64, HALF = 128, HTB = HALF * BK * 2  , STAGE_BYTES = 8 * HTB, NXCD = 8, WGM = 8;

__host__ __device__ __forceinline__ int lds_byte(int r, int c) { const int st = (r >> 4) * 2 + (c >> 5), rr = r & 15, cc = c & 31, ob = rr * 64 + cc * 2; return st * 1024 + (ob ^ (((ob >> 9) & 1) << 5)); }
__host__ __device__ __forceinline__ void stage_rc(int b, int& R, int& C) { const int st = b / 1024, sb = b % 1024, swz = sb ^ (((sb >> 9) & 1) << 5); R = (st >> 1) * 16 + swz / 64; C = (st & 1) * 32 + (swz % 64) / 2; }
__host__ __device__ __forceinline__ int perm32(int rho) { const int n = rho >> 4, i = rho & 15; return 8 * (i >> 2) + 4 * n + (i & 3); }
__host__ __device__ __forceinline__ int tokrow(int R) { return 128 * (R >> 6) + 8 * (R & 15) + ((R >> 4) & 3); }

struct Unit { int pm, pn; };
struct Gemm { const bf16_t* A; const bf16_t* Bt; int M, N, K; };

struct StaticOrder {
    int nM, nN, nwg, G, c;
    __host__ __device__ void init(int M, int N, int G_, int c_) { nM = M / BM; nN = N / BM; nwg = nM * nN; G = G_; c = c_; }
    __host__ __device__ bool next(int i, Unit& u) const {
        const long L = (long)i * G + c; if (L >= nwg) return false;
        int wgid = (int)L; { const int q = nwg / NXCD, r = nwg % NXCD, xcd = wgid % NXCD, off = wgid / NXCD; wgid = (xcd < r ? xcd * (q + 1) : r * (q + 1) + (xcd - r) * q) + off; }
        const int nig = WGM * nN, gid = wgid / nig, fm = gid * WGM, gsz = (nM - fm) < WGM ? (nM - fm) : WGM;
        u.pm = fm + ((wgid % nig) % gsz); u.pn = (wgid % nig) / gsz; return true;
    }
    __device__ __forceinline__ void a_ready(const Unit&) const {}
    __device__ __forceinline__ void done(const Unit&) const {}
};

__device__ __forceinline__ unsigned cvt_pk_bf16(float lo, float hi) { unsigned r; asm volatile("v_cvt_pk_bf16_f32 %0, %1, %2" : "=v"(r) : "v"(lo), "v"(hi)); return r; }
__device__ __forceinline__ f32x2 gelu_pk(f32x2 v) {
    const f32x2 av = __builtin_elementwise_abs(v), d = av * 0.2316418882f + 1.0f;
    f32x2 t; t.x = __builtin_amdgcn_rcpf(d.x); t.y = __builtin_amdgcn_rcpf(d.y);
    f32x2 q = t * 0.5307027145f + (-0.7265760135f); q = q * t + 0.7107068705f; q = q * t + (-0.142248368f); q = q * t + 0.127414796f; q = q * t;
    const f32x2 s = (v * v) * (-0.72134752044f);
    f32x2 e; e.x = __builtin_amdgcn_exp2f(s.x); e.y = __builtin_amdgcn_exp2f(s.y);
    const f32x2 m = v * (q * e), r = v - m;
    f32x2 o; o.x = v.x < 0.f ? m.x : r.x; o.y = v.y < 0.f ? m.y : r.y; return o;
}
__device__ __forceinline__ float silu_f(float v) { return v * __builtin_amdgcn_rcpf(1.f + __builtin_amdgcn_exp2f(-1.4426950408889634f * v)); }
__device__ __forceinline__ f32x4 silu4(f32x4 v) { return (f32x4){silu_f(v[0]), silu_f(v[1]), silu_f(v[2]), silu_f(v[3])}; }
__device__ __forceinline__ f32x4 gelu4(f32x4 v) { const f32x2 a = gelu_pk((f32x2){v[0], v[1]}), b = gelu_pk((f32x2){v[2], v[3]}); return (f32x4){a.x, a.y, b.x, b.y}; }
__device__ __forceinline__ u32x2 pack4(f32x4 v) { u32x2 w; w.x = cvt_pk_bf16(v[0], v[1]); w.y = cvt_pk_bf16(v[2], v[3]); return w; }

constexpr int PROJ_W = 3072, DM = 1024, DFF = 2816, UPW = 5632, SEQ = 2048;
constexpr float EPS = 1e-6f;

struct EpiProj {
    static constexpr bool PERM = true, AFTER_DRAIN = false, AROWPERM = false;
    bf16_t* O; const float* rope;
    __device__ __forceinline__ void operator()(const f32x4 (&acc)[2][2][4][2], const Unit& u, int wr, int wc, int fr, int fq) const {
        const int row0 = u.pm * BM + wr * 64 + fr; const int type = u.pn >> 1;
        if (type < 2) {
            const float sc = (type == 1) ? 0.08838834764831845f : 1.0f; const int pp = 16 * wc + 4 * fq;
#pragma unroll
            for (int ai = 0; ai < 2; ++ai)
#pragma unroll
                for (int m = 0; m < 4; ++m) { const int row = row0 + ai * HALF + m * 16; const int pos = row & (SEQ - 1);
                    const f32x4 c = *(const f32x4*)(rope + pos * 128 + pp), s = *(const f32x4*)(rope + pos * 128 + 64 + pp);
#pragma unroll
                    for (int bj = 0; bj < 2; ++bj) { const f32x4 x1 = acc[ai][bj][m][0], x2 = acc[ai][bj][m][1];
                        const f32x4 o1 = (x1 * c - x2 * s) * sc, o2 = (x2 * c + x1 * s) * sc;
                        bf16_t* p = O + (size_t)row * PROJ_W + u.pn * BM + bj * HALF + pp;
                        *(u32x2*)p = pack4(o1); *(u32x2*)(p + 64) = pack4(o2); } }
        } else {
            const int col0 = u.pn * BM + wc * 32 + 8 * fq;
#pragma unroll
            for (int ai = 0; ai < 2; ++ai)
#pragma unroll
                for (int m = 0; m < 4; ++m) { bf16_t* rowp = O + (size_t)(row0 + ai * HALF + m * 16) * PROJ_W + col0;
#pragma unroll
                    for (int bj = 0; bj < 2; ++bj) { f32x4 v0 = acc[ai][bj][m][0], v1 = acc[ai][bj][m][1];
                        if (type == 3) { v0 = silu4(v0); v1 = silu4(v1); } else if (type >= 4) { v0 = gelu4(v0); v1 = gelu4(v1); }
                        const u32x2 a = pack4(v0), b = pack4(v1); u32x4 w; w.x = a.x; w.y = a.y; w.z = b.x; w.w = b.y;
                        *(u32x4*)(rowp + bj * HALF) = w; } }
        }
    }
};

template <bool WRITE_XG> struct EpiRes {
    static constexpr bool PERM = false, AFTER_DRAIN = false, AROWPERM = false;
    const float* base; float* out; bf16_t* xg; const float* gain; float* ssq;
    __device__ __forceinline__ void operator()(const f32x4 (&acc)[2][2][4][2], const Unit& u, int wr, int wc, int fr, int fq) const {
        const int col0 = u.pn * BM + wc * 32 + 4 * fq;
        f32x4 gv[2][2];
#pragma unroll
        for (int bj = 0; bj < 2; ++bj)
#pragma unroll
            for (int n = 0; n < 2; ++n) gv[bj][n] = WRITE_XG ? *(const f32x4*)(gain + col0 + bj * HALF + n * 16) : (f32x4){0.f, 0.f, 0.f, 0.f};
#pragma unroll
        for (int ai = 0; ai < 2; ++ai)
#pragma unroll
            for (int m = 0; m < 4; ++m) { const int row = u.pm * BM + ai * HALF + wr * 64 + m * 16 + fr; const size_t off = (size_t)row * DM + col0; float s = 0.f;
#pragma unroll
                for (int bj = 0; bj < 2; ++bj)
#pragma unroll
                    for (int n = 0; n < 2; ++n) { const f32x4 x1 = *(const f32x4*)(base + off + bj * HALF + n * 16) + acc[ai][bj][m][n];
                        *(f32x4*)(out + off + bj * HALF + n * 16) = x1; s += (x1[0] * x1[0] + x1[1] * x1[1]) + (x1[2] * x1[2] + x1[3] * x1[3]);
                        if (WRITE_XG) *(u32x2*)(xg + off + bj * HALF + n * 16) = pack4(x1 * gv[bj][n]); }
                s += __shfl_xor(s, 16); s += __shfl_xor(s, 32);
                if (fq == 0) (void)__hip_atomic_fetch_add(ssq + row, s, __ATOMIC_RELAXED, __HIP_MEMORY_SCOPE_AGENT);
                if (m & 1) asm volatile("" ::: "memory"); }
    }
};

__device__ __forceinline__ float dpp_shr1(float v) { return __int_as_float(__builtin_amdgcn_update_dpp(0, __float_as_int(v), 0x111, 0xf, 0xf, true)); }
__device__ __forceinline__ f32x4 dpp_shr1_4(f32x4 v) { return (f32x4){dpp_shr1(v[0]), dpp_shr1(v[1]), dpp_shr1(v[2]), dpp_shr1(v[3])}; }
struct EpiConv {
    static constexpr bool PERM = true, AFTER_DRAIN = false, AROWPERM = true;
    const float* ssq; const float* cw; const float* cb; bf16_t* act; float* edge;
    __device__ __forceinline__ void operator()(const f32x4 (&acc)[2][2][4][2], const Unit& u, int wr, int wc, int fr, int fq) const {
        const int run = u.pm * 2 + wr; const int tok0 = u.pm * BM + wr * HALF + 8 * fr;
        float rstd[8];
        { const f32x4 s0 = *(const f32x4*)(ssq + tok0), s1 = *(const f32x4*)(ssq + tok0 + 4);
#pragma unroll
          for (int i = 0; i < 4; ++i) { rstd[i] = __builtin_amdgcn_rsqf(s0[i] * (1.0f / DM) + EPS); rstd[4 + i] = __builtin_amdgcn_rsqf(s1[i] * (1.0f / DM) + EPS); } }
        u32x2 pk0[8];
#pragma unroll
        for (int n = 0; n < 2; ++n) {
            const int ca = u.pn * HALF + wc * 32 + 8 * fq + 4 * n;
            const f32x4 w0a = *(const f32x4*)(cw + ca), w1a = *(const f32x4*)(cw + UPW + ca), w2a = *(const f32x4*)(cw + 2 * UPW + ca), ba = *(const f32x4*)(cb + ca);
            const f32x4 w0b = *(const f32x4*)(cw + DFF + ca), w1b = *(const f32x4*)(cw + UPW + DFF + ca), w2b = *(const f32x4*)(cw + 2 * UPW + DFF + ca), bb = *(const f32x4*)(cb + DFF + ca);
            f32x4 ua[8], ub[8];
#pragma unroll
            for (int t = 0; t < 8; ++t) { ua[t] = acc[t >> 2][0][t & 3][n] * rstd[t]; ub[t] = acc[t >> 2][1][t & 3][n] * rstd[t]; }
            const f32x4 pa1 = dpp_shr1_4(ua[7]), pa2 = dpp_shr1_4(ua[6]), pb1 = dpp_shr1_4(ub[7]), pb2 = dpp_shr1_4(ub[6]);
            if (fr == 0) { float* e = edge + (size_t)run * 4 * UPW; *(f32x4*)(e + ca) = ua[0]; *(f32x4*)(e + UPW + ca) = ua[1]; *(f32x4*)(e + DFF + ca) = ub[0]; *(f32x4*)(e + UPW + DFF + ca) = ub[1]; }
            if (fr == 15) { float* e = edge + (size_t)run * 4 * UPW + 2 * UPW; *(f32x4*)(e + ca) = ua[6]; *(f32x4*)(e + UPW + ca) = ua[7]; *(f32x4*)(e + DFF + ca) = ub[6]; *(f32x4*)(e + UPW + DFF + ca) = ub[7]; }
#pragma unroll
            for (int t = 0; t < 8; ++t) {
                const f32x4 am1 = (t >= 1) ? ua[t >= 1 ? t - 1 : 0] : pa1, am2 = (t >= 2) ? ua[t >= 2 ? t - 2 : 0] : (t == 1 ? pa1 : pa2);
                const f32x4 bm1 = (t >= 1) ? ub[t >= 1 ? t - 1 : 0] : pb1, bm2 = (t >= 2) ? ub[t >= 2 ? t - 2 : 0] : (t == 1 ? pb1 : pb2);
                const f32x4 ya = w2a * ua[t] + w1a * am1 + w0a * am2 + ba, yb = w2b * ub[t] + w1b * bm1 + w0b * bm2 + bb;
                const u32x2 pk = pack4(silu4(ya) * yb);
                if (n == 0) pk0[t] = pk;
                else if (!(fr == 0 && t < 2)) { u32x4 w; w.x = pk0[t].x; w.y = pk0[t].y; w.z = pk.x; w.w = pk.y;
                    *(u32x4*)(act + (size_t)(tok0 + t) * DFF + u.pn * HALF + wc * 32 + 8 * fq) = w; }
            }
        }
    }
};
template <class Epi, class Sched, bool ALIGN_EPI = false, bool SP2 = false>
__device__ __forceinline__ void gemm_phase(PG8_LAS unsigned char* lds, const Gemm g, const Sched& S, const Epi& E) {
    const int tid = threadIdx.x, wid = __builtin_amdgcn_readfirstlane(tid >> 6), lane = tid & 63, wr = wid >> 2, wc = wid & 3, fr = lane & 15, fq = lane >> 4;
    const int K = g.K, nt = K / BK;
    unsigned voffA[2], voffB[2];
#pragma unroll
    for (int i = 0; i < 2; ++i) { int R, C; stage_rc(tid * 16 + i * 8192, R, C); const int Rb = Epi::PERM ? ((R & ~31) + perm32(R & 31)) : R;
        voffA[i] = (unsigned)((Epi::AROWPERM ? tokrow(R) : R) * K + C) * 2u; voffB[i] = (unsigned)(Rb * K + C) * 2u; }
    const size_t kstep = (size_t)(BK * 2);
    const size_t hstepB = (size_t)HALF * K * 2; const size_t hstepA = Epi::AROWPERM ? (size_t)4 * K * 2 : hstepB;
    const size_t tstep = 2 * hstepB;
    const unsigned ldsw = (unsigned)wid * 1024u;
    const int aoff = lds_byte(wr * 64 + fr, fq * 8), boff = lds_byte(wc * 32 + fr, fq * 8);
#define PG8_SA(b, h) (((b) * 2 + (h)) * HTB)
#define PG8_SB(b, h) ((4 + (b) * 2 + (h)) * HTB)
#define PG8_STAGE(bufoff, gbase, voff) do { _Pragma("unroll") for (int _i = 0; _i < 2; ++_i) \
        __builtin_amdgcn_global_load_lds((const unsigned*)((const char*)(gbase) + (voff)[_i]), (PG8_LAS unsigned*)(lds + (bufoff) + ldsw + _i * 8192), 16, 0, 0); } while (0)
#define PG8_LDA(dst, b, h) do { _Pragma("unroll") for (int m = 0; m < 4; ++m) _Pragma("unroll") for (int k = 0; k < 2; ++k) dst[m][k] = *(const PG8_LAS bf16x8*)(lds + PG8_SA(b, h) + aoff + m * 2048 + k * 1024); } while (0)
#define PG8_LDB(dst, b, h) do { _Pragma("unroll") for (int n = 0; n < 2; ++n) _Pragma("unroll") for (int k = 0; k < 2; ++k) dst[n][k] = *(const PG8_LAS bf16x8*)(lds + PG8_SB(b, h) + boff + n * 2048 + k * 1024); } while (0)
#define PG8_MMA(ai, bj, At, Bt) do { __builtin_amdgcn_s_setprio(1); _Pragma("unroll") for (int m = 0; m < 4; ++m) _Pragma("unroll") for (int n = 0; n < 2; ++n) _Pragma("unroll") for (int k = 0; k < 2; ++k) \
        acc[ai][bj][m][n] = __builtin_amdgcn_mfma_f32_16x16x32_bf16(Bt[n][k], At[m][k], acc[ai][bj][m][n], 0, 0, 0); __builtin_amdgcn_s_setprio(0); } while (0)
#define PG8_WAIT_V(n) asm volatile("s_waitcnt vmcnt(" #n ")" ::: "memory")
#define PG8_WAIT_L(n) asm volatile("s_waitcnt lgkmcnt(" #n ")" ::: "memory")
#define PG8_BAR __builtin_amdgcn_s_barrier()
#define PG8_SCHED __builtin_amdgcn_sched_barrier(0)
    Unit cur, nxt; int ui = 0;
    if (!S.next(0, cur)) return;
    f32x4 acc[2][2][4][2];
#pragma unroll
    for (int a = 0; a < 2; ++a)
#pragma unroll
        for (int b = 0; b < 2; ++b)
#pragma unroll
            for (int m = 0; m < 4; ++m)
#pragma unroll
                for (int n = 0; n < 2; ++n) acc[a][b][m][n] = (f32x4){0.f, 0.f, 0.f, 0.f};
    bf16x8 At[4][2], B0[2][2], B1[2][2];
    const char* cA = (const char*)g.A + (size_t)cur.pm * tstep; const char* cB = (const char*)g.Bt + (size_t)cur.pn * tstep;
    S.a_ready(cur);
    if constexpr (SP2) {
        PG8_STAGE(PG8_SB(0, 0), cB, voffB); PG8_STAGE(PG8_SB(0, 1), cB + hstepB, voffB); PG8_STAGE(PG8_SA(0, 0), cA, voffA); PG8_STAGE(PG8_SA(0, 1), cA + hstepA, voffA);
        if (wr == 1) PG8_BAR;
        PG8_WAIT_V(2); PG8_BAR;
        PG8_STAGE(PG8_SB(1, 0), cB + kstep, voffB); PG8_STAGE(PG8_SA(1, 0), cA + kstep, voffA); PG8_STAGE(PG8_SB(1, 1), cB + hstepB + kstep, voffB);
        PG8_WAIT_V(6); PG8_BAR;
    } else {
        PG8_STAGE(PG8_SB(0, 0), cB, voffB); PG8_STAGE(PG8_SA(0, 0), cA, voffA); PG8_STAGE(PG8_SB(0, 1), cB + hstepB, voffB); PG8_STAGE(PG8_SA(0, 1), cA + hstepA, voffA);
        if (wr == 1) PG8_BAR;
        PG8_WAIT_V(4); PG8_BAR;
        PG8_STAGE(PG8_SB(1, 0), cB + kstep, voffB); PG8_STAGE(PG8_SA(1, 0), cA + kstep, voffA); PG8_STAGE(PG8_SB(1, 1), cB + hstepB + kstep, voffB);
        PG8_WAIT_V(6); PG8_BAR;
    }
    for (;;) {
        const bool has_next = S.next(ui + 1, nxt);
        const char* nA = has_next ? (const char*)g.A + (size_t)nxt.pm * tstep : cA; const char* nB = has_next ? (const char*)g.Bt + (size_t)nxt.pn * tstep : cB;
        for (int t = 0; t < nt; t += 2) {
            const bool last = (t == nt - 2);
            const char* a1 = cA + (size_t)(t + 1) * kstep;
            const char* a2 = last ? nA : cA + (size_t)(t + 2) * kstep; const char* b2 = last ? nB : cB + (size_t)(t + 2) * kstep;
            const char* a3 = a2 + kstep; const char* b3 = b2 + kstep;
            if (last && has_next) S.a_ready(nxt);
            if constexpr (SP2) {
            PG8_LDB(B0, 0, 0); PG8_LDB(B1, 0, 1); PG8_SCHED; PG8_LDA(At, 0, 0); PG8_STAGE(PG8_SA(1, 1), a1 + hstepA, voffA);
            PG8_WAIT_V(8); PG8_WAIT_L(0); PG8_BAR; PG8_MMA(0, 0, At, B0); PG8_MMA(0, 1, At, B1); PG8_BAR; PG8_SCHED;
            PG8_LDA(At, 0, 1); PG8_STAGE(PG8_SB(0, 0), b2, voffB); PG8_STAGE(PG8_SB(0, 1), b2 + hstepB, voffB); PG8_STAGE(PG8_SA(0, 0), a2, voffA);
            PG8_WAIT_V(8); PG8_WAIT_L(0); PG8_BAR; PG8_MMA(1, 0, At, B0); PG8_MMA(1, 1, At, B1); PG8_BAR; PG8_SCHED;
            PG8_LDB(B0, 1, 0); PG8_LDB(B1, 1, 1); PG8_SCHED; PG8_LDA(At, 1, 0); PG8_STAGE(PG8_SA(0, 1), a2 + hstepA, voffA);
            PG8_WAIT_V(8); PG8_WAIT_L(0); PG8_BAR; PG8_MMA(0, 0, At, B0); PG8_MMA(0, 1, At, B1); PG8_BAR; PG8_SCHED;
            PG8_LDA(At, 1, 1); PG8_STAGE(PG8_SB(1, 0), b3, voffB); PG8_STAGE(PG8_SB(1, 1), b3 + hstepB, voffB); PG8_STAGE(PG8_SA(1, 0), a3, voffA);
            PG8_WAIT_V(8); PG8_WAIT_L(0); PG8_BAR; PG8_MMA(1, 0, At, B0); PG8_MMA(1, 1, At, B1); PG8_BAR; PG8_SCHED;
            } else {
            PG8_LDB(B0, 0, 0); PG8_SCHED; PG8_LDA(At, 0, 0); PG8_STAGE(PG8_SA(1, 1), a1 + hstepA, voffA);
            PG8_WAIT_L(8); PG8_BAR; PG8_WAIT_L(0); PG8_MMA(0, 0, At, B0); PG8_BAR; PG8_SCHED;
            PG8_LDB(B1, 0, 1); PG8_STAGE(PG8_SB(0, 0), b2, voffB);
            PG8_BAR; PG8_WAIT_L(0); PG8_MMA(0, 1, At, B1); PG8_BAR;
            PG8_LDA(At, 0, 1); PG8_STAGE(PG8_SA(0, 0), a2, voffA);
            PG8_BAR; PG8_WAIT_L(0); PG8_MMA(1, 0, At, B0); PG8_BAR; PG8_SCHED;
            PG8_STAGE(PG8_SB(0, 1), b2 + hstepB, voffB);
            PG8_WAIT_V(6); PG8_BAR; PG8_MMA(1, 1, At, B1); PG8_BAR;
            PG8_LDB(B0, 1, 0); PG8_SCHED; PG8_LDA(At, 1, 0); PG8_STAGE(PG8_SA(0, 1), a2 + hstepA, voffA);
            PG8_WAIT_L(8); PG8_BAR; PG8_WAIT_L(0); PG8_MMA(0, 0, At, B0); PG8_BAR; PG8_SCHED;
            PG8_LDB(B1, 1, 1); PG8_STAGE(PG8_SB(1, 0), b3, voffB);
            PG8_BAR; PG8_WAIT_L(0); PG8_MMA(0, 1, At, B1); PG8_BAR;
            PG8_LDA(At, 1, 1); PG8_STAGE(PG8_SA(1, 0), a3, voffA);
            PG8_BAR; PG8_WAIT_L(0); PG8_MMA(1, 0, At, B0); PG8_BAR; PG8_SCHED;
            PG8_STAGE(PG8_SB(1, 1), b3 + hstepB, voffB);
            PG8_WAIT_V(6); PG8_BAR; PG8_MMA(1, 1, At, B1); PG8_BAR;
            }
        }
        if constexpr (ALIGN_EPI) { if (wr == 0) PG8_BAR; }
        if constexpr (!Epi::AFTER_DRAIN) { E(acc, cur, wr, wc, fr, fq); S.done(cur); }
        if (!has_next) break;
#pragma unroll
        for (int a = 0; a < 2; ++a)
#pragma unroll
            for (int b = 0; b < 2; ++b)
#pragma unroll
                for (int m = 0; m < 4; ++m)
#pragma unroll
                    for (int n = 0; n < 2; ++n) acc[a][b][m][n] = (f32x4){0.f, 0.f, 0.f, 0.f};
        cur = nxt; cA = nA; cB = nB; ++ui;
        if constexpr (ALIGN_EPI) { if (wr == 1) PG8_BAR; }
    }
    PG8_WAIT_V(0);
    if constexpr (!ALIGN_EPI) { if (wr == 0) PG8_BAR; }
    PG8_BAR;
    if constexpr (Epi::AFTER_DRAIN) { E.fused(acc, cur, wr, wc, fr, fq, lds, wid, lane); S.done(cur); }
#undef PG8_SA
#undef PG8_SB
#undef PG8_STAGE
#undef PG8_LDA
#undef PG8_LDB
#undef PG8_MMA
#undef PG8_WAIT_V
#undef PG8_WAIT_L
#undef PG8_BAR
#undef PG8_SCHED
}
}

constexpr int NWAVES = 8, NTHREADS = 512;
constexpr int BATCH = 8, SEQ = 2048, DM = 1024, M = BATCH * SEQ, PROJ_W = 3072, DFF = 2816, UPW = 5632, NCHUNK = 16;
constexpr float EPS = 1e-6f;
constexpr size_t MiB = 1u << 20;
constexpr size_t WS_SSQ1 = 0, WS_SSQ2 = 65536, WS_ROPE = 1 * MiB, WS_SGUW = 2 * MiB, WS_WIN = 3 * MiB, WS_WOUT = 9 * MiB, WS_WUP = 11 * MiB, WS_WDOWN = 22 * MiB,
                 WS_EDGE = 28 * MiB, WS_XN = 40 * MiB, WS_PROJ = 72 * MiB, WS_MIX = 168 * MiB, WS_KV = 200 * MiB, WS_ACT = 72 * MiB, WS_END = 216 * MiB;
constexpr int LDS_BYTES = 147456;
constexpr int LP = 272;
constexpr int TILE_LDS = 128 * LP;

#define LAS __attribute__((address_space(3)))
typedef unsigned short bf16;
typedef unsigned v4u __attribute__((ext_vector_type(4)));
typedef unsigned v2u __attribute__((ext_vector_type(2)));
typedef float f32x4 __attribute__((ext_vector_type(4)));
typedef short bf16x8 __attribute__((ext_vector_type(8)));
__device__ __forceinline__ unsigned f2bf(float f) { unsigned u = __builtin_bit_cast(unsigned, f); return (u + 0x7fffu + ((u >> 16) & 1u)) >> 16; }
__device__ __forceinline__ unsigned pk2(float lo, float hi) { return f2bf(lo) | (f2bf(hi) << 16); }
__device__ __forceinline__ float bflo(unsigned w) { return __uint_as_float(w << 16); }
__device__ __forceinline__ float bfhi(unsigned w) { return __uint_as_float(w & 0xffff0000u); }
__device__ __forceinline__ float wave_sum(float v) {
#pragma unroll
    for (int o = 1; o < 64; o <<= 1) v += __shfl_xor(v, o);
    return v;
}

struct Frame {
    LAS unsigned char* lds; unsigned char* ws;
    int tid, lane, wave, G, bid;
    const float* in[15]; float* out;
};

template <int MAP> __device__ __forceinline__ int dest_row(int n) {
    if (MAP == 1) { if (n >= 1024) return n; const int d = n & 127; return (n & ~127) + 32 * ((d >> 4) & 3) + 8 * ((d >> 2) & 3) + 4 * (d >> 6) + (d & 3); }
    if (MAP == 2) { return n < DFF ? 256 * (n >> 7) + (n & 127) : 256 * ((n - DFF) >> 7) + 128 + ((n - DFF) & 127); }
    return n;
}
template <int MAP> __device__ __forceinline__ void p0_transpose_item(const float* W, int K, int N, bf16* WT, LAS float* scr, int item, int lane) {
    const int nblk = N / 32, kb = item / nblk, nb = item % nblk, k0 = 64 * kb, n0 = 32 * nb;
#pragma unroll 8
    for (int i = 0; i < 32; ++i) { const int kk = 2 * i + (lane >> 5); scr[kk * 33 + (lane & 31)] = W[(size_t)(k0 + kk) * N + n0 + (lane & 31)]; }
    asm volatile("s_waitcnt lgkmcnt(0)" ::: "memory");
    const int c = lane & 7;
#pragma unroll
    for (int j = 0; j < 4; ++j) { const int n = (lane >> 3) + 8 * j; const LAS float* s = scr + (8 * c) * 33 + n;
        v4u o; o.x = pk2(s[0 * 33], s[1 * 33]); o.y = pk2(s[2 * 33], s[3 * 33]); o.z = pk2(s[4 * 33], s[5 * 33]); o.w = pk2(s[6 * 33], s[7 * 33]);
        *(v4u*)(WT + (size_t)dest_row<MAP>(n0 + n) * K + k0 + 8 * c) = o; }
    asm volatile("s_waitcnt lgkmcnt(0)" ::: "memory");
}

__device__ __forceinline__ void p0_prologue(Frame& F) {
    LAS float* scr = (LAS float*)(F.lds + F.wave * 16384);
    const int gw = F.bid * NWAVES + F.wave, NGW = F.G * NWAVES;
    const int gt = F.bid * NTHREADS + F.tid, NGT = F.G * NTHREADS;
    constexpr int I_IN = (DM / 64) * (PROJ_W / 32), I_OUT = (DM / 64) * (DM / 32), I_UP = (DM / 64) * (UPW / 32), I_DN = (DFF / 64) * (DM / 32);
    constexpr int NITEMS = I_IN + I_OUT + I_UP + I_DN;
    for (int it = gw; it < NITEMS; it += NGW) {
        int r = it;
        if (r < I_IN) { p0_transpose_item<1>(F.in[2], DM, PROJ_W, (bf16*)(F.ws + WS_WIN), scr, r, F.lane); continue; } r -= I_IN;
        if (r < I_OUT) { p0_transpose_item<0>(F.in[8], DM, DM, (bf16*)(F.ws + WS_WOUT), scr, r, F.lane); continue; } r -= I_OUT;
        if (r < I_UP) { p0_transpose_item<2>(F.in[10], DM, UPW, (bf16*)(F.ws + WS_WUP), scr, r, F.lane); continue; } r -= I_UP;
        p0_transpose_item<0>(F.in[13], DFF, DM, (bf16*)(F.ws + WS_WDOWN), scr, r, F.lane);
    }
    { const float* w = F.in[6]; bf16* o = (bf16*)(F.ws + WS_SGUW);
      for (int i = gt; i < 4 * 128 * 128; i += NGT) { const int t = (i >> 7) & 127, s = i & 127; o[i] = (bf16)f2bf(s <= t ? w[i] : 0.f); } }
    { float* rope = (float*)(F.ws + WS_ROPE);
      for (int i = gt; i < SEQ * 64; i += NGT) { const int pos = i >> 6, f = i & 63;
          const float inv = exp2f(-(float)f * (13.287712379549449f / 64.0f));
          const float ang = (float)pos * inv;
          double t = (double)ang * 0.15915494309189535; t -= rint(t); const float rv = (float)t;
          rope[pos * 128 + f] = __builtin_amdgcn_cosf(rv); rope[pos * 128 + 64 + f] = __builtin_amdgcn_sinf(rv); } }
    { float* z = (float*)(F.ws + WS_SSQ1); for (int i = gt; i < 2 * M; i += NGT) z[i] = 0.f; }
    { const float* g = F.in[1]; bf16* XN = (bf16*)(F.ws + WS_XN);
      f32x4 gv[4];
#pragma unroll
      for (int j = 0; j < 4; ++j) gv[j] = ((const f32x4*)g)[F.lane + 64 * j];
      for (int m = gw; m < M; m += NGW) { const f32x4* xr = (const f32x4*)(F.in[0] + (size_t)m * DM) + F.lane;
          f32x4 v[4]; float s = 0.f;
#pragma unroll
          for (int j = 0; j < 4; ++j) { v[j] = xr[64 * j]; s += (v[j].x * v[j].x + v[j].y * v[j].y) + (v[j].z * v[j].z + v[j].w * v[j].w); }
          const float rstd = 1.0f / sqrtf(wave_sum(s) * (1.0f / DM) + EPS);
          v2u* o8 = (v2u*)(XN + (size_t)m * DM) + F.lane;
#pragma unroll
          for (int j = 0; j < 4; ++j) { const f32x4 y = v[j] * rstd * gv[j]; v2u w; w.x = pk2(y.x, y.y); w.y = pk2(y.z, y.w); o8[64 * j] = w; } } }
}

__device__ __forceinline__ void tile_load_rm(LAS unsigned char* dst, const bf16* src, int ld, int tid) {
#pragma unroll
    for (int i = 0; i < 4; ++i) { const int c = tid + NTHREADS * i, row = c >> 4, ch = c & 15;
        const v4u v = *(const v4u*)(src + (size_t)row * ld + ch * 8); *(LAS v4u*)(dst + row * LP + ch * 16) = v; }
}
template <bool SCALE> __device__ __forceinline__ void tile_load_tr(LAS unsigned char* dst, const bf16* src, int ld, int tid, float lg) {
#pragma unroll
    for (int i = 0; i < 2; ++i) { const int id = tid + NTHREADS * i, kk = id & 63, ch = id >> 6;
        const bf16* p = src + (size_t)(2 * kk) * ld + ch * 8;
        v4u a = *(const v4u*)p, b = *(const v4u*)(p + ld);
        if (SCALE) { const float s0 = exp2f(lg * (float)(127 - 2 * kk)), s1 = exp2f(lg * (float)(126 - 2 * kk));
#pragma unroll
            for (int j = 0; j < 4; ++j) { a[j] = pk2(bflo(a[j]) * s0, bfhi(a[j]) * s0); b[j] = pk2(bflo(b[j]) * s1, bfhi(b[j]) * s1); } }
#pragma unroll
        for (int j = 0; j < 8; ++j) { const unsigned lo = (j & 1) ? (a[j >> 1] >> 16) : (a[j >> 1] & 0xffffu), hi = (j & 1) ? (b[j >> 1] >> 16) : (b[j >> 1] & 0xffffu);
            *(LAS unsigned*)(dst + (8 * ch + j) * LP + kk * 4) = lo | (hi << 16); } }
}
__device__ __forceinline__ void mm16(f32x4 (&acc)[8], const LAS unsigned char* X, const LAS unsigned char* Y, int w, int fr, int fq, int jmax, int ksmax) {
#pragma unroll
    for (int ks = 0; ks < 4; ++ks) if (ks <= ksmax) {
        const bf16x8 a = *(const LAS bf16x8*)(X + (16 * w + fr) * LP + (32 * ks + 8 * fq) * 2);
#pragma unroll
        for (int j = 0; j < 8; ++j) if (j <= jmax) {
            const bf16x8 b = *(const LAS bf16x8*)(Y + (16 * j + fr) * LP + (32 * ks + 8 * fq) * 2);
            acc[j] = __builtin_amdgcn_mfma_f32_16x16x32_bf16(b, a, acc[j], 0, 0, 0); }
    }
}
__device__ __forceinline__ float head_log2g(int h) { return log2f(1.0f - exp2f(-5.0f - (float)h)); }

__device__ __forceinline__ void kv_unit(Frame& F, int bh, int n) {
    const int b = bh >> 2, h = bh & 3; const size_t tok0 = (size_t)b * SEQ + 128 * n;
    const bf16* PROJ = (const bf16*)(F.ws + WS_PROJ);
    LAS unsigned char* Kt = F.lds; LAS unsigned char* Vt = F.lds + TILE_LDS;
    const float lg = head_log2g(h);
    __syncthreads();
    tile_load_tr<true>(Kt, PROJ + tok0 * PROJ_W + 512 + 128 * h, PROJ_W, F.tid, lg);
    tile_load_tr<false>(Vt, PROJ + tok0 * PROJ_W + 1024 + 128 * h, PROJ_W, F.tid, 0.f);
    __syncthreads();
    const int w = F.wave, fr = F.lane & 15, fq = F.lane >> 4;
    f32x4 acc[8];
#pragma unroll
    for (int j = 0; j < 8; ++j) acc[j] = (f32x4){0.f, 0.f, 0.f, 0.f};
    mm16(acc, Vt, Kt, w, fr, fq, 7, 3);
    bf16* o = (bf16*)(F.ws + WS_KV) + ((size_t)(bh * NCHUNK + n) * 128 + 16 * w + fr) * 128 + 4 * fq;
#pragma unroll
    for (int j = 0; j < 8; ++j) { v2u wv; wv.x = pk2(acc[j][0], acc[j][1]); wv.y = pk2(acc[j][2], acc[j][3]); *(v2u*)(o + 16 * j) = wv; }
}

__device__ __forceinline__ void sgu_unit(Frame& F, int b, int n, int g) {
    const size_t tok0 = (size_t)b * SEQ + 128 * n;
    const bf16* PROJ = (const bf16*)(F.ws + WS_PROJ);
    LAS unsigned char* Wl = F.lds; LAS unsigned char* vnT = F.lds + TILE_LDS;
    __syncthreads();
    tile_load_rm(Wl, (const bf16*)(F.ws + WS_SGUW) + g * 16384, 128, F.tid);
    { const int t = F.tid >> 2, qd = F.tid & 3;
      const v4u* p = (const v4u*)(PROJ + (tok0 + t) * PROJ_W + 2560 + 128 * g + 32 * qd);
      float v[32];
#pragma unroll
      for (int c = 0; c < 4; ++c) { const v4u x = p[c];
#pragma unroll
          for (int j = 0; j < 4; ++j) { v[8 * c + 2 * j] = bflo(x[j]); v[8 * c + 2 * j + 1] = bfhi(x[j]); } }
      float s = 0.f;
#pragma unroll
      for (int i = 0; i < 32; ++i) s += v[i];
      s += __shfl_xor(s, 1); s += __shfl_xor(s, 2);
      const float mu = s * (1.0f / 128.0f); float q = 0.f;
#pragma unroll
      for (int i = 0; i < 32; ++i) { v[i] -= mu; q += v[i] * v[i]; }
      q += __shfl_xor(q, 1); q += __shfl_xor(q, 2);
      const float rstd = 1.0f / sqrtf(q * (1.0f / 128.0f) + EPS);
      const float* lng = F.in[4] + 128 * g + 32 * qd; const float* lnb = F.in[5] + 128 * g + 32 * qd;
#pragma unroll
      for (int i = 0; i < 32; ++i) { const float y = v[i] * rstd * lng[i] + lnb[i];
          *(LAS unsigned short*)(vnT + (32 * qd + i) * LP + t * 2) = (unsigned short)f2bf(y); } }
    __syncthreads();
    const int w = F.wave, fr = F.lane & 15, fq = F.lane >> 4;
    f32x4 acc[8];
#pragma unroll
    for (int j = 0; j < 8; ++j) acc[j] = (f32x4){0.f, 0.f, 0.f, 0.f};
    mm16(acc, Wl, vnT, w, fr, fq, 7, (16 * w + 15) >> 5);
    const int t = 16 * w + fr; const float bs = F.in[7][128 * g + t];
    const bf16* up = PROJ + (tok0 + t) * PROJ_W + 2048 + 128 * g + 4 * fq;
    bf16* o = (bf16*)(F.ws + WS_MIX) + (tok0 + t) * DM + 512 + 128 * g + 4 * fq;
#pragma unroll
    for (int j = 0; j < 8; ++j) { const v2u uu = *(const v2u*)(up + 16 * j);
        v2u wv; wv.x = pk2(bflo(uu.x) * (acc[j][0] + bs), bfhi(uu.x) * (acc[j][1] + bs)); wv.y = pk2(bflo(uu.y) * (acc[j][2] + bs), bfhi(uu.y) * (acc[j][3] + bs));
        *(v2u*)(o + 16 * j) = wv; }
}

__device__ __forceinline__ void ret_unit(Frame& F, int bh, int n) {
    const int b = bh >> 2, h = bh & 3; const size_t tok0 = (size_t)b * SEQ + 128 * n;
    const bf16* PROJ = (const bf16*)(F.ws + WS_PROJ);
    LAS unsigned char* Qs = F.lds; LAS unsigned char* Ks = F.lds + TILE_LDS; LAS unsigned char* Vt = F.lds + 2 * TILE_LDS; LAS unsigned char* St = F.lds + 3 * TILE_LDS;
    const float lg = head_log2g(h); const float cd = exp2f(lg * 128.0f);
    __syncthreads();
    tile_load_rm(Qs, PROJ + tok0 * PROJ_W + 128 * h, PROJ_W, F.tid);
    tile_load_rm(Ks, PROJ + tok0 * PROJ_W + 512 + 128 * h, PROJ_W, F.tid);
    tile_load_tr<false>(Vt, PROJ + tok0 * PROJ_W + 1024 + 128 * h, PROJ_W, F.tid, 0.f);
    if (n > 0) {
        const bf16* kv = (const bf16*)(F.ws + WS_KV) + (size_t)bh * NCHUNK * 16384;
        float s[4][8];
#pragma unroll
        for (int i = 0; i < 4; ++i)
#pragma unroll
            for (int j = 0; j < 8; ++j) s[i][j] = 0.f;
        for (int jc = 0; jc < n; ++jc) {
            v4u x[4];
#pragma unroll
            for (int i = 0; i < 4; ++i) x[i] = *(const v4u*)(kv + (size_t)jc * 16384 + (size_t)(F.tid + NTHREADS * i) * 8);
#pragma unroll
            for (int i = 0; i < 4; ++i)
#pragma unroll
                for (int j = 0; j < 4; ++j) { s[i][2 * j] = s[i][2 * j] * cd + bflo(x[i][j]); s[i][2 * j + 1] = s[i][2 * j + 1] * cd + bfhi(x[i][j]); }
        }
#pragma unroll
        for (int i = 0; i < 4; ++i) { const int c = F.tid + NTHREADS * i, e = c >> 4, ch = c & 15;
            v4u o; o.x = pk2(s[i][0], s[i][1]); o.y = pk2(s[i][2], s[i][3]); o.z = pk2(s[i][4], s[i][5]); o.w = pk2(s[i][6], s[i][7]);
            *(LAS v4u*)(St + e * LP + ch * 16) = o; }
    }
    __syncthreads();
    const int w = F.wave, fr = F.lane & 15, fq = F.lane >> 4; const int q = 16 * w + fr;
    f32x4 sc[8], oc[8];
#pragma unroll
    for (int j = 0; j < 8; ++j) { sc[j] = (f32x4){0.f, 0.f, 0.f, 0.f}; oc[j] = (f32x4){0.f, 0.f, 0.f, 0.f}; }
    mm16(sc, Qs, Ks, w, fr, fq, w, 3);
    if (n > 0) { mm16(oc, Qs, St, w, fr, fq, 7, 3); const float qd = exp2f(lg * (float)(q + 1));
#pragma unroll
        for (int j = 0; j < 8; ++j) oc[j] = oc[j] * qd; }
#pragma unroll
    for (int j = 0; j < 8; ++j) { float p[4];
#pragma unroll
        for (int i = 0; i < 4; ++i) { const int k = 16 * j + 4 * fq + i; p[i] = (j <= w && q >= k) ? sc[j][i] * exp2f(lg * (float)(q - k)) : 0.f; }
        v2u wv; wv.x = pk2(p[0], p[1]); wv.y = pk2(p[2], p[3]); *(LAS v2u*)(Qs + q * LP + (16 * j + 4 * fq) * 2) = wv; }
    asm volatile("s_waitcnt lgkmcnt(0)" ::: "memory");
    mm16(oc, Qs, Vt, w, fr, fq, 7, (16 * w + 15) >> 5);
    float ss = 0.f;
#pragma unroll
    for (int j = 0; j < 8; ++j) ss += (oc[j][0] * oc[j][0] + oc[j][1] * oc[j][1]) + (oc[j][2] * oc[j][2] + oc[j][3] * oc[j][3]);
    ss += __shfl_xor(ss, 16); ss += __shfl_xor(ss, 32);
    const float rstd = 1.0f / sqrtf(ss * (1.0f / 128.0f) + EPS);
    const bf16* gp = PROJ + (tok0 + q) * PROJ_W + 1536 + 128 * h + 4 * fq;
    const float* rg = F.in[3] + 128 * h + 4 * fq;
    bf16* o = (bf16*)(F.ws + WS_MIX) + (tok0 + q) * DM + 128 * h + 4 * fq;
#pragma unroll
    for (int j = 0; j < 8; ++j) { const v2u gg = *(const v2u*)(gp + 16 * j); const f32x4 rgv = *(const f32x4*)(rg + 16 * j);
        v2u wv; wv.x = pk2(oc[j][0] * rstd * rgv[0] * bflo(gg.x), oc[j][1] * rstd * rgv[1] * bfhi(gg.x));
        wv.y = pk2(oc[j][2] * rstd * rgv[2] * bflo(gg.y), oc[j][3] * rstd * rgv[3] * bfhi(gg.y));
        *(v2u*)(o + 16 * j) = wv; }
}

struct Args { const float* in[15]; float* out; unsigned char* ws; int ph_lo, ph_hi; };
constexpr int NPHASE = 9;
__global__ void __launch_bounds__(NTHREADS, 2) fwd_megakernel(Args args) {
    extern __shared__ __attribute__((aligned(16))) unsigned char lds[];
    Frame F;
    F.lds = (LAS unsigned char*)lds; F.ws = args.ws;
    F.tid = threadIdx.x; F.lane = F.tid & 63; F.wave = __builtin_amdgcn_readfirstlane(F.tid >> 6);
    F.G = gridDim.x; F.bid = blockIdx.x;
#pragma unroll
    for (int i = 0; i < 15; ++i) F.in[i] = args.in[i];
    F.out = args.out;
    const int lo = args.ph_lo, hi = args.ph_hi;
#define IN(k) (lo <= (k) && (k) < hi)
#define SEAM(k) do { if (IN(k) && IN((k) + 1)) cg::this_grid().sync(); } while (0)

    if (IN(0)) p0_prologue(F);
    SEAM(0);
    if (IN(1)) {
        pg8::Gemm g{(const bf16*)(F.ws + WS_XN), (const bf16*)(F.ws + WS_WIN), M, PROJ_W, DM}; pg8::StaticOrder S; S.init(M, PROJ_W, F.G, F.bid);
        pg8::EpiProj E{(bf16*)(F.ws + WS_PROJ), (const float*)(F.ws + WS_ROPE)};
        pg8::gemm_phase<pg8::EpiProj, pg8::StaticOrder, true, true>(F.lds, g, S, E);
    }
    SEAM(1);
    if (IN(2)) {
        for (int it = F.bid; it < 32 * 15; it += F.G) kv_unit(F, it / 15, it % 15);
        for (int it = F.bid; it < 512; it += F.G) sgu_unit(F, it >> 6, (it >> 2) & 15, it & 3);
    }
    SEAM(2);
    if (IN(3)) {
        for (int it = F.bid; it < 256; it += F.G) { const int bh = it >> 3, n = it & 7; ret_unit(F, bh, 15 - n); ret_unit(F, bh, n); }
        __syncthreads();
    }
    SEAM(3);
    if (IN(4)) {
        pg8::Gemm g{(const bf16*)(F.ws + WS_MIX), (const bf16*)(F.ws + WS_WOUT), M, DM, DM}; pg8::StaticOrder S; S.init(M, DM, F.G, F.bid);
        pg8::EpiRes<true> E{F.in[0], F.out, (bf16*)(F.ws + WS_XN), F.in[9], (float*)(F.ws + WS_SSQ1)};
        pg8::gemm_phase<pg8::EpiRes<true>, pg8::StaticOrder, false, true>(F.lds, g, S, E);
    }
    SEAM(4);
    if (IN(5)) {
        pg8::Gemm g{(const bf16*)(F.ws + WS_XN), (const bf16*)(F.ws + WS_WUP), M, UPW, DM}; pg8::StaticOrder S; S.init(M, UPW, F.G, F.bid);
        pg8::EpiConv E{(const float*)(F.ws + WS_SSQ1), F.in[11], F.in[12], (bf16*)(F.ws + WS_ACT), (float*)(F.ws + WS_EDGE)};
        pg8::gemm_phase<pg8::EpiConv, pg8::StaticOrder, true, true>(F.lds, g, S, E);
    }
    SEAM(5);
    if (IN(6)) {
        const float* edge = (const float*)(F.ws + WS_EDGE); const float* cw = F.in[11]; const float* cb = F.in[12]; bf16* act = (bf16*)(F.ws + WS_ACT);
        const int gt = F.bid * NTHREADS + F.tid, NGT = F.G * NTHREADS;
        for (int i = gt; i < 128 * DFF; i += NGT) { const int run = i / DFF, c = i - run * DFF;
            const float* e = edge + (size_t)run * 4 * UPW; const bool first = (run & 15) == 0;
            float y0[2], y1[2];
#pragma unroll
            for (int hb = 0; hb < 2; ++hb) { const int cc = c + hb * DFF;
                const float f0 = e[cc], f1 = e[UPW + cc]; const float p2 = first ? 0.f : e[cc - 2 * UPW], p1 = first ? 0.f : e[cc - UPW];
                const float w0 = cw[cc], w1 = cw[UPW + cc], w2 = cw[2 * UPW + cc], bb = cb[cc];
                y0[hb] = w2 * f0 + w1 * p1 + w0 * p2 + bb; y1[hb] = w2 * f1 + w1 * f0 + w0 * p1 + bb; }
            act[(size_t)(128 * run) * DFF + c] = (bf16)f2bf(pg8::silu_f(y0[0]) * y0[1]);
            act[(size_t)(128 * run + 1) * DFF + c] = (bf16)f2bf(pg8::silu_f(y1[0]) * y1[1]); }
    }
    SEAM(6);
    if (IN(7)) {
        pg8::Gemm g{(const bf16*)(F.ws + WS_ACT), (const bf16*)(F.ws + WS_WDOWN), M, DM, DFF}; pg8::StaticOrder S; S.init(M, DM, F.G, F.bid);
        pg8::EpiRes<false> E{F.out, F.out, nullptr, nullptr, (float*)(F.ws + WS_SSQ2)};
        pg8::gemm_phase<pg8::EpiRes<false>, pg8::StaticOrder, false, true>(F.lds, g, S, E);
    }
    SEAM(7);
    if (IN(8)) {
        const int gw = F.bid * NWAVES + F.wave, NGW = F.G * NWAVES; const float* ssq = (const float*)(F.ws + WS_SSQ2);
        f32x4 gv[4];
#pragma unroll
        for (int j = 0; j < 4; ++j) gv[j] = ((const f32x4*)F.in[14])[F.lane + 64 * j];
        for (int m = gw; m < M; m += NGW) { f32x4* xr = (f32x4*)(F.out + (size_t)m * DM) + F.lane; const float rstd = 1.0f / sqrtf(ssq[m] * (1.0f / DM) + EPS);
#pragma unroll
            for (int j = 0; j < 4; ++j) xr[64 * j] = xr[64 * j] * rstd * gv[j]; }
    }
#undef IN
#undef SEAM
}

#ifndef MK_MULTI
#define MK_MULTI 0
#endif
extern "C" void kernel_launch(void* const* d_in, const int* in_sizes, int n_in, void* d_out, int out_size, void* d_ws, size_t ws_size, hipStream_t stream) {
    static int grid = 0;
    if (grid == 0) {
        if (n_in != 15 || out_size != M * DM || ws_size < WS_END) { fprintf(stderr, "kernel_launch: unexpected shapes (n_in %d out %d ws %zu)\n", n_in, out_size, ws_size); grid = -1; return; }
        if (hipFuncSetAttribute((const void*)fwd_megakernel, hipFuncAttributeMaxDynamicSharedMemorySize, LDS_BYTES) != hipSuccess) { fprintf(stderr, "kernel_launch: hipFuncSetAttribute failed\n"); grid = -1; return; }
        int dev = 0, cus = 0, per_cu = 0;
        (void)hipGetDevice(&dev); (void)hipDeviceGetAttribute(&cus, hipDeviceAttributeMultiprocessorCount, dev);
        (void)hipOccupancyMaxActiveBlocksPerMultiprocessor(&per_cu, (const void*)fwd_megakernel, NTHREADS, LDS_BYTES);
        (void)hipGetLastError();
        if (per_cu < 1) per_cu = 1;
        grid = cus > 0 ? cus : 256;
    }
    if (grid < 0) return;
    Args a{};
    for (int i = 0; i < 15; ++i) a.in[i] = (const float*)d_in[i];
    a.out = (float*)d_out; a.ws = (unsigned char*)d_ws;
#if MK_MULTI
    for (int p = 0; p < NPHASE; ++p) { a.ph_lo = p; a.ph_hi = p + 1; hipLaunchKernelGGL(fwd_megakernel, dim3(grid), dim3(NTHREADS), LDS_BYTES, stream, a); }
#else
    a.ph_lo = 0; a.ph_hi = NPHASE;
    void* kargs[] = {&a};
    hipError_t e = hipLaunchCooperativeKernel((const void*)fwd_megakernel, dim3(grid), dim3(NTHREADS), kargs, LDS_BYTES, stream);
    if (e != hipSuccess) fprintf(stderr, "cooperative launch failed: %s (grid %d)\n", hipGetErrorString(e), grid);
#endif
}
```

```cpp
#include <hip/hip_runtime.h>
#include <hip/hip_cooperative_groups.h>
#include <cstdio>
#include <cstdint>
namespace cg = cooperative_groups;

namespace pg8 {
#define PG8_LAS __attribute__((address_space(3)))
typedef unsigned short bf16_t;
typedef short bf16x8 __attribute__((ext_vector_type(8)));
typedef float f32x4 __attribute__((ext_vector_type(4)));
typedef float f32x2 __attribute__((ext_vector_type(2)));
typedef unsigned u32x4 __attribute__((ext_vector_type(4)));
typedef unsigned u32x2 __attribute__((ext_vector_type(2)));
constexpr int BM = 256, BK = 64, HALF = 128, HTB = HALF * BK * 2  , STAGE_BYTES = 8 * HTB, NXCD = 8, WGM = 8;

__host__ __device__ __forceinline__ int lds_byte(int r, int c) { const int st = (r >> 4) * 2 + (c >> 5), rr = r & 15, cc = c & 31, ob = rr * 64 + cc * 2; return st * 1024 + (ob ^ (((ob >> 9) & 1) << 5)); }
__host__ __device__ __forceinline__ void stage_rc(int b, int& R, int& C) { const int st = b / 1024, sb = b % 1024, swz = sb ^ (((sb >> 9) & 1) << 5); R = (st >> 1) * 16 + swz / 64; C = (st & 1) * 32 + (swz % 64) / 2; }
__host__ __device__ __forceinline__ int perm32(int rho) { const int n = rho >> 4, i = rho & 15; return 8 * (i >> 2) + 4 * n + (i & 3); }
__host__ __device__ __forceinline__ int tokrow(int R) { return 128 * (R >> 6) + 8 * (R & 15) + ((R >> 4) & 3); }

struct Unit { int pm, pn; };
struct Gemm { const bf16_t* A; const bf16_t* Bt; int M, N, K; };

struct StaticOrder {
    int nM, nN, nwg, G, c;
    __host__ __device__ void init(int M, int N, int G_, int c_) { nM = M / BM; nN = N / BM; nwg = nM * nN; G = G_; c = c_; }
    __host__ __device__ bool next(int i, Unit& u) const {
        const long L = (long)i * G + c; if (L >= nwg) return false;
        int wgid = (int)L; { const int q = nwg / NXCD, r = nwg % NXCD, xcd = wgid % NXCD, off = wgid / NXCD; wgid = (xcd < r ? xcd * (q + 1) : r * (q + 1) + (xcd - r) * q) + off; }
        const int nig = WGM * nN, gid = wgid / nig, fm = gid * WGM, gsz = (nM - fm) < WGM ? (nM - fm) : WGM;
        u.pm = fm + ((wgid % nig) % gsz); u.pn = (wgid % nig) / gsz; return true;
    }
    __device__ __forceinline__ void a_ready(const Unit&) const {}
    __device__ __forceinline__ void done(const Unit&) const {}
};

__device__ __forceinline__ unsigned cvt_pk_bf16(float lo, float hi) { unsigned r; asm volatile("v_cvt_pk_bf16_f32 %0, %1, %2" : "=v"(r) : "v"(lo), "v"(hi)); return r; }
__device__ __forceinline__ f32x2 gelu_pk(f32x2 v) {
    const f32x2 av = __builtin_elementwise_abs(v), d = av * 0.2316418882f + 1.0f;
    f32x2 t; t.x = __builtin_amdgcn_rcpf(d.x); t.y = __builtin_amdgcn_rcpf(d.y);
    f32x2 q = t * 0.5307027145f + (-0.7265760135f); q = q * t + 0.7107068705f; q = q * t + (-0.142248368f); q = q * t + 0.127414796f; q = q * t;
    const f32x2 s = (v * v) * (-0.72134752044f);
    f32x2 e; e.x = __builtin_amdgcn_exp2f(s.x); e.y = __builtin_amdgcn_exp2f(s.y);
    const f32x2 m = v * (q * e), r = v - m;
    f32x2 o; o.x = v.x < 0.f ? m.x : r.x; o.y = v.y < 0.f ? m.y : r.y; return o;
}
__device__ __forceinline__ float silu_f(float v) { return v * __builtin_amdgcn_rcpf(1.f + __builtin_amdgcn_exp2f(-1.4426950408889634f * v)); }
__device__ __forceinline__ f32x4 silu4(f32x4 v) { return (f32x4){silu_f(v[0]), silu_f(v[1]), silu_f(v[2]), silu_f(v[3])}; }
__device__ __forceinline__ f32x4 gelu4(f32x4 v) { const f32x2 a = gelu_pk((f32x2){v[0], v[1]}), b = gelu_pk((f32x2){v[2], v[3]}); return (f32x4){a.x, a.y, b.x, b.y}; }
__device__ __forceinline__ u32x2 pack4(f32x4 v) { u32x2 w; w.x = cvt_pk_bf16(v[0], v[1]); w.y = cvt_pk_bf16(v[2], v[3]); return w; }

constexpr int PROJ_W = 3072, DM = 1024, DFF = 2816, UPW = 5632, SEQ = 2048;
constexpr float EPS = 1e-6f;

struct EpiProj {
    static constexpr bool PERM = true, AFTER_DRAIN = false, AROWPERM = false;
    bf16_t* O; const float* rope;
    __device__ __forceinline__ void operator()(const f32x4 (&acc)[2][2][4][2], const Unit& u, int wr, int wc, int fr, int fq) const {
        const int row0 = u.pm * BM + wr * 64 + fr; const int type = u.pn >> 1;
        if (type < 2) {
            const float sc = (type == 1) ? 0.08838834764831845f : 1.0f; const int pp = 16 * wc + 4 * fq;
#pragma unroll
            for (int ai = 0; ai < 2; ++ai)
#pragma unroll
                for (int m = 0; m < 4; ++m) { const int row = row0 + ai * HALF + m * 16; const int pos = row & (SEQ - 1);
                    const f32x4 c = *(const f32x4*)(rope + pos * 128 + pp), s = *(const f32x4*)(rope + pos * 128 + 64 + pp);
#pragma unroll
                    for (int bj = 0; bj < 2; ++bj) { const f32x4 x1 = acc[ai][bj][m][0], x2 = acc[ai][bj][m][1];
                        const f32x4 o1 = (x1 * c - x2 * s) * sc, o2 = (x2 * c + x1 * s) * sc;
                        bf16_t* p = O + (size_t)row * PROJ_W + u.pn * BM + bj * HALF + pp;
                        *(u32x2*)p = pack4(o1); *(u32x2*)(p + 64) = pack4(o2); } }
        } else {
            const int col0 = u.pn * BM + wc * 32 + 8 * fq;
#pragma unroll
            for (int ai = 0; ai < 2; ++ai)
#pragma unroll
                for (int m = 0; m < 4; ++m) { bf16_t* rowp = O + (size_t)(row0 + ai * HALF + m * 16) * PROJ_W + col0;
#pragma unroll
                    for (int bj = 0; bj < 2; ++bj) { f32x4 v0 = acc[ai][bj][m][0], v1 = acc[ai][bj][m][1];
                        if (type == 3) { v0 = silu4(v0); v1 = silu4(v1); } else if (type >= 4) { v0 = gelu4(v0); v1 = gelu4(v1); }
                        const u32x2 a = pack4(v0), b = pack4(v1); u32x4 w; w.x = a.x; w.y = a.y; w.z = b.x; w.w = b.y;
                        *(u32x4*)(rowp + bj * HALF) = w; } }
        }
    }
};

template <bool WRITE_XG> struct EpiRes {
    static constexpr bool PERM = false, AFTER_DRAIN = false, AROWPERM = false;
    const float* base; float* out; bf16_t* xg; const float* gain; float* ssq;
    __device__ __forceinline__ void operator()(const f32x4 (&acc)[2][2][4][2], const Unit& u, int wr, int wc, int fr, int fq) const {
        const int col0 = u.pn * BM + wc * 32 + 4 * fq;
        f32x4 gv[2][2];
#pragma unroll
        for (int bj = 0; bj < 2; ++bj)
#pragma unroll
            for (int n = 0; n < 2; ++n) gv[bj][n] = WRITE_XG ? *(const f32x4*)(gain + col0 + bj * HALF + n * 16) : (f32x4){0.f, 0.f, 0.f, 0.f};
#pragma unroll
        for (int ai = 0; ai < 2; ++ai)
#pragma unroll
            for (int m = 0; m < 4; ++m) { const int row = u.pm * BM + ai * HALF + wr * 64 + m * 16 + fr; const size_t off = (size_t)row * DM + col0; float s = 0.f;
#pragma unroll
                for (int bj = 0; bj < 2; ++bj)
#pragma unroll
                    for (int n = 0; n < 2; ++n) { const f32x4 x1 = *(const f32x4*)(base + off + bj * HALF + n * 16) + acc[ai][bj][m][n];
                        if (!WRITE_XG) *(f32x4*)(out + off + bj * HALF + n * 16) = x1; s += (x1[0] * x1[0] + x1[1] * x1[1]) + (x1[2] * x1[2] + x1[3] * x1[3]);
                        if (WRITE_XG) *(u32x2*)(xg + off + bj * HALF + n * 16) = pack4(x1 * gv[bj][n]); }
                s += __shfl_xor(s, 16); s += __shfl_xor(s, 32);
                if (fq == 0) (void)__hip_atomic_fetch_add(ssq + row, s, __ATOMIC_RELAXED, __HIP_MEMORY_SCOPE_AGENT);
                if (m == 3) asm volatile("" ::: "memory"); }
    }
};

struct EpiFinal {
    static constexpr bool PERM = false, AFTER_DRAIN = false, AROWPERM = false;
    const bf16_t* xg; const float* gffn; float* out; const float* gain; float* ssq; unsigned* cnt;
    __device__ __forceinline__ void operator()(f32x4 (&acc)[2][2][4][2], const Unit& u, int wr, int wc, int fr, int fq) const {
        const int col0 = u.pn * BM + wc * 32 + 4 * fq;
        f32x4 gi[2][2];
#pragma unroll
        for (int bj = 0; bj < 2; ++bj)
#pragma unroll
            for (int n = 0; n < 2; ++n) { const f32x4 gf = *(const f32x4*)(gffn + col0 + bj * HALF + n * 16); gi[bj][n] = (f32x4){1.0f / gf[0], 1.0f / gf[1], 1.0f / gf[2], 1.0f / gf[3]}; }
#pragma unroll
        for (int ai = 0; ai < 2; ++ai)
#pragma unroll
            for (int m = 0; m < 4; ++m) { const int row = u.pm * BM + ai * HALF + wr * 64 + m * 16 + fr; const size_t off = (size_t)row * DM + col0; float s = 0.f;
#pragma unroll
                for (int bj = 0; bj < 2; ++bj)
#pragma unroll
                    for (int n = 0; n < 2; ++n) { const u32x2 xb = *(const u32x2*)(xg + off + bj * HALF + n * 16);
                        const f32x4 x1 = (f32x4){__uint_as_float(xb.x << 16), __uint_as_float(xb.x & 0xffff0000u), __uint_as_float(xb.y << 16), __uint_as_float(xb.y & 0xffff0000u)} * gi[bj][n];
                        const f32x4 x2 = x1 + acc[ai][bj][m][n];
                        acc[ai][bj][m][n] = x2; s += (x2[0] * x2[0] + x2[1] * x2[1]) + (x2[2] * x2[2] + x2[3] * x2[3]); }
                s += __shfl_xor(s, 16); s += __shfl_xor(s, 32);
                if (fq == 0) (void)__hip_atomic_fetch_add(ssq + row, s, __ATOMIC_RELAXED, __HIP_MEMORY_SCOPE_AGENT);
                if (m == 3) asm volatile("" ::: "memory"); }
        asm volatile("s_waitcnt vmcnt(0)" ::: "memory");
        unsigned* c = cnt + 64 * u.pm;
        if ((threadIdx.x & 63) == 0) (void)__hip_atomic_fetch_add(c, 1u, __ATOMIC_RELAXED, __HIP_MEMORY_SCOPE_AGENT);
        { unsigned sp = 0;
          while ((unsigned)__builtin_amdgcn_readfirstlane(__hip_atomic_load(c, __ATOMIC_RELAXED, __HIP_MEMORY_SCOPE_AGENT)) < 32u) { __builtin_amdgcn_s_sleep(2); if (++sp > (1u << 22)) break; } }
        __builtin_amdgcn_fence(__ATOMIC_ACQUIRE, "agent");
        f32x4 gv[2][2];
#pragma unroll
        for (int bj = 0; bj < 2; ++bj)
#pragma unroll
            for (int n = 0; n < 2; ++n) gv[bj][n] = *(const f32x4*)(gain + col0 + bj * HALF + n * 16);
#pragma unroll
        for (int ai = 0; ai < 2; ++ai)
#pragma unroll
            for (int m = 0; m < 4; ++m) { const int row = u.pm * BM + ai * HALF + wr * 64 + m * 16 + fr; const size_t off = (size_t)row * DM + col0;
                const float tot = __hip_atomic_load(ssq + row, __ATOMIC_RELAXED, __HIP_MEMORY_SCOPE_AGENT);
                const float rstd = __builtin_amdgcn_rsqf(tot * (1.0f / DM) + EPS);
#pragma unroll
                for (int bj = 0; bj < 2; ++bj)
#pragma unroll
                    for (int n = 0; n < 2; ++n) *(f32x4*)(out + off + bj * HALF + n * 16) = acc[ai][bj][m][n] * rstd * gv[bj][n]; }
    }
};

__device__ __forceinline__ float dpp_shr1(float v) { return __int_as_float(__builtin_amdgcn_update_dpp(0, __float_as_int(v), 0x111, 0xf, 0xf, true)); }
__device__ __forceinline__ f32x4 dpp_shr1_4(f32x4 v) { return (f32x4){dpp_shr1(v[0]), dpp_shr1(v[1]), dpp_shr1(v[2]), dpp_shr1(v[3])}; }
struct EpiConv {
    static constexpr bool PERM = true, AFTER_DRAIN = false, AROWPERM = true;
    const float* ssq; const float* cw; const float* cb; bf16_t* act; float* edge;
    __device__ __forceinline__ void operator()(const f32x4 (&acc)[2][2][4][2], const Unit& u, int wr, int wc, int fr, int fq) const {
        const int run = u.pm * 2 + wr; const int tok0 = u.pm * BM + wr * HALF + 8 * fr;
        float rstd[8];
        { const f32x4 s0 = *(const f32x4*)(ssq + tok0), s1 = *(const f32x4*)(ssq + tok0 + 4);
#pragma unroll
          for (int i = 0; i < 4; ++i) { rstd[i] = __builtin_amdgcn_rsqf(s0[i] * (1.0f / DM) + EPS); rstd[4 + i] = __builtin_amdgcn_rsqf(s1[i] * (1.0f / DM) + EPS); } }
        u32x2 pk0[8];
#pragma unroll
        for (int n = 0; n < 2; ++n) {
            const int ca = u.pn * HALF + wc * 32 + 8 * fq + 4 * n;
            const f32x4 w0a = *(const f32x4*)(cw + ca), w1a = *(const f32x4*)(cw + UPW + ca), w2a = *(const f32x4*)(cw + 2 * UPW + ca), ba = *(const f32x4*)(cb + ca);
            const f32x4 w0b = *(const f32x4*)(cw + DFF + ca), w1b = *(const f32x4*)(cw + UPW + DFF + ca), w2b = *(const f32x4*)(cw + 2 * UPW + DFF + ca), bb = *(const f32x4*)(cb + DFF + ca);
            f32x4 ua[8], ub[8];
#pragma unroll
            for (int t = 0; t < 8; ++t) { ua[t] = acc[t >> 2][0][t & 3][n] * rstd[t]; ub[t] = acc[t >> 2][1][t & 3][n] * rstd[t]; }
            const f32x4 pa1 = dpp_shr1_4(ua[7]), pa2 = dpp_shr1_4(ua[6]), pb1 = dpp_shr1_4(ub[7]), pb2 = dpp_shr1_4(ub[6]);
            if (fr == 0) { float* e = edge + (size_t)run * 4 * UPW; *(f32x4*)(e + ca) = ua[0]; *(f32x4*)(e + UPW + ca) = ua[1]; *(f32x4*)(e + DFF + ca) = ub[0]; *(f32x4*)(e + UPW + DFF + ca) = ub[1]; }
            if (fr == 15) { float* e = edge + (size_t)run * 4 * UPW + 2 * UPW; *(f32x4*)(e + ca) = ua[6]; *(f32x4*)(e + UPW + ca) = ua[7]; *(f32x4*)(e + DFF + ca) = ub[6]; *(f32x4*)(e + UPW + DFF + ca) = ub[7]; }
#pragma unroll
            for (int t = 0; t < 8; ++t) {
                const f32x4 am1 = (t >= 1) ? ua[t >= 1 ? t - 1 : 0] : pa1, am2 = (t >= 2) ? ua[t >= 2 ? t - 2 : 0] : (t == 1 ? pa1 : pa2);
                const f32x4 bm1 = (t >= 1) ? ub[t >= 1 ? t - 1 : 0] : pb1, bm2 = (t >= 2) ? ub[t >= 2 ? t - 2 : 0] : (t == 1 ? pb1 : pb2);
                const f32x4 ya = w2a * ua[t] + w1a * am1 + w0a * am2 + ba, yb = w2b * ub[t] + w1b * bm1 + w0b * bm2 + bb;
                const u32x2 pk = pack4(silu4(ya) * yb);
                if (n == 0) pk0[t] = pk;
                else if (!(fr == 0 && t < 2)) { u32x4 w; w.x = pk0[t].x; w.y = pk0[t].y; w.z = pk.x; w.w = pk.y;
                    *(u32x4*)(act + (size_t)(tok0 + t) * DFF + u.pn * HALF + wc * 32 + 8 * fq) = w; }
            }
        }
    }
};
template <class Epi, class Sched, bool ALIGN_EPI = false, bool SP2 = false>
__device__ __forceinline__ void gemm_phase(PG8_LAS unsigned char* lds, const Gemm g, const Sched& S, const Epi& E) {
    const int tid = threadIdx.x, wid = __builtin_amdgcn_readfirstlane(tid >> 6), lane = tid & 63, wr = wid >> 2, wc = wid & 3, fr = lane & 15, fq = lane >> 4;
    const int K = g.K, nt = K / BK;
    unsigned voffA[2], voffB[2];
#pragma unroll
    for (int i = 0; i < 2; ++i) { int R, C; stage_rc(tid * 16 + i * 8192, R, C); const int Rb = Epi::PERM ? ((R & ~31) + perm32(R & 31)) : R;
        voffA[i] = (unsigned)((Epi::AROWPERM ? tokrow(R) : R) * K + C) * 2u; voffB[i] = (unsigned)(Rb * K + C) * 2u; }
    const size_t kstep = (size_t)(BK * 2);
    const size_t hstepB = (size_t)HALF * K * 2; const size_t hstepA = Epi::AROWPERM ? (size_t)4 * K * 2 : hstepB;
    const size_t tstep = 2 * hstepB;
    const unsigned ldsw = (unsigned)wid * 1024u;
    const int aoff = lds_byte(wr * 64 + fr, fq * 8), boff = lds_byte(wc * 32 + fr, fq * 8);
#define PG8_SA(b, h) (((b) * 2 + (h)) * HTB)
#define PG8_SB(b, h) ((4 + (b) * 2 + (h)) * HTB)
#define PG8_STAGE(bufoff, gbase, voff) do { _Pragma("unroll") for (int _i = 0; _i < 2; ++_i) \
        __builtin_amdgcn_global_load_lds((const unsigned*)((const char*)(gbase) + (voff)[_i]), (PG8_LAS unsigned*)(lds + (bufoff) + ldsw + _i * 8192), 16, 0, 0); } while (0)
#define PG8_LDA(dst, b, h) do { _Pragma("unroll") for (int m = 0; m < 4; ++m) _Pragma("unroll") for (int k = 0; k < 2; ++k) dst[m][k] = *(const PG8_LAS bf16x8*)(lds + PG8_SA(b, h) + aoff + m * 2048 + k * 1024); } while (0)
#define PG8_LDB(dst, b, h) do { _Pragma("unroll") for (int n = 0; n < 2; ++n) _Pragma("unroll") for (int k = 0; k < 2; ++k) dst[n][k] = *(const PG8_LAS bf16x8*)(lds + PG8_SB(b, h) + boff + n * 2048 + k * 1024); } while (0)
#define PG8_MMA(ai, bj, At, Bt) do { __builtin_amdgcn_s_setprio(1); _Pragma("unroll") for (int m = 0; m < 4; ++m) _Pragma("unroll") for (int n = 0; n < 2; ++n) _Pragma("unroll") for (int k = 0; k < 2; ++k) \
        acc[ai][bj][m][n] = __builtin_amdgcn_mfma_f32_16x16x32_bf16(Bt[n][k], At[m][k], acc[ai][bj][m][n], 0, 0, 0); __builtin_amdgcn_s_setprio(0); } while (0)
#define PG8_WAIT_V(n) asm volatile("s_waitcnt vmcnt(" #n ")" ::: "memory")
#define PG8_WAIT_L(n) asm volatile("s_waitcnt lgkmcnt(" #n ")" ::: "memory")
#define PG8_BAR __builtin_amdgcn_s_barrier()
#define PG8_SCHED __builtin_amdgcn_sched_barrier(0)
    Unit cur, nxt; int ui = 0;
    if (!S.next(0, cur)) return;
    f32x4 acc[2][2][4][2];
#pragma unroll
    for (int a = 0; a < 2; ++a)
#pragma unroll
        for (int b = 0; b < 2; ++b)
#pragma unroll
            for (int m = 0; m < 4; ++m)
#pragma unroll
                for (int n = 0; n < 2; ++n) acc[a][b][m][n] = (f32x4){0.f, 0.f, 0.f, 0.f};
    bf16x8 At[4][2], B0[2][2], B1[2][2];
    const char* cA = (const char*)g.A + (size_t)cur.pm * tstep; const char* cB = (const char*)g.Bt + (size_t)cur.pn * tstep;
    S.a_ready(cur);
    if constexpr (SP2) {
        PG8_STAGE(PG8_SB(0, 0), cB, voffB); PG8_STAGE(PG8_SB(0, 1), cB + hstepB, voffB); PG8_STAGE(PG8_SA(0, 0), cA, voffA); PG8_STAGE(PG8_SA(0, 1), cA + hstepA, voffA);
        if (wr == 1) PG8_BAR;
        PG8_WAIT_V(2); PG8_BAR;
        PG8_STAGE(PG8_SB(1, 0), cB + kstep, voffB); PG8_STAGE(PG8_SA(1, 0), cA + kstep, voffA); PG8_STAGE(PG8_SB(1, 1), cB + hstepB + kstep, voffB);
        PG8_WAIT_V(6); PG8_BAR;
    } else {
        PG8_STAGE(PG8_SB(0, 0), cB, voffB); PG8_STAGE(PG8_SA(0, 0), cA, voffA); PG8_STAGE(PG8_SB(0, 1), cB + hstepB, voffB); PG8_STAGE(PG8_SA(0, 1), cA + hstepA, voffA);
        if (wr == 1) PG8_BAR;
        PG8_WAIT_V(4); PG8_BAR;
        PG8_STAGE(PG8_SB(1, 0), cB + kstep, voffB); PG8_STAGE(PG8_SA(1, 0), cA + kstep, voffA); PG8_STAGE(PG8_SB(1, 1), cB + hstepB + kstep, voffB);
        PG8_WAIT_V(6); PG8_BAR;
    }
    for (;;) {
        const bool has_next = S.next(ui + 1, nxt);
        const char* nA = has_next ? (const char*)g.A + (size_t)nxt.pm * tstep : cA; const char* nB = has_next ? (const char*)g.Bt + (size_t)nxt.pn * tstep : cB;
        for (int t = 0; t < nt; t += 2) {
            const bool last = (t == nt - 2);
            const char* a1 = cA + (size_t)(t + 1) * kstep;
            const char* a2 = last ? nA : cA + (size_t)(t + 2) * kstep; const char* b2 = last ? nB : cB + (size_t)(t + 2) * kstep;
            const char* a3 = a2 + kstep; const char* b3 = b2 + kstep;
            if (last && has_next) S.a_ready(nxt);
            if constexpr (SP2) {
            PG8_LDB(B0, 0, 0); PG8_LDB(B1, 0, 1); PG8_SCHED; PG8_LDA(At, 0, 0); PG8_STAGE(PG8_SA(1, 1), a1 + hstepA, voffA);
            PG8_WAIT_V(8); PG8_WAIT_L(0); PG8_BAR; PG8_MMA(0, 0, At, B0); PG8_MMA(0, 1, At, B1); PG8_BAR; PG8_SCHED;
            PG8_LDA(At, 0, 1); PG8_STAGE(PG8_SB(0, 0), b2, voffB); PG8_STAGE(PG8_SB(0, 1), b2 + hstepB, voffB); PG8_STAGE(PG8_SA(0, 0), a2, voffA);
            PG8_WAIT_V(8); PG8_WAIT_L(0); PG8_BAR; PG8_MMA(1, 0, At, B0); PG8_MMA(1, 1, At, B1); PG8_BAR; PG8_SCHED;
            PG8_LDB(B0, 1, 0); PG8_LDB(B1, 1, 1); PG8_SCHED; PG8_LDA(At, 1, 0); PG8_STAGE(PG8_SA(0, 1), a2 + hstepA, voffA);
            PG8_WAIT_V(8); PG8_WAIT_L(0); PG8_BAR; PG8_MMA(0, 0, At, B0); PG8_MMA(0, 1, At, B1); PG8_BAR; PG8_SCHED;
            PG8_LDA(At, 1, 1); PG8_STAGE(PG8_SB(1, 0), b3, voffB); PG8_STAGE(PG8_SB(1, 1), b3 + hstepB, voffB); PG8_STAGE(PG8_SA(1, 0), a3, voffA);
            PG8_WAIT_V(8); PG8_WAIT_L(0); PG8_BAR; PG8_MMA(1, 0, At, B0); PG8_MMA(1, 1, At, B1); PG8_BAR; PG8_SCHED;
            } else {
            PG8_LDB(B0, 0, 0); PG8_SCHED; PG8_LDA(At, 0, 0); PG8_STAGE(PG8_SA(1, 1), a1 + hstepA, voffA);
            PG8_WAIT_L(8); PG8_BAR; PG8_WAIT_L(0); PG8_MMA(0, 0, At, B0); PG8_BAR; PG8_SCHED;
            PG8_LDB(B1, 0, 1); PG8_STAGE(PG8_SB(0, 0), b2, voffB);
            PG8_BAR; PG8_WAIT_L(0); PG8_MMA(0, 1, At, B1); PG8_BAR;
            PG8_LDA(At, 0, 1); PG8_STAGE(PG8_SA(0, 0), a2, voffA);
            PG8_BAR; PG8_WAIT_L(0); PG8_MMA(1, 0, At, B0); PG8_BAR; PG8_SCHED;
            PG8_STAGE(PG8_SB(0, 1), b2 + hstepB, voffB);
            PG8_WAIT_V(6); PG8_BAR; PG8_MMA(1, 1, At, B1); PG8_BAR;
            PG8_LDB(B0, 1, 0); PG8_SCHED; PG8_LDA(At, 1, 0); PG8_STAGE(PG8_SA(0, 1), a2 + hstepA, voffA);
            PG8_WAIT_L(8); PG8_BAR; PG8_WAIT_L(0); PG8_MMA(0, 0, At, B0); PG8_BAR; PG8_SCHED;
            PG8_LDB(B1, 1, 1); PG8_STAGE(PG8_SB(1, 0), b3, voffB);
            PG8_BAR; PG8_WAIT_L(0); PG8_MMA(0, 1, At, B1); PG8_BAR;
            PG8_LDA(At, 1, 1); PG8_STAGE(PG8_SA(1, 0), a3, voffA);
            PG8_BAR; PG8_WAIT_L(0); PG8_MMA(1, 0, At, B0); PG8_BAR; PG8_SCHED;
            PG8_STAGE(PG8_SB(1, 1), b3 + hstepB, voffB);
            PG8_WAIT_V(6); PG8_BAR; PG8_MMA(1, 1, At, B1); PG8_BAR;
            }
        }
        if constexpr (ALIGN_EPI) { if (wr == 0) PG8_BAR; }
        if constexpr (!Epi::AFTER_DRAIN) { E(acc, cur, wr, wc, fr, fq); S.done(cur); }
        if (!has_next) break;
#pragma unroll
        for (int a = 0; a < 2; ++a)
#pragma unroll
            for (int b = 0; b < 2; ++b)
#pragma unroll
                for (int m = 0; m < 4; ++m)
#pragma unroll
                    for (int n = 0; n < 2; ++n) acc[a][b][m][n] = (f32x4){0.f, 0.f, 0.f, 0.f};
        cur = nxt; cA = nA; cB = nB; ++ui;
        if constexpr (ALIGN_EPI) { if (wr == 1) PG8_BAR; }
    }
    PG8_WAIT_V(0);
    if constexpr (!ALIGN_EPI) { if (wr == 0) PG8_BAR; }
    PG8_BAR;
    if constexpr (Epi::AFTER_DRAIN) { E.fused(acc, cur, wr, wc, fr, fq, lds, wid, lane); S.done(cur); }
#undef PG8_SA
#undef PG8_SB
#undef PG8_STAGE
#undef PG8_LDA
#undef PG8_LDB
#undef PG8_MMA
#undef PG8_WAIT_V
#undef PG8_WAIT_L
#undef PG8_BAR
#undef PG8_SCHED
}
}
#ifndef MK_MULTI
#define MK_MULTI 0
#endif
#ifndef MK_SPIN
#define MK_SPIN -1
#endif
#ifndef MK_CGSYNC
#define MK_CGSYNC 0
#endif
#ifndef MK_REPMASK
#define MK_REPMASK 0
#endif

constexpr int NWAVES = 8, NTHREADS = 512;
constexpr int BATCH = 8, SEQ = 2048, DM = 1024, M = BATCH * SEQ, PROJ_W = 3072, DFF = 2816, UPW = 5632, NCHUNK = 16;
constexpr float EPS = 1e-6f;
constexpr size_t MiB = 1u << 20;
constexpr size_t WS_SSQ1 = 0, WS_SSQ2 = 65536, WS_BAR = 131072, WS_BAR_BYTES = 32768, WS_PCNT = 131072 + 16384, WS_ROPE = 1 * MiB, WS_SGUW = 2 * MiB, WS_WIN = 3 * MiB, WS_WOUT = 9 * MiB, WS_WUP = 11 * MiB, WS_WDOWN = 22 * MiB,
                 WS_EDGE = 28 * MiB, WS_XN = 40 * MiB, WS_PROJ = 72 * MiB, WS_MIX = 168 * MiB, WS_KV = 200 * MiB, WS_ACT = 72 * MiB, WS_END = 216 * MiB;
constexpr int LDS_BYTES = 147456, MISC_OFF = 147456 - 64;
constexpr int LP = 272;
constexpr int TILE_LDS = 128 * LP;

#define LAS __attribute__((address_space(3)))
typedef unsigned short bf16;
typedef unsigned v4u __attribute__((ext_vector_type(4)));
typedef unsigned v2u __attribute__((ext_vector_type(2)));
typedef float f32x4 __attribute__((ext_vector_type(4)));
typedef short bf16x8 __attribute__((ext_vector_type(8)));
__device__ __forceinline__ unsigned f2bf(float f) { unsigned u = __builtin_bit_cast(unsigned, f); return (u + 0x7fffu + ((u >> 16) & 1u)) >> 16; }
__device__ __forceinline__ unsigned pk2(float lo, float hi) { return f2bf(lo) | (f2bf(hi) << 16); }
__device__ __forceinline__ float bflo(unsigned w) { return __uint_as_float(w << 16); }
__device__ __forceinline__ float bfhi(unsigned w) { return __uint_as_float(w & 0xffff0000u); }
__device__ __forceinline__ float wave_sum(float v) {
#pragma unroll
    for (int o = 1; o < 64; o <<= 1) v += __shfl_xor(v, o);
    return v;
}

struct Frame {
    LAS unsigned char* lds; unsigned char* ws;
    int tid, lane, wave, G, bid;
    const float* in[15]; float* out;
};

__device__ __forceinline__ int dest_row(int map, int n) {
    if (map == 1) { if (n >= 1024) return n; const int d = n & 127; return (n & ~127) + 32 * ((d >> 4) & 3) + 8 * ((d >> 2) & 3) + 4 * (d >> 6) + (d & 3); }
    if (map == 2) { return n < DFF ? 256 * (n >> 7) + (n & 127) : 256 * ((n - DFF) >> 7) + 128 + ((n - DFF) & 127); }
    return n;
}
struct WItem { const float* W; bf16* WT; int K, N, map, item; };
__device__ __forceinline__ WItem witem_in(Frame& F, int it) { WItem w; w.W = F.in[2]; w.WT = (bf16*)(F.ws + WS_WIN); w.K = DM; w.N = PROJ_W; w.map = 1; w.item = it; return w; }
constexpr int I_IN = (DM / 64) * (PROJ_W / 32), I_OUT = (DM / 64) * (DM / 32), I_UP = (DM / 64) * (UPW / 32), I_DN = (DFF / 64) * (DM / 32), I_TAIL = I_OUT + I_UP + I_DN;
__device__ __forceinline__ WItem witem_tail(Frame& F, int it) {
    WItem w; int r = it;
    if (r < I_OUT) { w.W = F.in[8]; w.WT = (bf16*)(F.ws + WS_WOUT); w.K = DM; w.N = DM; w.map = 0; w.item = r; return w; } r -= I_OUT;
    if (r < I_UP) { w.W = F.in[10]; w.WT = (bf16*)(F.ws + WS_WUP); w.K = DM; w.N = UPW; w.map = 2; w.item = r; return w; } r -= I_UP;
    w.W = F.in[13]; w.WT = (bf16*)(F.ws + WS_WDOWN); w.K = DFF; w.N = DM; w.map = 0; w.item = r; return w;
}
__device__ __forceinline__ void witem_load(const WItem& w, f32x4 (&v)[8], int lane) {
    const int nblk = w.N / 32, kb = w.item / nblk, nb = w.item % nblk;
    const float* p = w.W + (size_t)(64 * kb + (lane >> 3)) * w.N + 32 * nb + 4 * (lane & 7);
#pragma unroll
    for (int i = 0; i < 8; ++i) v[i] = *(const f32x4*)(p + (size_t)(8 * i) * w.N);
}
__device__ __forceinline__ void witem_finish(const WItem& w, const f32x4 (&v)[8], LAS float* scr, int lane) {
    const int nblk = w.N / 32, kb = w.item / nblk, nb = w.item % nblk, k0 = 64 * kb, n0 = 32 * nb;
#pragma unroll
    for (int i = 0; i < 8; ++i) { LAS float* d = scr + (8 * i + (lane >> 3)) * 33 + 4 * (lane & 7); d[0] = v[i].x; d[1] = v[i].y; d[2] = v[i].z; d[3] = v[i].w; }
    asm volatile("s_waitcnt lgkmcnt(0)" ::: "memory");
    const int c = lane & 7;
#pragma unroll
    for (int j = 0; j < 4; ++j) { const int n = (lane >> 3) + 8 * j; const LAS float* s = scr + (8 * c) * 33 + n;
        v4u o; o.x = pk2(s[0 * 33], s[1 * 33]); o.y = pk2(s[2 * 33], s[3 * 33]); o.z = pk2(s[4 * 33], s[5 * 33]); o.w = pk2(s[6 * 33], s[7 * 33]);
        *(v4u*)(w.WT + (size_t)dest_row(w.map, n0 + n) * w.K + k0 + 8 * c) = o; }
    asm volatile("s_waitcnt lgkmcnt(0)" ::: "memory");
}

__device__ __forceinline__ void p0_prologue(Frame& F) {
    LAS float* scr = (LAS float*)(F.lds + F.wave * 16384);
    const int gw = F.bid * NWAVES + F.wave, NGW = F.G * NWAVES;
    const int gt = F.bid * NTHREADS + F.tid, NGT = F.G * NTHREADS;
    for (int it = gw; it < I_IN; it += NGW) { const WItem w = witem_in(F, it); f32x4 v[8]; witem_load(w, v, F.lane); witem_finish(w, v, scr, F.lane); }
    { float* rope = (float*)(F.ws + WS_ROPE);
      for (int i = gt; i < SEQ * 64; i += NGT) { const int pos = i >> 6, f = i & 63;
          const float inv = exp2f(-(float)f * (13.287712379549449f / 64.0f));
          const float ang = (float)pos * inv;
          double t = (double)ang * 0.15915494309189535; t -= rint(t); const float rv = (float)t;
          rope[pos * 128 + f] = __builtin_amdgcn_cosf(rv); rope[pos * 128 + 64 + f] = __builtin_amdgcn_sinf(rv); } }
    { float* z = (float*)(F.ws + WS_SSQ1); for (int i = gt; i < 2 * M; i += NGT) z[i] = 0.f; }
    { const float* g = F.in[1]; bf16* XN = (bf16*)(F.ws + WS_XN);
      f32x4 gv[4];
#pragma unroll
      for (int j = 0; j < 4; ++j) gv[j] = ((const f32x4*)g)[F.lane + 64 * j];
      for (int m0 = gw * 4; m0 < M; m0 += NGW * 4) {
          f32x4 v[4][4]; float s[4];
#pragma unroll
          for (int r = 0; r < 4; ++r) { const f32x4* xr = (const f32x4*)(F.in[0] + (size_t)(m0 + r) * DM) + F.lane;
#pragma unroll
              for (int j = 0; j < 4; ++j) v[r][j] = xr[64 * j]; }
#pragma unroll
          for (int r = 0; r < 4; ++r) { s[r] = 0.f;
#pragma unroll
              for (int j = 0; j < 4; ++j) s[r] += (v[r][j].x * v[r][j].x + v[r][j].y * v[r][j].y) + (v[r][j].z * v[r][j].z + v[r][j].w * v[r][j].w); }
#pragma unroll
          for (int o = 1; o < 64; o <<= 1) {
#pragma unroll
              for (int r = 0; r < 4; ++r) s[r] += __shfl_xor(s[r], o); }
#pragma unroll
          for (int r = 0; r < 4; ++r) { const float rstd = 1.0f / sqrtf(s[r] * (1.0f / DM) + EPS);
              v2u* o8 = (v2u*)(XN + (size_t)(m0 + r) * DM) + F.lane;
#pragma unroll
              for (int j = 0; j < 4; ++j) { const f32x4 y = v[r][j] * rstd * gv[j]; v2u w; w.x = pk2(y.x, y.y); w.y = pk2(y.z, y.w); o8[64 * j] = w; } } } }
}

__device__ __forceinline__ void p1_tail(Frame& F) {
    LAS float* scr = (LAS float*)(F.lds + F.wave * 16384);
    const int gw = F.bid * NWAVES + F.wave, NGW = F.G * NWAVES;
    const int gt = F.bid * NTHREADS + F.tid, NGT = F.G * NTHREADS;
    int it = gw; f32x4 v[8];
    if (it < I_TAIL) { const WItem w = witem_tail(F, it); witem_load(w, v, F.lane); }
    while (it < I_TAIL) {
        const int nx = it + NGW; f32x4 vn[8];
#pragma unroll
        for (int i = 0; i < 8; ++i) vn[i] = v[i];
        if (nx < I_TAIL) { const WItem wn = witem_tail(F, nx); witem_load(wn, vn, F.lane); }
        { const WItem w = witem_tail(F, it); witem_finish(w, v, scr, F.lane); }
#pragma unroll
        for (int i = 0; i < 8; ++i) v[i] = vn[i];
        it = nx;
    }
    { const float* w = F.in[6]; bf16* o = (bf16*)(F.ws + WS_SGUW);
      for (int i = gt; i < 4 * 128 * 128; i += NGT) { const int t = (i >> 7) & 127, s = i & 127; o[i] = (bf16)f2bf(s <= t ? w[i] : 0.f); } }
}

typedef short s16x4 __attribute__((ext_vector_type(4)));
struct TileRegs { v4u v[4]; };
__device__ __forceinline__ void tile_fetch(TileRegs& t, const bf16* src, int ld, int tid) {
#pragma unroll
    for (int i = 0; i < 4; ++i) { const int c = tid + NTHREADS * i, row = c >> 4, ch = c & 15; t.v[i] = *(const v4u*)(src + (size_t)row * ld + ch * 8); }
}
template <bool SCALE> __device__ __forceinline__ void tile_stage(LAS unsigned char* dst, TileRegs& t, int tid, float lg) {
#pragma unroll
    for (int i = 0; i < 4; ++i) { const int c = tid + NTHREADS * i, row = c >> 4, ch = c & 15;
        if (SCALE) { const float sc = exp2f(lg * (float)(127 - row));
#pragma unroll
            for (int j = 0; j < 4; ++j) t.v[i][j] = pk2(bflo(t.v[i][j]) * sc, bfhi(t.v[i][j]) * sc); }
        *(LAS v4u*)(dst + row * LP + ch * 16) = t.v[i]; }
}
__device__ __forceinline__ bf16x8 frag_row(const LAS unsigned char* T, int r0, int ks, int fr, int fq) { return *(const LAS bf16x8*)(T + (r0 + fr) * LP + (32 * ks + 8 * fq) * 2); }
__device__ __forceinline__ bf16x8 frag_tr(const LAS unsigned char* T, int c0, int ks, int fr, int fq) {
    const LAS unsigned char* a = T + (32 * ks + 8 * fq + (fr >> 2)) * LP + c0 * 2 + 8 * (fr & 3);
    const s16x4 lo = __builtin_bit_cast(s16x4, __builtin_amdgcn_ds_read_tr16_b64_v4i16((LAS s16x4*)a));
    const s16x4 hi = __builtin_bit_cast(s16x4, __builtin_amdgcn_ds_read_tr16_b64_v4i16((LAS s16x4*)(a + 4 * LP)));
    return __builtin_shufflevector(lo, hi, 0, 1, 2, 3, 4, 5, 6, 7);
}
template <bool XTR, bool YTR> __device__ __forceinline__ void mm16(f32x4 (&acc)[8], const LAS unsigned char* X, const LAS unsigned char* Y, int w, int fr, int fq) {
#pragma unroll
    for (int ks = 0; ks < 4; ++ks) {
        const bf16x8 a = XTR ? frag_tr(X, 16 * w, ks, fr, fq) : frag_row(X, 16 * w, ks, fr, fq);
#pragma unroll
        for (int jh = 0; jh < 8; jh += 4) {
            bf16x8 bfr[4];
#pragma unroll
            for (int j = 0; j < 4; ++j) bfr[j] = YTR ? frag_tr(Y, 16 * (jh + j), ks, fr, fq) : frag_row(Y, 16 * (jh + j), ks, fr, fq);
#pragma unroll
            for (int j = 0; j < 4; ++j) acc[jh + j] = __builtin_amdgcn_mfma_f32_16x16x32_bf16(bfr[j], a, acc[jh + j], 0, 0, 0);
            __builtin_amdgcn_sched_barrier(0);
        }
    }
}
__device__ __forceinline__ float head_log2g(int h) { return log2f(1.0f - exp2f(-5.0f - (float)h)); }

struct KvRegs { TileRegs k, v; };
__device__ __forceinline__ void kv_fetch(Frame& F, KvRegs& r, int it) {
    const int bh = it >> 4, n = it & 15; const size_t tok0 = (size_t)(bh >> 2) * SEQ + 128 * n; const bf16* PROJ = (const bf16*)(F.ws + WS_PROJ);
    tile_fetch(r.k, PROJ + tok0 * PROJ_W + 512 + 128 * (bh & 3), PROJ_W, F.tid); tile_fetch(r.v, PROJ + tok0 * PROJ_W + 1024 + 128 * (bh & 3), PROJ_W, F.tid);
}
__device__ __forceinline__ void kv_stage(Frame& F, KvRegs& r, int it) {
    tile_stage<true>(F.lds, r.k, F.tid, head_log2g((it >> 4) & 3)); tile_stage<false>(F.lds + TILE_LDS, r.v, F.tid, 0.f);
}
__device__ __forceinline__ void kv_compute(Frame& F, int it, f32x4 (&acc)[8], bool first) {
    const int bh = it >> 4, n = it & 15; const int w = F.wave, fr = F.lane & 15, fq = F.lane >> 4;
    const float cd = first ? 0.f : exp2f(head_log2g(bh & 3) * 128.0f);
#pragma unroll
    for (int j = 0; j < 8; ++j) acc[j] = acc[j] * cd;
    mm16<true, true>(acc, F.lds + TILE_LDS, F.lds, w, fr, fq);
    bf16* o = (bf16*)(F.ws + WS_KV) + ((size_t)(bh * NCHUNK + n) * 128 + 16 * w + fr) * 128 + 4 * fq;
#pragma unroll
    for (int j = 0; j < 8; ++j) { v2u wv; wv.x = pk2(acc[j][0], acc[j][1]); wv.y = pk2(acc[j][2], acc[j][3]); *(v2u*)(o + 16 * j) = wv; }
}

struct SguRegs { TileRegs wt; v4u sv[4]; v2u up[8]; float bs; };
__device__ __forceinline__ void sgu_fetch(Frame& F, SguRegs& r, int it) {
    const int b = it >> 6, n = (it >> 2) & 15, g = it & 3; const size_t tok0 = (size_t)b * SEQ + 128 * n; const bf16* PROJ = (const bf16*)(F.ws + WS_PROJ);
    tile_fetch(r.wt, (const bf16*)(F.ws + WS_SGUW) + g * 16384, 128, F.tid);
    { const int t = F.tid >> 2, qd = F.tid & 3; const v4u* p = (const v4u*)(PROJ + (tok0 + t) * PROJ_W + 2560 + 128 * g + 32 * qd);
#pragma unroll
      for (int c = 0; c < 4; ++c) r.sv[c] = p[c]; }
    { const int t = 16 * F.wave + (F.lane & 15); const bf16* up = PROJ + (tok0 + t) * PROJ_W + 2048 + 128 * g + 4 * (F.lane >> 4);
#pragma unroll
      for (int j = 0; j < 8; ++j) r.up[j] = *(const v2u*)(up + 16 * j);
      r.bs = F.in[7][128 * g + t]; }
}
__device__ __forceinline__ void sgu_stage(Frame& F, SguRegs& r, int it) {
    const int g = it & 3; LAS unsigned char* vn = F.lds + TILE_LDS;
    tile_stage<false>(F.lds, r.wt, F.tid, 0.f);
    const int t = F.tid >> 2, qd = F.tid & 3;
    float v[32];
#pragma unroll
    for (int c = 0; c < 4; ++c)
#pragma unroll
        for (int j = 0; j < 4; ++j) { v[8 * c + 2 * j] = bflo(r.sv[c][j]); v[8 * c + 2 * j + 1] = bfhi(r.sv[c][j]); }
    float s = 0.f;
#pragma unroll
    for (int i = 0; i < 32; ++i) s += v[i];
    s += __shfl_xor(s, 1); s += __shfl_xor(s, 2);
    const float mu = s * (1.0f / 128.0f); float q = 0.f;
#pragma unroll
    for (int i = 0; i < 32; ++i) { v[i] -= mu; q += v[i] * v[i]; }
    q += __shfl_xor(q, 1); q += __shfl_xor(q, 2);
    const float rstd = 1.0f / sqrtf(q * (1.0f / 128.0f) + EPS);
    const f32x4* lng = (const f32x4*)(F.in[4] + 128 * g + 32 * qd); const f32x4* lnb = (const f32x4*)(F.in[5] + 128 * g + 32 * qd);
#pragma unroll
    for (int c = 0; c < 4; ++c) { const f32x4 g0 = lng[2 * c], g1 = lng[2 * c + 1], b0 = lnb[2 * c], b1 = lnb[2 * c + 1]; v4u o;
        o.x = pk2(v[8 * c + 0] * rstd * g0[0] + b0[0], v[8 * c + 1] * rstd * g0[1] + b0[1]); o.y = pk2(v[8 * c + 2] * rstd * g0[2] + b0[2], v[8 * c + 3] * rstd * g0[3] + b0[3]);
        o.z = pk2(v[8 * c + 4] * rstd * g1[0] + b1[0], v[8 * c + 5] * rstd * g1[1] + b1[1]); o.w = pk2(v[8 * c + 6] * rstd * g1[2] + b1[2], v[8 * c + 7] * rstd * g1[3] + b1[3]);
        *(LAS v4u*)(vn + t * LP + qd * 64 + c * 16) = o; }
}
__device__ __forceinline__ void sgu_compute(Frame& F, const v2u (&upv)[8], float bs, int it) {
    const int b = it >> 6, n = (it >> 2) & 15, g = it & 3; const size_t tok0 = (size_t)b * SEQ + 128 * n;
    const int w = F.wave, fr = F.lane & 15, fq = F.lane >> 4;
    f32x4 acc[8];
#pragma unroll
    for (int j = 0; j < 8; ++j) acc[j] = (f32x4){0.f, 0.f, 0.f, 0.f};
    mm16<false, true>(acc, F.lds, F.lds + TILE_LDS, w, fr, fq);
    const int t = 16 * w + fr;
    bf16* o = (bf16*)(F.ws + WS_MIX) + (tok0 + t) * DM + 512 + 128 * g + 4 * fq;
#pragma unroll
    for (int j = 0; j < 8; ++j) { const v2u uu = upv[j];
        v2u wv; wv.x = pk2(bflo(uu.x) * (acc[j][0] + bs), bfhi(uu.x) * (acc[j][1] + bs)); wv.y = pk2(bflo(uu.y) * (acc[j][2] + bs), bfhi(uu.y) * (acc[j][3] + bs));
        *(v2u*)(o + 16 * j) = wv; }
}
__device__ __forceinline__ void p2_phase(Frame& F) {
    const int k0 = 2 * F.bid, k1 = 2 * F.bid + 1, s0 = F.bid, s1 = F.bid + 256;
    KvRegs kr; SguRegs sr; f32x4 kacc[8];
#pragma unroll
    for (int j = 0; j < 8; ++j) kacc[j] = (f32x4){0.f, 0.f, 0.f, 0.f};
    kv_fetch(F, kr, k0);
    __syncthreads(); kv_stage(F, kr, k0); kv_fetch(F, kr, k1); __syncthreads(); kv_compute(F, k0, kacc, true);
    __syncthreads(); kv_stage(F, kr, k1); sgu_fetch(F, sr, s0); __syncthreads(); kv_compute(F, k1, kacc, false);
    v2u upv[8]; float bs;
    __syncthreads(); sgu_stage(F, sr, s0);
#pragma unroll
    for (int j = 0; j < 8; ++j) upv[j] = sr.up[j];
    bs = sr.bs; sgu_fetch(F, sr, s1); __syncthreads(); sgu_compute(F, upv, bs, s0);
    __syncthreads(); sgu_stage(F, sr, s1); __syncthreads(); sgu_compute(F, sr.up, sr.bs, s1);
}

template <int NB> __device__ __forceinline__ void kv_horner(float (&s)[4][8], const bf16* kv, int slot0, int cnt, float f) {
#pragma unroll 1
    for (int jc = 0; jc < cnt; jc += NB) {
        const bf16* kp = kv + (size_t)(slot0 + 2 * jc) * 16384;
        v4u x[NB][4];
#pragma unroll
        for (int u = 0; u < NB; ++u) if (jc + u < cnt) {
#pragma unroll
            for (int i = 0; i < 4; ++i) x[u][i] = *(const v4u*)(kp + (size_t)u * 32768 + (size_t)(NTHREADS * i) * 8); }
#pragma unroll
        for (int u = 0; u < NB; ++u) if (jc + u < cnt) {
#pragma unroll
            for (int i = 0; i < 4; ++i)
#pragma unroll
                for (int j = 0; j < 4; ++j) { s[i][2 * j] = s[i][2 * j] * f + bflo(x[u][i][j]); s[i][2 * j + 1] = s[i][2 * j + 1] * f + bfhi(x[u][i][j]); } }
    }
}
__device__ __forceinline__ void kv_step1(float (&s)[4][8], const bf16* kv, int slot, bool take, float f) {
    v4u x[4];
#pragma unroll
    for (int i = 0; i < 4; ++i) x[i] = (v4u){0u, 0u, 0u, 0u};
    if (take) {
#pragma unroll
        for (int i = 0; i < 4; ++i) x[i] = *(const v4u*)(kv + (size_t)slot * 16384 + (size_t)(NTHREADS * i) * 8); }
#pragma unroll
    for (int i = 0; i < 4; ++i)
#pragma unroll
        for (int j = 0; j < 4; ++j) { s[i][2 * j] = s[i][2 * j] * f + bflo(x[i][j]); s[i][2 * j + 1] = s[i][2 * j + 1] * f + bfhi(x[i][j]); }
}
__device__ __forceinline__ void ret_pair(Frame& F, int bh, int n_small) {
    const int b = bh >> 2, h = bh & 3;
    const bf16* PROJ = (const bf16*)(F.ws + WS_PROJ);
    LAS unsigned char* Qs = F.lds; LAS unsigned char* Ks = F.lds + TILE_LDS; LAS unsigned char* Vs = F.lds + 2 * TILE_LDS; LAS unsigned char* St = F.lds + 3 * TILE_LDS;
    const float lg = head_log2g(h); const float cd = exp2f(lg * 128.0f);
    const int w = F.wave, fr = F.lane & 15, fq = F.lane >> 4; const int q = 16 * w + fr;
    const int n_big = 15 - n_small;
    v4u sb[4]; TileRegs tq, tk, tv;
    { const size_t tok0 = (size_t)b * SEQ + 128 * n_small;
      tile_fetch(tq, PROJ + tok0 * PROJ_W + 128 * h, PROJ_W, F.tid); tile_fetch(tk, PROJ + tok0 * PROJ_W + 512 + 128 * h, PROJ_W, F.tid); tile_fetch(tv, PROJ + tok0 * PROJ_W + 1024 + 128 * h, PROJ_W, F.tid); }
    __syncthreads();
    { const bf16* kv = (const bf16*)(F.ws + WS_KV) + (size_t)bh * NCHUNK * 16384 + (size_t)F.tid * 8;
      float s[4][8];
#pragma unroll
      for (int i = 0; i < 4; ++i)
#pragma unroll
          for (int j = 0; j < 8; ++j) s[i][j] = 0.f;
      const int a = n_small >> 1; const bool odd = (n_small & 1) != 0; const float cd2 = cd * cd;
      kv_horner<4>(s, kv, 1, a, cd2);
      { v4u x[4];
#pragma unroll
        for (int i = 0; i < 4; ++i) x[i] = (v4u){0u, 0u, 0u, 0u};
        if (odd) {
#pragma unroll
            for (int i = 0; i < 4; ++i) x[i] = *(const v4u*)(kv + (size_t)(2 * a) * 16384 + (size_t)(NTHREADS * i) * 8); }
        const float f1 = odd ? cd : 1.0f;
        if (n_small > 0) {
#pragma unroll
            for (int i = 0; i < 4; ++i) { const int c = F.tid + NTHREADS * i, e = c >> 4, ch = c & 15; v4u o;
#pragma unroll
                for (int j = 0; j < 4; ++j) o[j] = pk2(s[i][2 * j] * f1 + bflo(x[i][j]), s[i][2 * j + 1] * f1 + bfhi(x[i][j]));
                *(LAS v4u*)(St + e * LP + ch * 16) = o; } } }
      kv_horner<4>(s, kv, 2 * a + 1, 7 - 2 * a, cd2);
      kv_step1(s, kv, 14 - 2 * a, !odd, odd ? 1.0f : cd);
#pragma unroll
      for (int i = 0; i < 4; ++i) { sb[i].x = pk2(s[i][0], s[i][1]); sb[i].y = pk2(s[i][2], s[i][3]); sb[i].z = pk2(s[i][4], s[i][5]); sb[i].w = pk2(s[i][6], s[i][7]); }
    }
#pragma unroll 1
    for (int pass = 0; pass < 2; ++pass) {
        const int n = pass == 0 ? n_small : n_big; const size_t tok0 = (size_t)b * SEQ + 128 * n;
        int opq = 0; asm volatile("" : "+v"(opq));
        if (pass == 1) { __syncthreads();
#pragma unroll
            for (int i = 0; i < 4; ++i) { const int c = F.tid + NTHREADS * i, e = c >> 4, ch = c & 15; *(LAS v4u*)(St + e * LP + ch * 16) = sb[i]; } }
        if (pass == 1) { tile_fetch(tq, PROJ + tok0 * PROJ_W + 128 * h, PROJ_W, F.tid); tile_fetch(tk, PROJ + tok0 * PROJ_W + 512 + 128 * h, PROJ_W, F.tid); tile_fetch(tv, PROJ + tok0 * PROJ_W + 1024 + 128 * h, PROJ_W, F.tid); }
        tile_stage<false>(Qs, tq, F.tid, 0.f); tile_stage<false>(Ks, tk, F.tid, 0.f); tile_stage<false>(Vs, tv, F.tid, 0.f);
        v2u gg[8]; const bf16* gp = PROJ + (tok0 + q) * PROJ_W + 1536 + 128 * h + 4 * fq;
#pragma unroll
        for (int j = 0; j < 8; ++j) gg[j] = *(const v2u*)(gp + 16 * j);
        __syncthreads();
        f32x4 sc[8], oc[8];
#pragma unroll
        for (int j = 0; j < 8; ++j) { sc[j] = (f32x4){0.f, 0.f, 0.f, 0.f}; oc[j] = (f32x4){0.f, 0.f, 0.f, 0.f}; }
        mm16<false, false>(sc, Qs, Ks, w, fr, fq);
        if (n > 0) { mm16<false, false>(oc, Qs, St, w, fr, fq); const float qd = exp2f(lg * (float)(q + 1 + opq));
#pragma unroll
            for (int j = 0; j < 8; ++j) oc[j] = oc[j] * qd; }
#pragma unroll
        for (int j = 0; j < 8; ++j) { float pv[4];
#pragma unroll
            for (int i = 0; i < 4; ++i) { const int k = 16 * j + 4 * fq + i; pv[i] = (q >= k) ? sc[j][i] * exp2f(lg * (float)(q - k + opq)) : 0.f; }
            v2u wv; wv.x = pk2(pv[0], pv[1]); wv.y = pk2(pv[2], pv[3]); *(LAS v2u*)(Qs + q * LP + (16 * j + 4 * fq) * 2) = wv; }
        asm volatile("s_waitcnt lgkmcnt(0)" ::: "memory");
        mm16<false, true>(oc, Qs, Vs, w, fr, fq);
        float ss = 0.f;
#pragma unroll
        for (int j = 0; j < 8; ++j) ss += (oc[j][0] * oc[j][0] + oc[j][1] * oc[j][1]) + (oc[j][2] * oc[j][2] + oc[j][3] * oc[j][3]);
        ss += __shfl_xor(ss, 16); ss += __shfl_xor(ss, 32);
        const float rstd = 1.0f / sqrtf(ss * (1.0f / 128.0f) + EPS);
        const float* rg = F.in[3] + 128 * h + 4 * fq + opq;
        bf16* o = (bf16*)(F.ws + WS_MIX) + (tok0 + q) * DM + 128 * h + 4 * fq;
#pragma unroll
        for (int j = 0; j < 8; ++j) { const f32x4 rgv = *(const f32x4*)(rg + 16 * j);
            v2u wv; wv.x = pk2(oc[j][0] * rstd * rgv[0] * bflo(gg[j].x), oc[j][1] * rstd * rgv[1] * bfhi(gg[j].x));
            wv.y = pk2(oc[j][2] * rstd * rgv[2] * bflo(gg[j].y), oc[j][3] * rstd * rgv[3] * bfhi(gg[j].y));
            *(v2u*)(o + 16 * j) = wv; }
    }
}

#define XB_TMO      128
#define XB_XCNT(j)  (256  + 64 * (j))
#define XB_XSUB(j)  (1280 + 64 * (j))
#define XB_XGEN(j)  (2304 + 64 * (j))
#define XB_TOP      3328
#define XB_TOPGEN   3392
#define XCD_BAR_WORDS 3456
#define XB_SPIN_CAP (1u << 18)
__device__ __forceinline__ unsigned xb_ld(unsigned* p)              { return __hip_atomic_load(p, __ATOMIC_RELAXED, __HIP_MEMORY_SCOPE_AGENT); }
__device__ __forceinline__ unsigned xb_add(unsigned* p, unsigned v) { return __hip_atomic_fetch_add(p, v, __ATOMIC_RELAXED, __HIP_MEMORY_SCOPE_AGENT); }
__device__ __forceinline__ unsigned xb_xcc_id() { return (unsigned)__builtin_amdgcn_s_getreg((3 << 11) | 20) & 0xFu; }
#define XB_SPIN(cond, bar) do { unsigned _sp = 0; while (cond) { __builtin_amdgcn_s_sleep(1); \
    if ((++_sp & 255u) == 0u) { if (xb_ld(&(bar)[XB_TMO])) break; if (_sp > XB_SPIN_CAP) { atomicAdd(&(bar)[XB_TMO], 1u); break; } } } } while (0)
struct XcdBarrier { unsigned* bar; unsigned x; volatile LAS unsigned* st; };
__device__ __forceinline__ XcdBarrier xcd_barrier_post(unsigned* bar, volatile LAS unsigned* st) {
    XcdBarrier b; b.bar = bar; b.x = xb_xcc_id(); b.st = st;
    if (threadIdx.x == 0) (void)xb_add(&bar[XB_XCNT(b.x)], 1u);
    return b;
}
__device__ __forceinline__ void xcd_barrier_complete(unsigned* bar, unsigned x, unsigned& nloc, unsigned& nx) {
    const unsigned G = gridDim.x * gridDim.y * gridDim.z;
    unsigned sum, cnt, mine, sp = 0u;
    for (;;) {
        sum = 0u; cnt = 0u; mine = 0u;
#pragma unroll
        for (unsigned j = 0; j < 16; ++j) { const unsigned c = xb_ld(&bar[XB_XCNT(j)]); sum += c; cnt += (c > 0u) ? 1u : 0u; mine = (j == x) ? c : mine; }
        if (sum == G) break;
        __builtin_amdgcn_s_sleep(1);
        if ((++sp & 255u) == 0u) { if (xb_ld(&bar[XB_TMO])) break; if (sp > XB_SPIN_CAP) { atomicAdd(&bar[XB_TMO], 1u); break; } }
    }
    nloc = mine > 0u ? mine : 1u; nx = cnt > 0u ? cnt : 1u;
}
__device__ __forceinline__ void xcd_barrier(const XcdBarrier& b) {
    asm volatile("s_waitcnt vmcnt(0)" ::: "memory");
    __syncthreads();
    if (threadIdx.x == 0) {
        unsigned* bar = b.bar;
        __builtin_amdgcn_s_waitcnt(0);
        unsigned nloc = b.st[0], nx = b.st[1];
        if (nloc == 0u) { xcd_barrier_complete(bar, b.x, nloc, nx); b.st[0] = nloc; b.st[1] = nx; }
        const unsigned old = xb_add(&bar[XB_XSUB(b.x)], 1u);
        const unsigned gen = old / nloc;
        if (old + 1u == (gen + 1u) * nloc) {
            __builtin_amdgcn_fence(__ATOMIC_RELEASE, "agent");
            asm volatile("s_waitcnt vmcnt(0)" ::: "memory");
            const unsigned og = xb_add(&bar[XB_TOP], 1u);
            const unsigned tg = og / nx;
            if (og + 1u == (tg + 1u) * nx) xb_add(&bar[XB_TOPGEN], 1u);
            else XB_SPIN(xb_ld(&bar[XB_TOPGEN]) == tg, bar);
            __builtin_amdgcn_fence(__ATOMIC_ACQUIRE, "agent");
            xb_add(&bar[XB_XGEN(b.x)], 1u);
            asm volatile("s_waitcnt vmcnt(0)" ::: "memory");
        } else {
            XB_SPIN(xb_ld(&bar[XB_XGEN(b.x)]) == gen, bar);
            __builtin_amdgcn_fence(__ATOMIC_ACQUIRE, "agent");
            asm volatile("s_waitcnt vmcnt(0)" ::: "memory");
        }
    }
    __syncthreads();
}

struct Args { const float* in[15]; float* out; unsigned char* ws; int ph_lo, ph_hi; };
constexpr int NPHASE = 7;
__global__ void __launch_bounds__(NTHREADS, 2) fwd_megakernel(Args args) {
    extern __shared__ __attribute__((aligned(16))) unsigned char lds[];
    Frame F;
    F.lds = (LAS unsigned char*)lds; F.ws = args.ws;
    F.tid = threadIdx.x; F.lane = F.tid & 63; F.wave = __builtin_amdgcn_readfirstlane(F.tid >> 6);
    F.G = gridDim.x; F.bid = blockIdx.x;
#pragma unroll
    for (int i = 0; i < 15; ++i) F.in[i] = args.in[i];
    F.out = args.out;
    const int lo = args.ph_lo, hi = args.ph_hi;
    volatile LAS unsigned* MISC = (volatile LAS unsigned*)(F.lds + MISC_OFF);
    if (F.tid < 16) MISC[F.tid] = 0u;
    __syncthreads();
    XcdBarrier bar; bar.bar = (unsigned*)(F.ws + WS_BAR); bar.x = 0; bar.st = nullptr;
    if (hi - lo > 1) bar = xcd_barrier_post((unsigned*)(F.ws + WS_BAR), MISC);
    if (lo < 0) cg::this_grid().sync();
#define IN(k) (lo <= (k) && (k) < hi)
#if MK_CGSYNC
#define SEAM(k) do { if (IN(k) && IN((k) + 1)) cg::this_grid().sync(); } while (0)
#else
#define SEAM(k) do { if (IN(k) && IN((k) + 1)) xcd_barrier(bar); } while (0)
#endif
#if MK_SPIN >= 0
    unsigned long long t0_ = 0;
#define PH_BEGIN(k) do { if ((k) == MK_SPIN) t0_ = __builtin_amdgcn_s_memrealtime(); } while (0)
#define PH_END(k) do { if ((k) == MK_SPIN) { asm volatile("s_waitcnt vmcnt(0)" ::: "memory"); const unsigned long long t1_ = __builtin_amdgcn_s_memrealtime(); while (__builtin_amdgcn_s_memrealtime() - t1_ < (t1_ - t0_)) __builtin_amdgcn_s_sleep(8); } } while (0)
#else
#define PH_BEGIN(k) do {} while (0)
#define PH_END(k) do {} while (0)
#endif

    PH_BEGIN(0);
    if (IN(0)) p0_prologue(F);
    PH_END(0);
    SEAM(0);
    PH_BEGIN(1);
    if (IN(1)) {
        pg8::Gemm g{(const bf16*)(F.ws + WS_XN), (const bf16*)(F.ws + WS_WIN), M, PROJ_W, DM}; pg8::StaticOrder S; S.init(M, PROJ_W, F.G, F.bid);
        pg8::EpiProj E{(bf16*)(F.ws + WS_PROJ), (const float*)(F.ws + WS_ROPE)};
        pg8::gemm_phase<pg8::EpiProj, pg8::StaticOrder, true, true>(F.lds, g, S, E);
        p1_tail(F);
    }
    PH_END(1);
    SEAM(1);
    PH_BEGIN(2);
    if (IN(2)) p2_phase(F);
    PH_END(2);
    SEAM(2);
    PH_BEGIN(3);
    if (IN(3)) {
        for (int it = F.bid; it < 256; it += F.G) ret_pair(F, it >> 3, it & 7);
        __syncthreads();
    }
    PH_END(3);
    SEAM(3);
    PH_BEGIN(4);
    if (IN(4)) {
        pg8::Gemm g{(const bf16*)(F.ws + WS_MIX), (const bf16*)(F.ws + WS_WOUT), M, DM, DM}; pg8::StaticOrder S; S.init(M, DM, F.G, F.bid);
        pg8::EpiRes<true> E{F.in[0], F.out, (bf16*)(F.ws + WS_XN), F.in[9], (float*)(F.ws + WS_SSQ1)};
        pg8::gemm_phase<pg8::EpiRes<true>, pg8::StaticOrder, false, true>(F.lds, g, S, E);
    }
    PH_END(4);
    SEAM(4);
    PH_BEGIN(5);
    if (IN(5)) {
        pg8::Gemm g{(const bf16*)(F.ws + WS_XN), (const bf16*)(F.ws + WS_WUP), M, UPW, DM}; pg8::StaticOrder S; S.init(M, UPW, F.G, F.bid);
        pg8::EpiConv E{(const float*)(F.ws + WS_SSQ1), F.in[11], F.in[12], (bf16*)(F.ws + WS_ACT), (float*)(F.ws + WS_EDGE)};
        pg8::gemm_phase<pg8::EpiConv, pg8::StaticOrder, true, true>(F.lds, g, S, E);
    }
    PH_END(5);
    SEAM(5);
    PH_BEGIN(6);
    if (IN(6)) {
        pg8::Gemm g{(const bf16*)(F.ws + WS_ACT), (const bf16*)(F.ws + WS_WDOWN), M, DM, DFF}; pg8::StaticOrder S; S.init(M, DM, F.G, F.bid);
        pg8::Unit u0;
        if (S.next(0, u0)) {
            const float* edge = (const float*)(F.ws + WS_EDGE); const float* cw = F.in[11]; const float* cb = F.in[12]; bf16* act = (bf16*)(F.ws + WS_ACT);
            for (int i = F.tid; i < 2 * (DFF / 4); i += NTHREADS) { const int rl = i >= (DFF / 4) ? 1 : 0; const int run = 2 * u0.pm + rl, c = 4 * (i - rl * (DFF / 4));
                const float* e = edge + (size_t)run * 4 * UPW; const bool first = (run & 15) == 0;
                f32x4 y0[2], y1[2];
#pragma unroll
                for (int hb = 0; hb < 2; ++hb) { const int cc = c + hb * DFF; const f32x4 z = (f32x4){0.f, 0.f, 0.f, 0.f};
                    const f32x4 f0 = *(const f32x4*)(e + cc), f1 = *(const f32x4*)(e + UPW + cc);
                    const f32x4 p2 = first ? z : *(const f32x4*)(e + cc - 2 * UPW), p1 = first ? z : *(const f32x4*)(e + cc - UPW);
                    const f32x4 w0 = *(const f32x4*)(cw + cc), w1 = *(const f32x4*)(cw + UPW + cc), w2 = *(const f32x4*)(cw + 2 * UPW + cc), bb = *(const f32x4*)(cb + cc);
                    y0[hb] = w2 * f0 + w1 * p1 + w0 * p2 + bb; y1[hb] = w2 * f1 + w1 * f0 + w0 * p1 + bb; }
                *(v2u*)(act + (size_t)(128 * run) * DFF + c) = (v2u){pk2(pg8::silu_f(y0[0][0]) * y0[1][0], pg8::silu_f(y0[0][1]) * y0[1][1]), pk2(pg8::silu_f(y0[0][2]) * y0[1][2], pg8::silu_f(y0[0][3]) * y0[1][3])};
                *(v2u*)(act + (size_t)(128 * run + 1) * DFF + c) = (v2u){pk2(pg8::silu_f(y1[0][0]) * y1[1][0], pg8::silu_f(y1[0][1]) * y1[1][1]), pk2(pg8::silu_f(y1[0][2]) * y1[1][2], pg8::silu_f(y1[0][3]) * y1[1][3])}; }
            asm volatile("s_waitcnt vmcnt(0)" ::: "memory");
            __syncthreads();
        }
        pg8::EpiFinal E{(const bf16*)(F.ws + WS_XN), F.in[9], F.out, F.in[14], (float*)(F.ws + WS_SSQ2), (unsigned*)(F.ws + WS_PCNT)};
        pg8::gemm_phase<pg8::EpiFinal, pg8::StaticOrder, true, true>(F.lds, g, S, E);
    }
    PH_END(6);
#undef IN
#undef SEAM
}

extern "C" void kernel_launch(void* const* d_in, const int* in_sizes, int n_in, void* d_out, int out_size, void* d_ws, size_t ws_size, hipStream_t stream) {
    static int grid = 0;
    if (grid == 0) {
        if (n_in != 15 || out_size != M * DM || ws_size < WS_END) { fprintf(stderr, "kernel_launch: unexpected shapes (n_in %d out %d ws %zu)\n", n_in, out_size, ws_size); grid = -1; return; }
        if (hipFuncSetAttribute((const void*)fwd_megakernel, hipFuncAttributeMaxDynamicSharedMemorySize, LDS_BYTES) != hipSuccess) { fprintf(stderr, "kernel_launch: hipFuncSetAttribute failed\n"); grid = -1; return; }
        int dev = 0, cus = 0, per_cu = 0;
        (void)hipGetDevice(&dev); (void)hipDeviceGetAttribute(&cus, hipDeviceAttributeMultiprocessorCount, dev);
        (void)hipOccupancyMaxActiveBlocksPerMultiprocessor(&per_cu, (const void*)fwd_megakernel, NTHREADS, LDS_BYTES);
        (void)hipGetLastError();
        if (per_cu < 1) per_cu = 1;
        grid = cus > 0 ? cus : 256;
    }
    if (grid < 0) return;
    Args a{};
    for (int i = 0; i < 15; ++i) a.in[i] = (const float*)d_in[i];
    a.out = (float*)d_out; a.ws = (unsigned char*)d_ws;
    if (hipMemsetAsync((char*)d_ws + WS_BAR, 0, WS_BAR_BYTES, stream) != hipSuccess) { fprintf(stderr, "kernel_launch: memset failed\n"); return; }
#if MK_MULTI
    for (int p = 0; p < NPHASE; ++p) { a.ph_lo = p; a.ph_hi = p + 1; const int reps = ((MK_REPMASK >> p) & 1) ? 2 : 1;
        for (int r = 0; r < reps; ++r) hipLaunchKernelGGL(fwd_megakernel, dim3(grid), dim3(NTHREADS), LDS_BYTES, stream, a); }
#else
    a.ph_lo = 0; a.ph_hi = NPHASE;
    void* kargs[] = {&a};
    hipError_t e = hipLaunchCooperativeKernel((const void*)fwd_megakernel, dim3(grid), dim3(NTHREADS), kargs, LDS_BYTES, stream);
    if (e != hipSuccess) fprintf(stderr, "cooperative launch failed: %s (grid %d)\n", hipGetErrorString(e), grid);
#endif
}
```

```cpp
#include <hip/hip_runtime.h>
#include <hip/hip_cooperative_groups.h>
#include <cstdio>
#include <cstdint>
namespace cg = cooperative_groups;

namespace pg8 {
#define PG8_LAS __attribute__((address_space(3)))
typedef unsigned short bf16_t;
typedef short bf16x8 __attribute__((ext_vector_type(8)));
typedef float f32x4 __attribute__((ext_vector_type(4)));
typedef float f32x2 __attribute__((ext_vector_type(2)));
typedef unsigned u32x4 __attribute__((ext_vector_type(4)));
typedef unsigned u32x2 __attribute__((ext_vector_type(2)));
constexpr int BM = 256, BK = 64, HALF = 128, HTB = HALF * BK * 2  , STAGE_BYTES = 8 * HTB, NXCD = 8, WGM = 8;

__host__ __device__ __forceinline__ int lds_byte(int r, int c) { const int st = (r >> 4) * 2 + (c >> 5), rr = r & 15, cc = c & 31, ob = rr * 64 + cc * 2; return st * 1024 + (ob ^ (((ob >> 9) & 1) << 5)); }
__host__ __device__ __forceinline__ void stage_rc(int b, int& R, int& C) { const int st = b / 1024, sb = b % 1024, swz = sb ^ (((sb >> 9) & 1) << 5); R = (st >> 1) * 16 + swz / 64; C = (st & 1) * 32 + (swz % 64) / 2; }
__host__ __device__ __forceinline__ int perm32(int rho) { const int n = rho >> 4, i = rho & 15; return 8 * (i >> 2) + 4 * n + (i & 3); }
__host__ __device__ __forceinline__ int tokrow(int R) { return 128 * (R >> 6) + 8 * (R & 15) + ((R >> 4) & 3); }

struct Unit { int pm, pn; };
struct Gemm { const bf16_t* A; const bf16_t* Bt; int M, N, K; };

struct StaticOrder {
    int nM, nN, nwg, G, c;
    __host__ __device__ void init(int M, int N, int G_, int c_) { nM = M / BM; nN = N / BM; nwg = nM * nN; G = G_; c = c_; }
    __host__ __device__ bool next(int i, Unit& u) const {
        const long L = (long)i * G + c; if (L >= nwg) return false;
        int wgid = (int)L; { const int q = nwg / NXCD, r = nwg % NXCD, xcd = wgid % NXCD, off = wgid / NXCD; wgid = (xcd < r ? xcd * (q + 1) : r * (q + 1) + (xcd - r) * q) + off; }
        const int nig = WGM * nN, gid = wgid / nig, fm = gid * WGM, gsz = (nM - fm) < WGM ? (nM - fm) : WGM;
        u.pm = fm + ((wgid % nig) % gsz); u.pn = (wgid % nig) / gsz; return true;
    }
    __device__ __forceinline__ void a_ready(const Unit&) const {}
    __device__ __forceinline__ void done(const Unit&) const {}
};

__device__ __forceinline__ unsigned cvt_pk_bf16(float lo, float hi) { unsigned r; asm volatile("v_cvt_pk_bf16_f32 %0, %1, %2" : "=v"(r) : "v"(lo), "v"(hi)); return r; }
__device__ __forceinline__ f32x2 gelu_pk(f32x2 v) {
    const f32x2 av = __builtin_elementwise_abs(v), d = av * 0.2316418882f + 1.0f;
    f32x2 t; t.x = __builtin_amdgcn_rcpf(d.x); t.y = __builtin_amdgcn_rcpf(d.y);
    f32x2 q = t * 0.5307027145f + (-0.7265760135f); q = q * t + 0.7107068705f; q = q * t + (-0.142248368f); q = q * t + 0.127414796f; q = q * t;
    const f32x2 s = (v * v) * (-0.72134752044f);
    f32x2 e; e.x = __builtin_amdgcn_exp2f(s.x); e.y = __builtin_amdgcn_exp2f(s.y);
    const f32x2 m = v * (q * e), r = v - m;
    f32x2 o; o.x = v.x < 0.f ? m.x : r.x; o.y = v.y < 0.f ? m.y : r.y; return o;
}
__device__ __forceinline__ float silu_f(float v) { return v * __builtin_amdgcn_rcpf(1.f + __builtin_amdgcn_exp2f(-1.4426950408889634f * v)); }
__device__ __forceinline__ f32x4 silu4(f32x4 v) { return (f32x4){silu_f(v[0]), silu_f(v[1]), silu_f(v[2]), silu_f(v[3])}; }
__device__ __forceinline__ f32x4 gelu4(f32x4 v) { const f32x2 a = gelu_pk((f32x2){v[0], v[1]}), b = gelu_pk((f32x2){v[2], v[3]}); return (f32x4){a.x, a.y, b.x, b.y}; }
__device__ __forceinline__ u32x2 pack4(f32x4 v) { u32x2 w; w.x = cvt_pk_bf16(v[0], v[1]); w.y = cvt_pk_bf16(v[2], v[3]); return w; }

constexpr int PROJ_W = 3072, DM = 1024, DFF = 2816, UPW = 5632, SEQ = 2048;
constexpr float EPS = 1e-6f;

struct EpiProj {
    static constexpr bool PERM = true, AFTER_DRAIN = false, AROWPERM = false;
    bf16_t* O; const float* rope; const float* ssq0;
    __device__ __forceinline__ void operator()(const f32x4 (&acc)[2][2][4][2], const Unit& u, int wr, int wc, int fr, int fq) const {
        const int row0 = u.pm * BM + wr * 64 + fr; const int type = u.pn >> 1;
        if (type < 2) {
            const float sc = (type == 1) ? 0.08838834764831845f : 1.0f; const int pp = 16 * wc + 4 * fq;
#pragma unroll
            for (int ai = 0; ai < 2; ++ai)
#pragma unroll
                for (int m = 0; m < 4; ++m) { const int row = row0 + ai * HALF + m * 16; const int pos = row & (SEQ - 1);
                    const float rs = __builtin_amdgcn_rsqf(ssq0[row] * (1.0f / DM) + EPS) * sc;
                    const f32x4 c = *(const f32x4*)(rope + pos * 128 + pp) * rs, s = *(const f32x4*)(rope + pos * 128 + 64 + pp) * rs;
#pragma unroll
                    for (int bj = 0; bj < 2; ++bj) { const f32x4 x1 = acc[ai][bj][m][0], x2 = acc[ai][bj][m][1];
                        const f32x4 o1 = x1 * c - x2 * s, o2 = x2 * c + x1 * s;
                        bf16_t* p = O + (size_t)row * PROJ_W + u.pn * BM + bj * HALF + pp;
                        *(u32x2*)p = pack4(o1); *(u32x2*)(p + 64) = pack4(o2); } }
        } else {
            const int col0 = u.pn * BM + wc * 32 + 8 * fq;
#pragma unroll
            for (int ai = 0; ai < 2; ++ai)
#pragma unroll
                for (int m = 0; m < 4; ++m) { const int row = row0 + ai * HALF + m * 16; bf16_t* rowp = O + (size_t)row * PROJ_W + col0;
                    const float rs = __builtin_amdgcn_rsqf(ssq0[row] * (1.0f / DM) + EPS);
#pragma unroll
                    for (int bj = 0; bj < 2; ++bj) { f32x4 v0 = acc[ai][bj][m][0] * rs, v1 = acc[ai][bj][m][1] * rs;
                        if (type == 3) { v0 = silu4(v0); v1 = silu4(v1); } else if (type >= 4) { v0 = gelu4(v0); v1 = gelu4(v1); }
                        const u32x2 a = pack4(v0), b = pack4(v1); u32x4 w; w.x = a.x; w.y = a.y; w.z = b.x; w.w = b.y;
                        *(u32x4*)(rowp + bj * HALF) = w; } }
        }
    }
};

template <bool WRITE_XG> struct EpiRes {
    static constexpr bool PERM = false, AFTER_DRAIN = false, AROWPERM = false;
    const bf16_t* base; float* out; bf16_t* xg; const float* gain; float* ssq;
    __device__ __forceinline__ void operator()(const f32x4 (&acc)[2][2][4][2], const Unit& u, int wr, int wc, int fr, int fq) const {
        const int col0 = u.pn * BM + wc * 32 + 4 * fq;
        f32x4 gv[2][2];
#pragma unroll
        for (int bj = 0; bj < 2; ++bj)
#pragma unroll
            for (int n = 0; n < 2; ++n) gv[bj][n] = WRITE_XG ? *(const f32x4*)(gain + col0 + bj * HALF + n * 16) : (f32x4){0.f, 0.f, 0.f, 0.f};
#pragma unroll
        for (int ai = 0; ai < 2; ++ai)
#pragma unroll
            for (int m = 0; m < 4; ++m) { const int row = u.pm * BM + ai * HALF + wr * 64 + m * 16 + fr; const size_t off = (size_t)row * DM + col0; float s = 0.f;
#pragma unroll
                for (int bj = 0; bj < 2; ++bj)
#pragma unroll
                    for (int n = 0; n < 2; ++n) { const u32x2 xb = *(const u32x2*)(base + off + bj * HALF + n * 16);
                        const f32x4 x1 = (f32x4){__uint_as_float(xb.x << 16), __uint_as_float(xb.x & 0xffff0000u), __uint_as_float(xb.y << 16), __uint_as_float(xb.y & 0xffff0000u)} + acc[ai][bj][m][n];
                        if (!WRITE_XG) *(f32x4*)(out + off + bj * HALF + n * 16) = x1; s += (x1[0] * x1[0] + x1[1] * x1[1]) + (x1[2] * x1[2] + x1[3] * x1[3]);
                        if (WRITE_XG) *(u32x2*)(xg + off + bj * HALF + n * 16) = pack4(x1 * gv[bj][n]); }
                s += __shfl_xor(s, 16); s += __shfl_xor(s, 32);
                if (fq == 0) (void)__hip_atomic_fetch_add(ssq + row, s, __ATOMIC_RELAXED, __HIP_MEMORY_SCOPE_AGENT);
                if (m == 3) asm volatile("" ::: "memory"); }
    }
};

struct EpiFinal {
    static constexpr bool PERM = false, AFTER_DRAIN = false, AROWPERM = false;
    const bf16_t* xg; const float* gffn; float* out; const float* gain; float* ssq; unsigned* cnt;
    __device__ __forceinline__ void operator()(f32x4 (&acc)[2][2][4][2], const Unit& u, int wr, int wc, int fr, int fq) const {
        const int col0 = u.pn * BM + wc * 32 + 4 * fq;
        f32x4 gi[2][2];
#pragma unroll
        for (int bj = 0; bj < 2; ++bj)
#pragma unroll
            for (int n = 0; n < 2; ++n) { const f32x4 gf = *(const f32x4*)(gffn + col0 + bj * HALF + n * 16); gi[bj][n] = (f32x4){1.0f / gf[0], 1.0f / gf[1], 1.0f / gf[2], 1.0f / gf[3]}; }
#pragma unroll
        for (int ai = 0; ai < 2; ++ai)
#pragma unroll
            for (int m = 0; m < 4; ++m) { const int row = u.pm * BM + ai * HALF + wr * 64 + m * 16 + fr; const size_t off = (size_t)row * DM + col0; float s = 0.f;
#pragma unroll
                for (int bj = 0; bj < 2; ++bj)
#pragma unroll
                    for (int n = 0; n < 2; ++n) { const u32x2 xb = *(const u32x2*)(xg + off + bj * HALF + n * 16);
                        const f32x4 x1 = (f32x4){__uint_as_float(xb.x << 16), __uint_as_float(xb.x & 0xffff0000u), __uint_as_float(xb.y << 16), __uint_as_float(xb.y & 0xffff0000u)} * gi[bj][n];
                        const f32x4 x2 = x1 + acc[ai][bj][m][n];
                        acc[ai][bj][m][n] = x2; s += (x2[0] * x2[0] + x2[1] * x2[1]) + (x2[2] * x2[2] + x2[3] * x2[3]); }
                s += __shfl_xor(s, 16); s += __shfl_xor(s, 32);
                if (fq == 0) (void)__hip_atomic_fetch_add(ssq + row, s, __ATOMIC_RELAXED, __HIP_MEMORY_SCOPE_AGENT);
                if (m == 3) asm volatile("" ::: "memory"); }
        asm volatile("s_waitcnt vmcnt(0)" ::: "memory");
        unsigned* c = cnt + 64 * u.pm;
        if ((threadIdx.x & 63) == 0) (void)__hip_atomic_fetch_add(c, 1u, __ATOMIC_RELAXED, __HIP_MEMORY_SCOPE_AGENT);
        { unsigned sp = 0;
          while ((unsigned)__builtin_amdgcn_readfirstlane(__hip_atomic_load(c, __ATOMIC_RELAXED, __HIP_MEMORY_SCOPE_AGENT)) < 32u) { __builtin_amdgcn_s_sleep(2); if (++sp > (1u << 22)) break; } }
        __builtin_amdgcn_fence(__ATOMIC_ACQUIRE, "agent");
        f32x4 gv[2][2];
#pragma unroll
        for (int bj = 0; bj < 2; ++bj)
#pragma unroll
            for (int n = 0; n < 2; ++n) gv[bj][n] = *(const f32x4*)(gain + col0 + bj * HALF + n * 16);
#pragma unroll
        for (int ai = 0; ai < 2; ++ai)
#pragma unroll
            for (int m = 0; m < 4; ++m) { const int row = u.pm * BM + ai * HALF + wr * 64 + m * 16 + fr; const size_t off = (size_t)row * DM + col0;
                const float tot = __hip_atomic_load(ssq + row, __ATOMIC_RELAXED, __HIP_MEMORY_SCOPE_AGENT);
                const float rstd = __builtin_amdgcn_rsqf(tot * (1.0f / DM) + EPS);
#pragma unroll
                for (int bj = 0; bj < 2; ++bj)
#pragma unroll
                    for (int n = 0; n < 2; ++n) *(f32x4*)(out + off + bj * HALF + n * 16) = acc[ai][bj][m][n] * rstd * gv[bj][n]; }
    }
};

__device__ __forceinline__ float dpp_shr1(float v) { return __int_as_float(__builtin_amdgcn_update_dpp(0, __float_as_int(v), 0x111, 0xf, 0xf, true)); }
__device__ __forceinline__ f32x4 dpp_shr1_4(f32x4 v) { return (f32x4){dpp_shr1(v[0]), dpp_shr1(v[1]), dpp_shr1(v[2]), dpp_shr1(v[3])}; }
struct EpiConv {
    static constexpr bool PERM = true, AFTER_DRAIN = false, AROWPERM = true;
    const float* ssq; const float* cw; const float* cb; bf16_t* act; float* edge;
    __device__ __forceinline__ void operator()(const f32x4 (&acc)[2][2][4][2], const Unit& u, int wr, int wc, int fr, int fq) const {
        const int run = u.pm * 2 + wr; const int tok0 = u.pm * BM + wr * HALF + 8 * fr;
        float rstd[8];
        { const f32x4 s0 = *(const f32x4*)(ssq + tok0), s1 = *(const f32x4*)(ssq + tok0 + 4);
#pragma unroll
          for (int i = 0; i < 4; ++i) { rstd[i] = __builtin_amdgcn_rsqf(s0[i] * (1.0f / DM) + EPS); rstd[4 + i] = __builtin_amdgcn_rsqf(s1[i] * (1.0f / DM) + EPS); } }
        u32x2 pk0[8];
#pragma unroll
        for (int n = 0; n < 2; ++n) {
            const int ca = u.pn * HALF + wc * 32 + 8 * fq + 4 * n;
            const f32x4 w0a = *(const f32x4*)(cw + ca), w1a = *(const f32x4*)(cw + UPW + ca), w2a = *(const f32x4*)(cw + 2 * UPW + ca), ba = *(const f32x4*)(cb + ca);
            const f32x4 w0b = *(const f32x4*)(cw + DFF + ca), w1b = *(const f32x4*)(cw + UPW + DFF + ca), w2b = *(const f32x4*)(cw + 2 * UPW + DFF + ca), bb = *(const f32x4*)(cb + DFF + ca);
            f32x4 ua[8], ub[8];
#pragma unroll
            for (int t = 0; t < 8; ++t) { ua[t] = acc[t >> 2][0][t & 3][n] * rstd[t]; ub[t] = acc[t >> 2][1][t & 3][n] * rstd[t]; }
            const f32x4 pa1 = dpp_shr1_4(ua[7]), pa2 = dpp_shr1_4(ua[6]), pb1 = dpp_shr1_4(ub[7]), pb2 = dpp_shr1_4(ub[6]);
            if (fr == 0) { float* e = edge + (size_t)run * 4 * UPW; *(f32x4*)(e + ca) = ua[0]; *(f32x4*)(e + UPW + ca) = ua[1]; *(f32x4*)(e + DFF + ca) = ub[0]; *(f32x4*)(e + UPW + DFF + ca) = ub[1]; }
            if (fr == 15) { float* e = edge + (size_t)run * 4 * UPW + 2 * UPW; *(f32x4*)(e + ca) = ua[6]; *(f32x4*)(e + UPW + ca) = ua[7]; *(f32x4*)(e + DFF + ca) = ub[6]; *(f32x4*)(e + UPW + DFF + ca) = ub[7]; }
#pragma unroll
            for (int t = 0; t < 8; ++t) {
                const f32x4 am1 = (t >= 1) ? ua[t >= 1 ? t - 1 : 0] : pa1, am2 = (t >= 2) ? ua[t >= 2 ? t - 2 : 0] : (t == 1 ? pa1 : pa2);
                const f32x4 bm1 = (t >= 1) ? ub[t >= 1 ? t - 1 : 0] : pb1, bm2 = (t >= 2) ? ub[t >= 2 ? t - 2 : 0] : (t == 1 ? pb1 : pb2);
                const f32x4 ya = w2a * ua[t] + w1a * am1 + w0a * am2 + ba, yb = w2b * ub[t] + w1b * bm1 + w0b * bm2 + bb;
                const u32x2 pk = pack4(silu4(ya) * yb);
                if (n == 0) pk0[t] = pk;
                else if (!(fr == 0 && t < 2)) { u32x4 w; w.x = pk0[t].x; w.y = pk0[t].y; w.z = pk.x; w.w = pk.y;
                    *(u32x4*)(act + (size_t)(tok0 + t) * DFF + u.pn * HALF + wc * 32 + 8 * fq) = w; }
            }
        }
    }
};
template <class Epi, class Sched, bool ALIGN_EPI = false, bool SP2 = false>
__device__ __forceinline__ void gemm_phase(PG8_LAS unsigned char* lds, const Gemm g, const Sched& S, const Epi& E) {
    const int tid = threadIdx.x, wid = __builtin_amdgcn_readfirstlane(tid >> 6), lane = tid & 63, wr = wid >> 2, wc = wid & 3, fr = lane & 15, fq = lane >> 4;
    const int K = g.K, nt = K / BK;
    unsigned voffA[2], voffB[2];
#pragma unroll
    for (int i = 0; i < 2; ++i) { int R, C; stage_rc(tid * 16 + i * 8192, R, C); const int Rb = Epi::PERM ? ((R & ~31) + perm32(R & 31)) : R;
        voffA[i] = (unsigned)((Epi::AROWPERM ? tokrow(R) : R) * K + C) * 2u; voffB[i] = (unsigned)(Rb * K + C) * 2u; }
    const size_t kstep = (size_t)(BK * 2);
    const size_t hstepB = (size_t)HALF * K * 2; const size_t hstepA = Epi::AROWPERM ? (size_t)4 * K * 2 : hstepB;
    const size_t tstep = 2 * hstepB;
    const unsigned ldsw = (unsigned)wid * 1024u;
    const int aoff = lds_byte(wr * 64 + fr, fq * 8), boff = lds_byte(wc * 32 + fr, fq * 8);
#define PG8_SA(b, h) (((b) * 2 + (h)) * HTB)
#define PG8_SB(b, h) ((4 + (b) * 2 + (h)) * HTB)
#define PG8_STAGE(bufoff, gbase, voff) do { _Pragma("unroll") for (int _i = 0; _i < 2; ++_i) \
        __builtin_amdgcn_global_load_lds((const unsigned*)((const char*)(gbase) + (voff)[_i]), (PG8_LAS unsigned*)(lds + (bufoff) + ldsw + _i * 8192), 16, 0, 0); } while (0)
#define PG8_LDA(dst, b, h) do { _Pragma("unroll") for (int m = 0; m < 4; ++m) _Pragma("unroll") for (int k = 0; k < 2; ++k) dst[m][k] = *(const PG8_LAS bf16x8*)(lds + PG8_SA(b, h) + aoff + m * 2048 + k * 1024); } while (0)
#define PG8_LDB(dst, b, h) do { _Pragma("unroll") for (int n = 0; n < 2; ++n) _Pragma("unroll") for (int k = 0; k < 2; ++k) dst[n][k] = *(const PG8_LAS bf16x8*)(lds + PG8_SB(b, h) + boff + n * 2048 + k * 1024); } while (0)
#define PG8_MMA(ai, bj, At, Bt) do { __builtin_amdgcn_s_setprio(1); _Pragma("unroll") for (int m = 0; m < 4; ++m) _Pragma("unroll") for (int n = 0; n < 2; ++n) _Pragma("unroll") for (int k = 0; k < 2; ++k) \
        acc[ai][bj][m][n] = __builtin_amdgcn_mfma_f32_16x16x32_bf16(Bt[n][k], At[m][k], acc[ai][bj][m][n], 0, 0, 0); __builtin_amdgcn_s_setprio(0); } while (0)
#define PG8_WAIT_V(n) asm volatile("s_waitcnt vmcnt(" #n ")" ::: "memory")
#define PG8_WAIT_L(n) asm volatile("s_waitcnt lgkmcnt(" #n ")" ::: "memory")
#define PG8_BAR __builtin_amdgcn_s_barrier()
#define PG8_SCHED __builtin_amdgcn_sched_barrier(0)
    Unit cur, nxt; int ui = 0;
    if (!S.next(0, cur)) return;
    f32x4 acc[2][2][4][2];
#pragma unroll
    for (int a = 0; a < 2; ++a)
#pragma unroll
        for (int b = 0; b < 2; ++b)
#pragma unroll
            for (int m = 0; m < 4; ++m)
#pragma unroll
                for (int n = 0; n < 2; ++n) acc[a][b][m][n] = (f32x4){0.f, 0.f, 0.f, 0.f};
    bf16x8 At[4][2], B0[2][2], B1[2][2];
    const char* cA = (const char*)g.A + (size_t)cur.pm * tstep; const char* cB = (const char*)g.Bt + (size_t)cur.pn * tstep;
    S.a_ready(cur);
    if constexpr (SP2) {
        PG8_STAGE(PG8_SB(0, 0), cB, voffB); PG8_STAGE(PG8_SB(0, 1), cB + hstepB, voffB); PG8_STAGE(PG8_SA(0, 0), cA, voffA); PG8_STAGE(PG8_SA(0, 1), cA + hstepA, voffA);
        if (wr == 1) PG8_BAR;
        PG8_WAIT_V(2); PG8_BAR;
        PG8_STAGE(PG8_SB(1, 0), cB + kstep, voffB); PG8_STAGE(PG8_SA(1, 0), cA + kstep, voffA); PG8_STAGE(PG8_SB(1, 1), cB + hstepB + kstep, voffB);
        PG8_WAIT_V(6); PG8_BAR;
    } else {
        PG8_STAGE(PG8_SB(0, 0), cB, voffB); PG8_STAGE(PG8_SA(0, 0), cA, voffA); PG8_STAGE(PG8_SB(0, 1), cB + hstepB, voffB); PG8_STAGE(PG8_SA(0, 1), cA + hstepA, voffA);
        if (wr == 1) PG8_BAR;
        PG8_WAIT_V(4); PG8_BAR;
        PG8_STAGE(PG8_SB(1, 0), cB + kstep, voffB); PG8_STAGE(PG8_SA(1, 0), cA + kstep, voffA); PG8_STAGE(PG8_SB(1, 1), cB + hstepB + kstep, voffB);
        PG8_WAIT_V(6); PG8_BAR;
    }
    for (;;) {
        const bool has_next = S.next(ui + 1, nxt);
        const char* nA = has_next ? (const char*)g.A + (size_t)nxt.pm * tstep : cA; const char* nB = has_next ? (const char*)g.Bt + (size_t)nxt.pn * tstep : cB;
        for (int t = 0; t < nt; t += 2) {
            const bool last = (t == nt - 2);
            const char* a1 = cA + (size_t)(t + 1) * kstep;
            const char* a2 = last ? nA : cA + (size_t)(t + 2) * kstep; const char* b2 = last ? nB : cB + (size_t)(t + 2) * kstep;
            const char* a3 = a2 + kstep; const char* b3 = b2 + kstep;
            if (last && has_next) S.a_ready(nxt);
            if constexpr (SP2) {
            PG8_LDB(B0, 0, 0); PG8_LDB(B1, 0, 1); PG8_SCHED; PG8_LDA(At, 0, 0); PG8_STAGE(PG8_SA(1, 1), a1 + hstepA, voffA);
            PG8_WAIT_V(8); PG8_WAIT_L(0); PG8_BAR; PG8_MMA(0, 0, At, B0); PG8_MMA(0, 1, At, B1); PG8_BAR; PG8_SCHED;
            PG8_LDA(At, 0, 1); PG8_STAGE(PG8_SB(0, 0), b2, voffB); PG8_STAGE(PG8_SB(0, 1), b2 + hstepB, voffB); PG8_STAGE(PG8_SA(0, 0), a2, voffA);
            PG8_WAIT_V(8); PG8_WAIT_L(0); PG8_BAR; PG8_MMA(1, 0, At, B0); PG8_MMA(1, 1, At, B1); PG8_BAR; PG8_SCHED;
            PG8_LDB(B0, 1, 0); PG8_LDB(B1, 1, 1); PG8_SCHED; PG8_LDA(At, 1, 0); PG8_STAGE(PG8_SA(0, 1), a2 + hstepA, voffA);
            PG8_WAIT_V(8); PG8_WAIT_L(0); PG8_BAR; PG8_MMA(0, 0, At, B0); PG8_MMA(0, 1, At, B1); PG8_BAR; PG8_SCHED;
            PG8_LDA(At, 1, 1); PG8_STAGE(PG8_SB(1, 0), b3, voffB); PG8_STAGE(PG8_SB(1, 1), b3 + hstepB, voffB); PG8_STAGE(PG8_SA(1, 0), a3, voffA);
            PG8_WAIT_V(8); PG8_WAIT_L(0); PG8_BAR; PG8_MMA(1, 0, At, B0); PG8_MMA(1, 1, At, B1); PG8_BAR; PG8_SCHED;
            } else {
            PG8_LDB(B0, 0, 0); PG8_SCHED; PG8_LDA(At, 0, 0); PG8_STAGE(PG8_SA(1, 1), a1 + hstepA, voffA);
            PG8_WAIT_L(8); PG8_BAR; PG8_WAIT_L(0); PG8_MMA(0, 0, At, B0); PG8_BAR; PG8_SCHED;
            PG8_LDB(B1, 0, 1); PG8_STAGE(PG8_SB(0, 0), b2, voffB);
            PG8_BAR; PG8_WAIT_L(0); PG8_MMA(0, 1, At, B1); PG8_BAR;
            PG8_LDA(At, 0, 1); PG8_STAGE(PG8_SA(0, 0), a2, voffA);
            PG8_BAR; PG8_WAIT_L(0); PG8_MMA(1, 0, At, B0); PG8_BAR; PG8_SCHED;
            PG8_STAGE(PG8_SB(0, 1), b2 + hstepB, voffB);
            PG8_WAIT_V(6); PG8_BAR; PG8_MMA(1, 1, At, B1); PG8_BAR;
            PG8_LDB(B0, 1, 0); PG8_SCHED; PG8_LDA(At, 1, 0); PG8_STAGE(PG8_SA(0, 1), a2 + hstepA, voffA);
            PG8_WAIT_L(8); PG8_BAR; PG8_WAIT_L(0); PG8_MMA(0, 0, At, B0); PG8_BAR; PG8_SCHED;
            PG8_LDB(B1, 1, 1); PG8_STAGE(PG8_SB(1, 0), b3, voffB);
            PG8_BAR; PG8_WAIT_L(0); PG8_MMA(0, 1, At, B1); PG8_BAR;
            PG8_LDA(At, 1, 1); PG8_STAGE(PG8_SA(1, 0), a3, voffA);
            PG8_BAR; PG8_WAIT_L(0); PG8_MMA(1, 0, At, B0); PG8_BAR; PG8_SCHED;
            PG8_STAGE(PG8_SB(1, 1), b3 + hstepB, voffB);
            PG8_WAIT_V(6); PG8_BAR; PG8_MMA(1, 1, At, B1); PG8_BAR;
            }
        }
        if constexpr (ALIGN_EPI) { if (wr == 0) PG8_BAR; }
        if constexpr (!Epi::AFTER_DRAIN) { E(acc, cur, wr, wc, fr, fq); S.done(cur); }
        if (!has_next) break;
#pragma unroll
        for (int a = 0; a < 2; ++a)
#pragma unroll
            for (int b = 0; b < 2; ++b)
#pragma unroll
                for (int m = 0; m < 4; ++m)
#pragma unroll
                    for (int n = 0; n < 2; ++n) acc[a][b][m][n] = (f32x4){0.f, 0.f, 0.f, 0.f};
        cur = nxt; cA = nA; cB = nB; ++ui;
        if constexpr (ALIGN_EPI) { if (wr == 1) PG8_BAR; }
    }
    PG8_WAIT_V(0);
    if constexpr (!ALIGN_EPI) { if (wr == 0) PG8_BAR; }
    PG8_BAR;
    if constexpr (Epi::AFTER_DRAIN) { E.fused(acc, cur, wr, wc, fr, fq, lds, wid, lane); S.done(cur); }
#undef PG8_SA
#undef PG8_SB
#undef PG8_STAGE
#undef PG8_LDA
#undef PG8_LDB
#undef PG8_MMA
#undef PG8_WAIT_V
#undef PG8_WAIT_L
#undef PG8_BAR
#undef PG8_SCHED
}
}
#ifndef MK_MULTI
#define MK_MULTI 0
#endif
#ifndef MK_SPIN
#define MK_SPIN -1
#endif
#ifndef MK_CGSYNC
#define MK_CGSYNC 0
#endif
#ifndef MK_REPMASK
#define MK_REPMASK 0
#endif

constexpr int NWAVES = 8, NTHREADS = 512;
constexpr int BATCH = 8, SEQ = 2048, DM = 1024, M = BATCH * SEQ, PROJ_W = 3072, DFF = 2816, UPW = 5632, NCHUNK = 16;
constexpr float EPS = 1e-6f;
constexpr size_t MiB = 1u << 20;
constexpr size_t WS_SSQ1 = 0, WS_SSQ2 = 65536, WS_SSQ0 = 262144, WS_BAR = 131072, WS_BAR_BYTES = 32768, WS_PCNT = 131072 + 16384, WS_ROPE = 1 * MiB, WS_SGUW = 2 * MiB, WS_WIN = 3 * MiB, WS_WOUT = 9 * MiB, WS_WUP = 11 * MiB, WS_WDOWN = 22 * MiB,
                 WS_EDGE = 28 * MiB, WS_XN = 40 * MiB, WS_PROJ = 72 * MiB, WS_MIX = 168 * MiB, WS_KV = 200 * MiB, WS_ACT = 72 * MiB, WS_END = 216 * MiB;
constexpr int LDS_BYTES = 147456, MISC_OFF = 147456 - 64;
constexpr int LP = 272;
constexpr int TILE_LDS = 128 * LP;

#define LAS __attribute__((address_space(3)))
typedef unsigned short bf16;
typedef unsigned v4u __attribute__((ext_vector_type(4)));
typedef unsigned v2u __attribute__((ext_vector_type(2)));
typedef float f32x4 __attribute__((ext_vector_type(4)));
typedef short bf16x8 __attribute__((ext_vector_type(8)));
__device__ __forceinline__ unsigned f2bf(float f) { unsigned u = __builtin_bit_cast(unsigned, f); return (u + 0x7fffu + ((u >> 16) & 1u)) >> 16; }
__device__ __forceinline__ unsigned pk2(float lo, float hi) { return f2bf(lo) | (f2bf(hi) << 16); }
__device__ __forceinline__ float bflo(unsigned w) { return __uint_as_float(w << 16); }
__device__ __forceinline__ float bfhi(unsigned w) { return __uint_as_float(w & 0xffff0000u); }
__device__ __forceinline__ float wave_sum(float v) {
#pragma unroll
    for (int o = 1; o < 64; o <<= 1) v += __shfl_xor(v, o);
    return v;
}

struct Frame {
    LAS unsigned char* lds; unsigned char* ws;
    int tid, lane, wave, G, bid;
    const float* in[15]; float* out;
};

__device__ __forceinline__ int dest_row(int map, int n) {
    if (map == 1) { if (n >= 1024) return n; const int d = n & 127; return (n & ~127) + 32 * ((d >> 4) & 3) + 8 * ((d >> 2) & 3) + 4 * (d >> 6) + (d & 3); }
    if (map == 2) { return n < DFF ? 256 * (n >> 7) + (n & 127) : 256 * ((n - DFF) >> 7) + 128 + ((n - DFF) & 127); }
    return n;
}
struct WItem { const float* W; bf16* WT; const float* kg; int K, N, map, item; };
__device__ __forceinline__ WItem witem_in(Frame& F, int it) { WItem w; w.W = F.in[2]; w.WT = (bf16*)(F.ws + WS_WIN); w.kg = F.in[1]; w.K = DM; w.N = PROJ_W; w.map = 1; w.item = it; return w; }
constexpr int I_IN = (DM / 64) * (PROJ_W / 32), I_OUT = (DM / 64) * (DM / 32), I_UP = (DM / 64) * (UPW / 32), I_DN = (DFF / 64) * (DM / 32), I_TAIL = I_OUT + I_UP + I_DN;
__device__ __forceinline__ WItem witem_tail(Frame& F, int it) {
    WItem w; w.kg = nullptr; int r = it;
    if (r < I_OUT) { w.W = F.in[8]; w.WT = (bf16*)(F.ws + WS_WOUT); w.K = DM; w.N = DM; w.map = 0; w.item = r; return w; } r -= I_OUT;
    if (r < I_UP) { w.W = F.in[10]; w.WT = (bf16*)(F.ws + WS_WUP); w.K = DM; w.N = UPW; w.map = 2; w.item = r; return w; } r -= I_UP;
    w.W = F.in[13]; w.WT = (bf16*)(F.ws + WS_WDOWN); w.K = DFF; w.N = DM; w.map = 0; w.item = r; return w;
}
__device__ __forceinline__ void witem_load(const WItem& w, f32x4 (&v)[8], int lane) {
    const int nblk = w.N / 32, kb = w.item / nblk, nb = w.item % nblk;
    const float* p = w.W + (size_t)(64 * kb + (lane >> 3)) * w.N + 32 * nb + 4 * (lane & 7);
#pragma unroll
    for (int i = 0; i < 8; ++i) v[i] = *(const f32x4*)(p + (size_t)(8 * i) * w.N);
}
__device__ __forceinline__ void witem_finish(const WItem& w, const f32x4 (&v)[8], LAS float* scr, int lane) {
    const int nblk = w.N / 32, kb = w.item / nblk, nb = w.item % nblk, k0 = 64 * kb, n0 = 32 * nb;
#pragma unroll
    for (int i = 0; i < 8; ++i) { LAS float* d = scr + (8 * i + (lane >> 3)) * 33 + 4 * (lane & 7); d[0] = v[i].x; d[1] = v[i].y; d[2] = v[i].z; d[3] = v[i].w; }
    asm volatile("s_waitcnt lgkmcnt(0)" ::: "memory");
    const int c = lane & 7;
    f32x4 g0 = (f32x4){1.f, 1.f, 1.f, 1.f}, g1 = g0;
    if (w.kg) { g0 = *(const f32x4*)(w.kg + k0 + 8 * c); g1 = *(const f32x4*)(w.kg + k0 + 8 * c + 4); }
#pragma unroll
    for (int j = 0; j < 4; ++j) { const int n = (lane >> 3) + 8 * j; const LAS float* s = scr + (8 * c) * 33 + n;
        v4u o; o.x = pk2(s[0 * 33] * g0[0], s[1 * 33] * g0[1]); o.y = pk2(s[2 * 33] * g0[2], s[3 * 33] * g0[3]); o.z = pk2(s[4 * 33] * g1[0], s[5 * 33] * g1[1]); o.w = pk2(s[6 * 33] * g1[2], s[7 * 33] * g1[3]);
        *(v4u*)(w.WT + (size_t)dest_row(w.map, n0 + n) * w.K + k0 + 8 * c) = o; }
    asm volatile("s_waitcnt lgkmcnt(0)" ::: "memory");
}

__device__ __forceinline__ void p0_prologue(Frame& F) {
    LAS float* scr = (LAS float*)(F.lds + F.wave * 16384);
    const int gw = F.bid * NWAVES + F.wave, NGW = F.G * NWAVES;
    const int gt = F.bid * NTHREADS + F.tid, NGT = F.G * NTHREADS;
    for (int it = gw; it < I_IN; it += NGW) { const WItem w = witem_in(F, it); f32x4 v[8]; witem_load(w, v, F.lane); witem_finish(w, v, scr, F.lane); }
    { float* rope = (float*)(F.ws + WS_ROPE);
      for (int i = gt; i < SEQ * 64; i += NGT) { const int pos = i >> 6, f = i & 63;
          const float inv = exp2f(-(float)f * (13.287712379549449f / 64.0f));
          const float ang = (float)pos * inv;
          double t = (double)ang * 0.15915494309189535; t -= rint(t); const float rv = (float)t;
          rope[pos * 128 + f] = __builtin_amdgcn_cosf(rv); rope[pos * 128 + 64 + f] = __builtin_amdgcn_sinf(rv); } }
    { float* z = (float*)(F.ws + WS_SSQ1); for (int i = gt; i < 2 * M; i += NGT) z[i] = 0.f; }
    { bf16* XB = (bf16*)(F.ws + WS_XN); float* ssq0 = (float*)(F.ws + WS_SSQ0);
      for (int m0 = gw * 4; m0 < M; m0 += NGW * 4) {
          f32x4 v[4][4]; float s[4];
#pragma unroll
          for (int r = 0; r < 4; ++r) { const f32x4* xr = (const f32x4*)(F.in[0] + (size_t)(m0 + r) * DM) + F.lane;
#pragma unroll
              for (int j = 0; j < 4; ++j) v[r][j] = xr[64 * j]; }
#pragma unroll
          for (int r = 0; r < 4; ++r) { s[r] = 0.f; v2u* o8 = (v2u*)(XB + (size_t)(m0 + r) * DM) + F.lane;
#pragma unroll
              for (int j = 0; j < 4; ++j) { const f32x4 y = v[r][j]; s[r] += (y.x * y.x + y.y * y.y) + (y.z * y.z + y.w * y.w); v2u w; w.x = pk2(y.x, y.y); w.y = pk2(y.z, y.w); o8[64 * j] = w; } }
#pragma unroll
          for (int o = 1; o < 64; o <<= 1) {
#pragma unroll
              for (int r = 0; r < 4; ++r) s[r] += __shfl_xor(s[r], o); }
          if (F.lane < 4) ssq0[m0 + F.lane] = F.lane == 0 ? s[0] : F.lane == 1 ? s[1] : F.lane == 2 ? s[2] : s[3]; } }
}

__device__ __forceinline__ void p1_tail(Frame& F) {
    LAS float* scr = (LAS float*)(F.lds + F.wave * 16384);
    const int gw = F.bid * NWAVES + F.wave, NGW = F.G * NWAVES;
    const int gt = F.bid * NTHREADS + F.tid, NGT = F.G * NTHREADS;
    int it = gw; f32x4 v[8];
    if (it < I_TAIL) { const WItem w = witem_tail(F, it); witem_load(w, v, F.lane); }
    while (it < I_TAIL) {
        const int nx = it + NGW; f32x4 vn[8];
#pragma unroll
        for (int i = 0; i < 8; ++i) vn[i] = v[i];
        if (nx < I_TAIL) { const WItem wn = witem_tail(F, nx); witem_load(wn, vn, F.lane); }
        { const WItem w = witem_tail(F, it); witem_finish(w, v, scr, F.lane); }
#pragma unroll
        for (int i = 0; i < 8; ++i) v[i] = vn[i];
        it = nx;
    }
    { const float* w = F.in[6]; bf16* o = (bf16*)(F.ws + WS_SGUW);
      for (int i = gt; i < 4 * 128 * 128; i += NGT) { const int t = (i >> 7) & 127, s = i & 127; o[i] = (bf16)f2bf(s <= t ? w[i] : 0.f); } }
}

typedef short s16x4 __attribute__((ext_vector_type(4)));
struct TileRegs { v4u v[4]; };
__device__ __forceinline__ void tile_fetch(TileRegs& t, const bf16* src, int ld, int tid) {
#pragma unroll
    for (int i = 0; i < 4; ++i) { const int c = tid + NTHREADS * i, row = c >> 4, ch = c & 15; t.v[i] = *(const v4u*)(src + (size_t)row * ld + ch * 8); }
}
template <bool SCALE> __device__ __forceinline__ void tile_stage(LAS unsigned char* dst, TileRegs& t, int tid, float lg) {
#pragma unroll
    for (int i = 0; i < 4; ++i) { const int c = tid + NTHREADS * i, row = c >> 4, ch = c & 15;
        if (SCALE) { const float sc = exp2f(lg * (float)(127 - row));
#pragma unroll
            for (int j = 0; j < 4; ++j) t.v[i][j] = pk2(bflo(t.v[i][j]) * sc, bfhi(t.v[i][j]) * sc); }
        *(LAS v4u*)(dst + row * LP + ch * 16) = t.v[i]; }
}
__device__ __forceinline__ bf16x8 frag_row(const LAS unsigned char* T, int r0, int ks, int fr, int fq) { return *(const LAS bf16x8*)(T + (r0 + fr) * LP + (32 * ks + 8 * fq) * 2); }
__device__ __forceinline__ bf16x8 frag_tr(const LAS unsigned char* T, int c0, int ks, int fr, int fq) {
    const LAS unsigned char* a = T + (32 * ks + 8 * fq + (fr >> 2)) * LP + c0 * 2 + 8 * (fr & 3);
    const s16x4 lo = __builtin_bit_cast(s16x4, __builtin_amdgcn_ds_read_tr16_b64_v4i16((LAS s16x4*)a));
    const s16x4 hi = __builtin_bit_cast(s16x4, __builtin_amdgcn_ds_read_tr16_b64_v4i16((LAS s16x4*)(a + 4 * LP)));
    return __builtin_shufflevector(lo, hi, 0, 1, 2, 3, 4, 5, 6, 7);
}
template <bool XTR, bool YTR> __device__ __forceinline__ void mm16(f32x4 (&acc)[8], const LAS unsigned char* X, const LAS unsigned char* Y, int w, int fr, int fq) {
#pragma unroll
    for (int ks = 0; ks < 4; ++ks) {
        const bf16x8 a = XTR ? frag_tr(X, 16 * w, ks, fr, fq) : frag_row(X, 16 * w, ks, fr, fq);
#pragma unroll
        for (int jh = 0; jh < 8; jh += 4) {
            bf16x8 bfr[4];
#pragma unroll
            for (int j = 0; j < 4; ++j) bfr[j] = YTR ? frag_tr(Y, 16 * (jh + j), ks, fr, fq) : frag_row(Y, 16 * (jh + j), ks, fr, fq);
#pragma unroll
            for (int j = 0; j < 4; ++j) acc[jh + j] = __builtin_amdgcn_mfma_f32_16x16x32_bf16(bfr[j], a, acc[jh + j], 0, 0, 0);
            __builtin_amdgcn_sched_barrier(0);
        }
    }
}
__device__ __forceinline__ float head_log2g(int h) { return log2f(1.0f - exp2f(-5.0f - (float)h)); }

struct KvRegs { TileRegs k, v; };
__device__ __forceinline__ void kv_fetch(Frame& F, KvRegs& r, int it) {
    const int bh = it >> 4, n = it & 15; const size_t tok0 = (size_t)(bh >> 2) * SEQ + 128 * n; const bf16* PROJ = (const bf16*)(F.ws + WS_PROJ);
    tile_fetch(r.k, PROJ + tok0 * PROJ_W + 512 + 128 * (bh & 3), PROJ_W, F.tid); tile_fetch(r.v, PROJ + tok0 * PROJ_W + 1024 + 128 * (bh & 3), PROJ_W, F.tid);
}
__device__ __forceinline__ void kv_stage(Frame& F, KvRegs& r, int it) {
    tile_stage<true>(F.lds, r.k, F.tid, head_log2g((it >> 4) & 3)); tile_stage<false>(F.lds + TILE_LDS, r.v, F.tid, 0.f);
}
__device__ __forceinline__ void kv_compute(Frame& F, int it, f32x4 (&acc)[8], bool first) {
    const int bh = it >> 4, n = it & 15; const int w = F.wave, fr = F.lane & 15, fq = F.lane >> 4;
    const float cd = first ? 0.f : exp2f(head_log2g(bh & 3) * 128.0f);
#pragma unroll
    for (int j = 0; j < 8; ++j) acc[j] = acc[j] * cd;
    mm16<true, true>(acc, F.lds + TILE_LDS, F.lds, w, fr, fq);
    bf16* o = (bf16*)(F.ws + WS_KV) + ((size_t)(bh * NCHUNK + n) * 128 + 16 * w + fr) * 128 + 4 * fq;
#pragma unroll
    for (int j = 0; j < 8; ++j) { v2u wv; wv.x = pk2(acc[j][0], acc[j][1]); wv.y = pk2(acc[j][2], acc[j][3]); *(v2u*)(o + 16 * j) = wv; }
}

struct SguRegs { TileRegs wt; v4u sv[4]; v2u up[8]; float bs; };
__device__ __forceinline__ void sgu_fetch(Frame& F, SguRegs& r, int it) {
    const int b = it >> 6, n = (it >> 2) & 15, g = it & 3; const size_t tok0 = (size_t)b * SEQ + 128 * n; const bf16* PROJ = (const bf16*)(F.ws + WS_PROJ);
    tile_fetch(r.wt, (const bf16*)(F.ws + WS_SGUW) + g * 16384, 128, F.tid);
    { const int t = F.tid >> 2, qd = F.tid & 3; const v4u* p = (const v4u*)(PROJ + (tok0 + t) * PROJ_W + 2560 + 128 * g + 32 * qd);
#pragma unroll
      for (int c = 0; c < 4; ++c) r.sv[c] = p[c]; }
    { const int t = 16 * F.wave + (F.lane & 15); const bf16* up = PROJ + (tok0 + t) * PROJ_W + 2048 + 128 * g + 4 * (F.lane >> 4);
#pragma unroll
      for (int j = 0; j < 8; ++j) r.up[j] = *(const v2u*)(up + 16 * j);
      r.bs = F.in[7][128 * g + t]; }
}
__device__ __forceinline__ void sgu_stage(Frame& F, SguRegs& r, int it) {
    const int g = it & 3; LAS unsigned char* vn = F.lds + TILE_LDS;
    tile_stage<false>(F.lds, r.wt, F.tid, 0.f);
    const int t = F.tid >> 2, qd = F.tid & 3;
    float v[32];
#pragma unroll
    for (int c = 0; c < 4; ++c)
#pragma unroll
        for (int j = 0; j < 4; ++j) { v[8 * c + 2 * j] = bflo(r.sv[c][j]); v[8 * c + 2 * j + 1] = bfhi(r.sv[c][j]); }
    float s = 0.f;
#pragma unroll
    for (int i = 0; i < 32; ++i) s += v[i];
    s += __shfl_xor(s, 1); s += __shfl_xor(s, 2);
    const float mu = s * (1.0f / 128.0f); float q = 0.f;
#pragma unroll
    for (int i = 0; i < 32; ++i) { v[i] -= mu; q += v[i] * v[i]; }
    q += __shfl_xor(q, 1); q += __shfl_xor(q, 2);
    const float rstd = 1.0f / sqrtf(q * (1.0f / 128.0f) + EPS);
    const f32x4* lng = (const f32x4*)(F.in[4] + 128 * g + 32 * qd); const f32x4* lnb = (const f32x4*)(F.in[5] + 128 * g + 32 * qd);
#pragma unroll
    for (int c = 0; c < 4; ++c) { const f32x4 g0 = lng[2 * c], g1 = lng[2 * c + 1], b0 = lnb[2 * c], b1 = lnb[2 * c + 1]; v4u o;
        o.x = pk2(v[8 * c + 0] * rstd * g0[0] + b0[0], v[8 * c + 1] * rstd * g0[1] + b0[1]); o.y = pk2(v[8 * c + 2] * rstd * g0[2] + b0[2], v[8 * c + 3] * rstd * g0[3] + b0[3]);
        o.z = pk2(v[8 * c + 4] * rstd * g1[0] + b1[0], v[8 * c + 5] * rstd * g1[1] + b1[1]); o.w = pk2(v[8 * c + 6] * rstd * g1[2] + b1[2], v[8 * c + 7] * rstd * g1[3] + b1[3]);
        *(LAS v4u*)(vn + t * LP + qd * 64 + c * 16) = o; }
}
__device__ __forceinline__ void sgu_compute(Frame& F, const v2u (&upv)[8], float bs, int it) {
    const int b = it >> 6, n = (it >> 2) & 15, g = it & 3; const size_t tok0 = (size_t)b * SEQ + 128 * n;
    const int w = F.wave, fr = F.lane & 15, fq = F.lane >> 4;
    f32x4 acc[8];
#pragma unroll
    for (int j = 0; j < 8; ++j) acc[j] = (f32x4){0.f, 0.f, 0.f, 0.f};
    mm16<false, true>(acc, F.lds, F.lds + TILE_LDS, w, fr, fq);
    const int t = 16 * w + fr;
    bf16* o = (bf16*)(F.ws + WS_MIX) + (tok0 + t) * DM + 512 + 128 * g + 4 * fq;
#pragma unroll
    for (int j = 0; j < 8; ++j) { const v2u uu = upv[j];
        v2u wv; wv.x = pk2(bflo(uu.x) * (acc[j][0] + bs), bfhi(uu.x) * (acc[j][1] + bs)); wv.y = pk2(bflo(uu.y) * (acc[j][2] + bs), bfhi(uu.y) * (acc[j][3] + bs));
        *(v2u*)(o + 16 * j) = wv; }
}
__device__ __forceinline__ void p2_phase(Frame& F) {
    const int k0 = 2 * F.bid, k1 = 2 * F.bid + 1, s0 = F.bid, s1 = F.bid + 256;
    KvRegs kr; SguRegs sr; f32x4 kacc[8];
#pragma unroll
    for (int j = 0; j < 8; ++j) kacc[j] = (f32x4){0.f, 0.f, 0.f, 0.f};
    kv_fetch(F, kr, k0);
    __syncthreads(); kv_stage(F, kr, k0); kv_fetch(F, kr, k1); __syncthreads(); kv_compute(F, k0, kacc, true);
    __syncthreads(); kv_stage(F, kr, k1); sgu_fetch(F, sr, s0); __syncthreads(); kv_compute(F, k1, kacc, false);
    v2u upv[8]; float bs;
    __syncthreads(); sgu_stage(F, sr, s0);
#pragma unroll
    for (int j = 0; j < 8; ++j) upv[j] = sr.up[j];
    bs = sr.bs; sgu_fetch(F, sr, s1); __syncthreads(); sgu_compute(F, upv, bs, s0);
    __syncthreads(); sgu_stage(F, sr, s1); __syncthreads(); sgu_compute(F, sr.up, sr.bs, s1);
}

template <int NB> __device__ __forceinline__ void kv_horner(float (&s)[4][8], const bf16* kv, int slot0, int cnt, float f) {
#pragma unroll 1
    for (int jc = 0; jc < cnt; jc += NB) {
        const bf16* kp = kv + (size_t)(slot0 + 2 * jc) * 16384;
        v4u x[NB][4];
#pragma unroll
        for (int u = 0; u < NB; ++u) if (jc + u < cnt) {
#pragma unroll
            for (int i = 0; i < 4; ++i) x[u][i] = *(const v4u*)(kp + (size_t)u * 32768 + (size_t)(NTHREADS * i) * 8); }
#pragma unroll
        for (int u = 0; u < NB; ++u) if (jc + u < cnt) {
#pragma unroll
            for (int i = 0; i < 4; ++i)
#pragma unroll
                for (int j = 0; j < 4; ++j) { s[i][2 * j] = s[i][2 * j] * f + bflo(x[u][i][j]); s[i][2 * j + 1] = s[i][2 * j + 1] * f + bfhi(x[u][i][j]); } }
    }
}
__device__ __forceinline__ void kv_step1(float (&s)[4][8], const bf16* kv, int slot, bool take, float f) {
    v4u x[4];
#pragma unroll
    for (int i = 0; i < 4; ++i) x[i] = (v4u){0u, 0u, 0u, 0u};
    if (take) {
#pragma unroll
        for (int i = 0; i < 4; ++i) x[i] = *(const v4u*)(kv + (size_t)slot * 16384 + (size_t)(NTHREADS * i) * 8); }
#pragma unroll
    for (int i = 0; i < 4; ++i)
#pragma unroll
        for (int j = 0; j < 4; ++j) { s[i][2 * j] = s[i][2 * j] * f + bflo(x[i][j]); s[i][2 * j + 1] = s[i][2 * j + 1] * f + bfhi(x[i][j]); }
}
__device__ __forceinline__ void ret_pair(Frame& F, int bh, int n_small) {
    const int b = bh >> 2, h = bh & 3;
    const bf16* PROJ = (const bf16*)(F.ws + WS_PROJ);
    LAS unsigned char* Qs = F.lds; LAS unsigned char* Ks = F.lds + TILE_LDS; LAS unsigned char* Vs = F.lds + 2 * TILE_LDS; LAS unsigned char* St = F.lds + 3 * TILE_LDS;
    const float lg = head_log2g(h); const float cd = exp2f(lg * 128.0f);
    const int w = F.wave, fr = F.lane & 15, fq = F.lane >> 4; const int q = 16 * w + fr;
    const int n_big = 15 - n_small;
    v4u sb[4]; TileRegs tq, tk, tv;
    { const size_t tok0 = (size_t)b * SEQ + 128 * n_small;
      tile_fetch(tq, PROJ + tok0 * PROJ_W + 128 * h, PROJ_W, F.tid); tile_fetch(tk, PROJ + tok0 * PROJ_W + 512 + 128 * h, PROJ_W, F.tid); tile_fetch(tv, PROJ + tok0 * PROJ_W + 1024 + 128 * h, PROJ_W, F.tid); }
    __syncthreads();
    { const bf16* kv = (const bf16*)(F.ws + WS_KV) + (size_t)bh * NCHUNK * 16384 + (size_t)F.tid * 8;
      float s[4][8];
#pragma unroll
      for (int i = 0; i < 4; ++i)
#pragma unroll
          for (int j = 0; j < 8; ++j) s[i][j] = 0.f;
      const int a = n_small >> 1; const bool odd = (n_small & 1) != 0; const float cd2 = cd * cd;
      kv_horner<4>(s, kv, 1, a, cd2);
      { v4u x[4];
#pragma unroll
        for (int i = 0; i < 4; ++i) x[i] = (v4u){0u, 0u, 0u, 0u};
        if (odd) {
#pragma unroll
            for (int i = 0; i < 4; ++i) x[i] = *(const v4u*)(kv + (size_t)(2 * a) * 16384 + (size_t)(NTHREADS * i) * 8); }
        const float f1 = odd ? cd : 1.0f;
        if (n_small > 0) {
#pragma unroll
            for (int i = 0; i < 4; ++i) { const int c = F.tid + NTHREADS * i, e = c >> 4, ch = c & 15; v4u o;
#pragma unroll
                for (int j = 0; j < 4; ++j) o[j] = pk2(s[i][2 * j] * f1 + bflo(x[i][j]), s[i][2 * j + 1] * f1 + bfhi(x[i][j]));
                *(LAS v4u*)(St + e * LP + ch * 16) = o; } } }
      kv_horner<4>(s, kv, 2 * a + 1, 7 - 2 * a, cd2);
      kv_step1(s, kv, 14 - 2 * a, !odd, odd ? 1.0f : cd);
#pragma unroll
      for (int i = 0; i < 4; ++i) { sb[i].x = pk2(s[i][0], s[i][1]); sb[i].y = pk2(s[i][2], s[i][3]); sb[i].z = pk2(s[i][4], s[i][5]); sb[i].w = pk2(s[i][6], s[i][7]); }
    }
#pragma unroll 1
    for (int pass = 0; pass < 2; ++pass) {
        const int n = pass == 0 ? n_small : n_big; const size_t tok0 = (size_t)b * SEQ + 128 * n;
        int opq = 0; asm volatile("" : "+v"(opq));
        if (pass == 1) { __syncthreads();
#pragma unroll
            for (int i = 0; i < 4; ++i) { const int c = F.tid + NTHREADS * i, e = c >> 4, ch = c & 15; *(LAS v4u*)(St + e * LP + ch * 16) = sb[i]; } }
        if (pass == 1) { tile_fetch(tq, PROJ + tok0 * PROJ_W + 128 * h, PROJ_W, F.tid); tile_fetch(tk, PROJ + tok0 * PROJ_W + 512 + 128 * h, PROJ_W, F.tid); tile_fetch(tv, PROJ + tok0 * PROJ_W + 1024 + 128 * h, PROJ_W, F.tid); }
        tile_stage<false>(Qs, tq, F.tid, 0.f); tile_stage<false>(Ks, tk, F.tid, 0.f); tile_stage<false>(Vs, tv, F.tid, 0.f);
        v2u gg[8]; const bf16* gp = PROJ + (tok0 + q) * PROJ_W + 1536 + 128 * h + 4 * fq;
#pragma unroll
        for (int j = 0; j < 8; ++j) gg[j] = *(const v2u*)(gp + 16 * j);
        __syncthreads();
        f32x4 sc[8], oc[8];
#pragma unroll
        for (int j = 0; j < 8; ++j) { sc[j] = (f32x4){0.f, 0.f, 0.f, 0.f}; oc[j] = (f32x4){0.f, 0.f, 0.f, 0.f}; }
        mm16<false, false>(sc, Qs, Ks, w, fr, fq);
        if (n > 0) { mm16<false, false>(oc, Qs, St, w, fr, fq); const float qd = exp2f(lg * (float)(q + 1 + opq));
#pragma unroll
            for (int j = 0; j < 8; ++j) oc[j] = oc[j] * qd; }
#pragma unroll
        for (int j = 0; j < 8; ++j) { float pv[4];
#pragma unroll
            for (int i = 0; i < 4; ++i) { const int k = 16 * j + 4 * fq + i; pv[i] = (q >= k) ? sc[j][i] * exp2f(lg * (float)(q - k + opq)) : 0.f; }
            v2u wv; wv.x = pk2(pv[0], pv[1]); wv.y = pk2(pv[2], pv[3]); *(LAS v2u*)(Qs + q * LP + (16 * j + 4 * fq) * 2) = wv; }
        asm volatile("s_waitcnt lgkmcnt(0)" ::: "memory");
        mm16<false, true>(oc, Qs, Vs, w, fr, fq);
        float ss = 0.f;
#pragma unroll
        for (int j = 0; j < 8; ++j) ss += (oc[j][0] * oc[j][0] + oc[j][1] * oc[j][1]) + (oc[j][2] * oc[j][2] + oc[j][3] * oc[j][3]);
        ss += __shfl_xor(ss, 16); ss += __shfl_xor(ss, 32);
        const float rstd = 1.0f / sqrtf(ss * (1.0f / 128.0f) + EPS);
        const float* rg = F.in[3] + 128 * h + 4 * fq + opq;
        bf16* o = (bf16*)(F.ws + WS_MIX) + (tok0 + q) * DM + 128 * h + 4 * fq;
#pragma unroll
        for (int j = 0; j < 8; ++j) { const f32x4 rgv = *(const f32x4*)(rg + 16 * j);
            v2u wv; wv.x = pk2(oc[j][0] * rstd * rgv[0] * bflo(gg[j].x), oc[j][1] * rstd * rgv[1] * bfhi(gg[j].x));
            wv.y = pk2(oc[j][2] * rstd * rgv[2] * bflo(gg[j].y), oc[j][3] * rstd * rgv[3] * bfhi(gg[j].y));
            *(v2u*)(o + 16 * j) = wv; }
    }
}

#define XB_TMO      128
#define XB_XCNT(j)  (256  + 64 * (j))
#define XB_XSUB(j)  (1280 + 64 * (j))
#define XB_XGEN(j)  (2304 + 64 * (j))
#define XB_TOP      3328
#define XB_TOPGEN   3392
#define XCD_BAR_WORDS 3456
#define XB_SPIN_CAP (1u << 18)
__device__ __forceinline__ unsigned xb_ld(unsigned* p)              { return __hip_atomic_load(p, __ATOMIC_RELAXED, __HIP_MEMORY_SCOPE_AGENT); }
__device__ __forceinline__ unsigned xb_add(unsigned* p, unsigned v) { return __hip_atomic_fetch_add(p, v, __ATOMIC_RELAXED, __HIP_MEMORY_SCOPE_AGENT); }
__device__ __forceinline__ unsigned xb_xcc_id() { return (unsigned)__builtin_amdgcn_s_getreg((3 << 11) | 20) & 0xFu; }
#define XB_SPIN(cond, bar) do { unsigned _sp = 0; while (cond) { __builtin_amdgcn_s_sleep(1); \
    if ((++_sp & 255u) == 0u) { if (xb_ld(&(bar)[XB_TMO])) break; if (_sp > XB_SPIN_CAP) { atomicAdd(&(bar)[XB_TMO], 1u); break; } } } } while (0)
struct XcdBarrier { unsigned* bar; unsigned x; volatile LAS unsigned* st; };
__device__ __forceinline__ XcdBarrier xcd_barrier_post(unsigned* bar, volatile LAS unsigned* st) {
    XcdBarrier b; b.bar = bar; b.x = xb_xcc_id(); b.st = st;
    if (threadIdx.x == 0) (void)xb_add(&bar[XB_XCNT(b.x)], 1u);
    return b;
}
__device__ __forceinline__ void xcd_barrier_complete(unsigned* bar, unsigned x, unsigned& nloc, unsigned& nx) {
    const unsigned G = gridDim.x * gridDim.y * gridDim.z;
    unsigned sum, cnt, mine, sp = 0u;
    for (;;) {
        sum = 0u; cnt = 0u; mine = 0u;
#pragma unroll
        for (unsigned j = 0; j < 16; ++j) { const unsigned c = xb_ld(&bar[XB_XCNT(j)]); sum += c; cnt += (c > 0u) ? 1u : 0u; mine = (j == x) ? c : mine; }
        if (sum == G) break;
        __builtin_amdgcn_s_sleep(1);
        if ((++sp & 255u) == 0u) { if (xb_ld(&bar[XB_TMO])) break; if (sp > XB_SPIN_CAP) { atomicAdd(&bar[XB_TMO], 1u); break; } }
    }
    nloc = mine > 0u ? mine : 1u; nx = cnt > 0u ? cnt : 1u;
}
__device__ __forceinline__ void xcd_barrier(const XcdBarrier& b) {
    asm volatile("s_waitcnt vmcnt(0)" ::: "memory");
    __syncthreads();
    if (threadIdx.x == 0) {
        unsigned* bar = b.bar;
        __builtin_amdgcn_s_waitcnt(0);
        unsigned nloc = b.st[0], nx = b.st[1];
        if (nloc == 0u) { xcd_barrier_complete(bar, b.x, nloc, nx); b.st[0] = nloc; b.st[1] = nx; }
        const unsigned old = xb_add(&bar[XB_XSUB(b.x)], 1u);
        const unsigned gen = old / nloc;
        if (old + 1u == (gen + 1u) * nloc) {
            __builtin_amdgcn_fence(__ATOMIC_RELEASE, "agent");
            asm volatile("s_waitcnt vmcnt(0)" ::: "memory");
            const unsigned og = xb_add(&bar[XB_TOP], 1u);
            const unsigned tg = og / nx;
            if (og + 1u == (tg + 1u) * nx) xb_add(&bar[XB_TOPGEN], 1u);
            else XB_SPIN(xb_ld(&bar[XB_TOPGEN]) == tg, bar);
            __builtin_amdgcn_fence(__ATOMIC_ACQUIRE, "agent");
            xb_add(&bar[XB_XGEN(b.x)], 1u);
            asm volatile("s_waitcnt vmcnt(0)" ::: "memory");
        } else {
            XB_SPIN(xb_ld(&bar[XB_XGEN(b.x)]) == gen, bar);
            __builtin_amdgcn_fence(__ATOMIC_ACQUIRE, "agent");
            asm volatile("s_waitcnt vmcnt(0)" ::: "memory");
        }
    }
    __syncthreads();
}

struct Args { const float* in[15]; float* out; unsigned char* ws; int ph_lo, ph_hi; };
constexpr int NPHASE = 7;
__global__ void __launch_bounds__(NTHREADS, 2) fwd_megakernel(Args args) {
    extern __shared__ __attribute__((aligned(16))) unsigned char lds[];
    Frame F;
    F.lds = (LAS unsigned char*)lds; F.ws = args.ws;
    F.tid = threadIdx.x; F.lane = F.tid & 63; F.wave = __builtin_amdgcn_readfirstlane(F.tid >> 6);
    F.G = gridDim.x; F.bid = blockIdx.x;
#pragma unroll
    for (int i = 0; i < 15; ++i) F.in[i] = args.in[i];
    F.out = args.out;
    const int lo = args.ph_lo, hi = args.ph_hi;
    volatile LAS unsigned* MISC = (volatile LAS unsigned*)(F.lds + MISC_OFF);
    if (F.tid < 16) MISC[F.tid] = 0u;
    __syncthreads();
    XcdBarrier bar; bar.bar = (unsigned*)(F.ws + WS_BAR); bar.x = 0; bar.st = nullptr;
    if (hi - lo > 1) bar = xcd_barrier_post((unsigned*)(F.ws + WS_BAR), MISC);
    if (lo < 0) cg::this_grid().sync();
#define IN(k) (lo <= (k) && (k) < hi)
#if MK_CGSYNC
#define SEAM(k) do { if (IN(k) && IN((k) + 1)) cg::this_grid().sync(); } while (0)
#else
#define SEAM(k) do { if (IN(k) && IN((k) + 1)) xcd_barrier(bar); } while (0)
#endif
#if MK_SPIN >= 0
    unsigned long long t0_ = 0;
#define PH_BEGIN(k) do { if ((k) == MK_SPIN) t0_ = __builtin_amdgcn_s_memrealtime(); } while (0)
#define PH_END(k) do { if ((k) == MK_SPIN) { asm volatile("s_waitcnt vmcnt(0)" ::: "memory"); const unsigned long long t1_ = __builtin_amdgcn_s_memrealtime(); while (__builtin_amdgcn_s_memrealtime() - t1_ < (t1_ - t0_)) __builtin_amdgcn_s_sleep(8); } } while (0)
#else
#define PH_BEGIN(k) do {} while (0)
#define PH_END(k) do {} while (0)
#endif

    PH_BEGIN(0);
    if (IN(0)) p0_prologue(F);
    PH_END(0);
    SEAM(0);
    PH_BEGIN(1);
    if (IN(1)) {
        pg8::Gemm g{(const bf16*)(F.ws + WS_XN), (const bf16*)(F.ws + WS_WIN), M, PROJ_W, DM}; pg8::StaticOrder S; S.init(M, PROJ_W, F.G, F.bid);
        pg8::EpiProj E{(bf16*)(F.ws + WS_PROJ), (const float*)(F.ws + WS_ROPE), (const float*)(F.ws + WS_SSQ0)};
        pg8::gemm_phase<pg8::EpiProj, pg8::StaticOrder, true, true>(F.lds, g, S, E);
        p1_tail(F);
    }
    PH_END(1);
    SEAM(1);
    PH_BEGIN(2);
    if (IN(2)) p2_phase(F);
    PH_END(2);
    SEAM(2);
    PH_BEGIN(3);
    if (IN(3)) {
        for (int it = F.bid; it < 256; it += F.G) ret_pair(F, it >> 3, it & 7);
        __syncthreads();
    }
    PH_END(3);
    SEAM(3);
    PH_BEGIN(4);
    if (IN(4)) {
        pg8::Gemm g{(const bf16*)(F.ws + WS_MIX), (const bf16*)(F.ws + WS_WOUT), M, DM, DM}; pg8::StaticOrder S; S.init(M, DM, F.G, F.bid);
        pg8::EpiRes<true> E{(const bf16*)(F.ws + WS_XN), F.out, (bf16*)(F.ws + WS_XN), F.in[9], (float*)(F.ws + WS_SSQ1)};
        pg8::gemm_phase<pg8::EpiRes<true>, pg8::StaticOrder, false, true>(F.lds, g, S, E);
    }
    PH_END(4);
    SEAM(4);
    PH_BEGIN(5);
    if (IN(5)) {
        pg8::Gemm g{(const bf16*)(F.ws + WS_XN), (const bf16*)(F.ws + WS_WUP), M, UPW, DM}; pg8::StaticOrder S; S.init(M, UPW, F.G, F.bid);
        pg8::EpiConv E{(const float*)(F.ws + WS_SSQ1), F.in[11], F.in[12], (bf16*)(F.ws + WS_ACT), (float*)(F.ws + WS_EDGE)};
        pg8::gemm_phase<pg8::EpiConv, pg8::StaticOrder, true, true>(F.lds, g, S, E);
    }
    PH_END(5);
    SEAM(5);
    PH_BEGIN(6);
    if (IN(6)) {
        pg8::Gemm g{(const bf16*)(F.ws + WS_ACT), (const bf16*)(F.ws + WS_WDOWN), M, DM, DFF}; pg8::StaticOrder S; S.init(M, DM, F.G, F.bid);
        pg8::Unit u0;
        if (S.next(0, u0)) {
            const float* edge = (const float*)(F.ws + WS_EDGE); const float* cw = F.in[11]; const float* cb = F.in[12]; bf16* act = (bf16*)(F.ws + WS_ACT);
            for (int i = F.tid; i < 2 * (DFF / 4); i += NTHREADS) { const int rl = i >= (DFF / 4) ? 1 : 0; const int run = 2 * u0.pm + rl, c = 4 * (i - rl * (DFF / 4));
                const float* e = edge + (size_t)run * 4 * UPW; const bool first = (run & 15) == 0;
                f32x4 y0[2], y1[2];
#pragma unroll
                for (int hb = 0; hb < 2; ++hb) { const int cc = c + hb * DFF; const f32x4 z = (f32x4){0.f, 0.f, 0.f, 0.f};
                    const f32x4 f0 = *(const f32x4*)(e + cc), f1 = *(const f32x4*)(e + UPW + cc);
                    const f32x4 p2 = first ? z : *(const f32x4*)(e + cc - 2 * UPW), p1 = first ? z : *(const f32x4*)(e + cc - UPW);
                    const f32x4 w0 = *(const f32x4*)(cw + cc), w1 = *(const f32x4*)(cw + UPW + cc), w2 = *(const f32x4*)(cw + 2 * UPW + cc), bb = *(const f32x4*)(cb + cc);
                    y0[hb] = w2 * f0 + w1 * p1 + w0 * p2 + bb; y1[hb] = w2 * f1 + w1 * f0 + w0 * p1 + bb; }
                *(v2u*)(act + (size_t)(128 * run) * DFF + c) = (v2u){pk2(pg8::silu_f(y0[0][0]) * y0[1][0], pg8::silu_f(y0[0][1]) * y0[1][1]), pk2(pg8::silu_f(y0[0][2]) * y0[1][2], pg8::silu_f(y0[0][3]) * y0[1][3])};
                *(v2u*)(act + (size_t)(128 * run + 1) * DFF + c) = (v2u){pk2(pg8::silu_f(y1[0][0]) * y1[1][0], pg8::silu_f(y1[0][1]) * y1[1][1]), pk2(pg8::silu_f(y1[0][2]) * y1[1][2], pg8::silu_f(y1[0][3]) * y1[1][3])}; }
            asm volatile("s_waitcnt vmcnt(0)" ::: "memory");
            __syncthreads();
        }
        pg8::EpiFinal E{(const bf16*)(F.ws + WS_XN), F.in[9], F.out, F.in[14], (float*)(F.ws + WS_SSQ2), (unsigned*)(F.ws + WS_PCNT)};
        pg8::gemm_phase<pg8::EpiFinal, pg8::StaticOrder, true, true>(F.lds, g, S, E);
    }
    PH_END(6);
#undef IN
#undef SEAM
}

extern "C" void kernel_launch(void* const* d_in, const int* in_sizes, int n_in, void* d_out, int out_size, void* d_ws, size_t ws_size, hipStream_t stream) {
    static int grid = 0;
    if (grid == 0) {
        if (n_in != 15 || out_size != M * DM || ws_size < WS_END) { fprintf(stderr, "kernel_launch: unexpected shapes (n_in %d out %d ws %zu)\n", n_in, out_size, ws_size); grid = -1; return; }
        if (hipFuncSetAttribute((const void*)fwd_megakernel, hipFuncAttributeMaxDynamicSharedMemorySize, LDS_BYTES) != hipSuccess) { fprintf(stderr, "kernel_launch: hipFuncSetAttribute failed\n"); grid = -1; return; }
        int dev = 0, cus = 0, per_cu = 0;
        (void)hipGetDevice(&dev); (void)hipDeviceGetAttribute(&cus, hipDeviceAttributeMultiprocessorCount, dev);
        (void)hipOccupancyMaxActiveBlocksPerMultiprocessor(&per_cu, (const void*)fwd_megakernel, NTHREADS, LDS_BYTES);
        (void)hipGetLastError();
        if (per_cu < 1) per_cu = 1;
        grid = cus > 0 ? cus : 256;
    }
    if (grid < 0) return;
    Args a{};
    for (int i = 0; i < 15; ++i) a.in[i] = (const float*)d_in[i];
    a.out = (float*)d_out; a.ws = (unsigned char*)d_ws;
    if (hipMemsetAsync((char*)d_ws + WS_BAR, 0, WS_BAR_BYTES, stream) != hipSuccess) { fprintf(stderr, "kernel_launch: memset failed\n"); return; }
#if MK_MULTI
    for (int p = 0; p < NPHASE; ++p) { a.ph_lo = p; a.ph_hi = p + 1; const int reps = ((MK_REPMASK >> p) & 1) ? 2 : 1;
        for (int r = 0; r < reps; ++r) hipLaunchKernelGGL(fwd_megakernel, dim3(grid), dim3(NTHREADS), LDS_BYTES, stream, a); }
#else
    a.ph_lo = 0; a.ph_hi = NPHASE;
    void* kargs[] = {&a};
    hipError_t e = hipLaunchCooperativeKernel((const void*)fwd_megakernel, dim3(grid), dim3(NTHREADS), kargs, LDS_BYTES, stream);
    if (e != hipSuccess) fprintf(stderr, "cooperative launch failed: %s (grid %d)\n", hipGetErrorString(e), grid);
#endif
}
```

```cpp
#include <hip/hip_runtime.h>
#include <hip/hip_cooperative_groups.h>
#include <cstdio>
#include <cstdint>
namespace cg = cooperative_groups;

namespace pg8 {
#define PG8_LAS __attribute__((address_space(3)))
typedef unsigned short bf16_t;
typedef short bf16x8 __attribute__((ext_vector_type(8)));
typedef float f32x4 __attribute__((ext_vector_type(4)));
typedef float f32x2 __attribute__((ext_vector_type(2)));
typedef unsigned u32x4 __attribute__((ext_vector_type(4)));
typedef unsigned u32x2 __attribute__((ext_vector_type(2)));
constexpr int BM = 256, BK = 64, HALF = 128, HTB = HALF * BK * 2  , STAGE_BYTES = 8 * HTB, NXCD = 8, WGM = 8;

__host__ __device__ __forceinline__ int lds_byte(int r, int c) { const int st = (r >> 4) * 2 + (c >> 5), rr = r & 15, cc = c & 31, ob = rr * 64 + cc * 2; return st * 1024 + (ob ^ (((ob >> 9) & 1) << 5)); }
__host__ __device__ __forceinline__ void stage_rc(int b, int& R, int& C) { const int st = b / 1024, sb = b % 1024, swz = sb ^ (((sb >> 9) & 1) << 5); R = (st >> 1) * 16 + swz / 64; C = (st & 1) * 32 + (swz % 64) / 2; }
__host__ __device__ __forceinline__ int perm32(int rho) { const int n = rho >> 4, i = rho & 15; return 8 * (i >> 2) + 4 * n + (i & 3); }
__host__ __device__ __forceinline__ int tokrow(int R) { return 128 * (R >> 6) + 8 * (R & 15) + ((R >> 4) & 3); }

struct Unit { int pm, pn; };
struct Gemm { const bf16_t* A; const bf16_t* Bt; int M, N, K; };

struct StaticOrder {
    int nM, nN, nwg, G, c;
    __host__ __device__ void init(int M, int N, int G_, int c_) { nM = M / BM; nN = N / BM; nwg = nM * nN; G = G_; c = c_; }
    __host__ __device__ bool next(int i, Unit& u) const {
        const long L = (long)i * G + c; if (L >= nwg) return false;
        int wgid = (int)L; { const int q = nwg / NXCD, r = nwg % NXCD, xcd = wgid % NXCD, off = wgid / NXCD; wgid = (xcd < r ? xcd * (q + 1) : r * (q + 1) + (xcd - r) * q) + off; }
        const int nig = WGM * nN, gid = wgid / nig, fm = gid * WGM, gsz = (nM - fm) < WGM ? (nM - fm) : WGM;
        u.pm = fm + ((wgid % nig) % gsz); u.pn = (wgid % nig) / gsz; return true;
    }
    __device__ __forceinline__ void a_ready(const Unit&) const {}
    __device__ __forceinline__ void done(const Unit&) const {}
};

__device__ __forceinline__ unsigned cvt_pk_bf16(float lo, float hi) { unsigned r; asm volatile("v_cvt_pk_bf16_f32 %0, %1, %2" : "=v"(r) : "v"(lo), "v"(hi)); return r; }
__device__ __forceinline__ f32x2 gelu_pk(f32x2 v) {
    const f32x2 av = __builtin_elementwise_abs(v), d = av * 0.2316418882f + 1.0f;
    f32x2 t; t.x = __builtin_amdgcn_rcpf(d.x); t.y = __builtin_amdgcn_rcpf(d.y);
    f32x2 q = t * 0.5307027145f + (-0.7265760135f); q = q * t + 0.7107068705f; q = q * t + (-0.142248368f); q = q * t + 0.127414796f; q = q * t;
    const f32x2 s = (v * v) * (-0.72134752044f);
    f32x2 e; e.x = __builtin_amdgcn_exp2f(s.x); e.y = __builtin_amdgcn_exp2f(s.y);
    const f32x2 m = v * (q * e), r = v - m;
    f32x2 o; o.x = v.x < 0.f ? m.x : r.x; o.y = v.y < 0.f ? m.y : r.y; return o;
}
__device__ __forceinline__ float silu_f(float v) { return v * __builtin_amdgcn_rcpf(1.f + __builtin_amdgcn_exp2f(-1.4426950408889634f * v)); }
__device__ __forceinline__ f32x4 silu4(f32x4 v) { return (f32x4){silu_f(v[0]), silu_f(v[1]), silu_f(v[2]), silu_f(v[3])}; }
__device__ __forceinline__ f32x4 gelu4(f32x4 v) { const f32x2 a = gelu_pk((f32x2){v[0], v[1]}), b = gelu_pk((f32x2){v[2], v[3]}); return (f32x4){a.x, a.y, b.x, b.y}; }
__device__ __forceinline__ u32x2 pack4(f32x4 v) { u32x2 w; w.x = cvt_pk_bf16(v[0], v[1]); w.y = cvt_pk_bf16(v[2], v[3]); return w; }

constexpr int PROJ_W = 3072, DM = 1024, DFF = 2816, UPW = 5632, SEQ = 2048;
constexpr float EPS = 1e-6f;

struct EpiProj {
    static constexpr bool PERM = true, AFTER_DRAIN = false, AROWPERM = false;
    bf16_t* O; const float* rope; const float* ssq0;
    __device__ __forceinline__ void operator()(const f32x4 (&acc)[2][2][4][2], const Unit& u, int wr, int wc, int fr, int fq) const {
        const int row0 = u.pm * BM + wr * 64 + fr; const int type = u.pn >> 1;
        if (type < 2) {
            const float sc = (type == 1) ? 0.08838834764831845f : 1.0f; const int pp = 16 * wc + 4 * fq;
#pragma unroll
            for (int ai = 0; ai < 2; ++ai)
#pragma unroll
                for (int m = 0; m < 4; ++m) { const int row = row0 + ai * HALF + m * 16; const int pos = row & (SEQ - 1);
                    const float rs = __builtin_amdgcn_rsqf(ssq0[row] * (1.0f / DM) + EPS) * sc;
                    const f32x4 c = *(const f32x4*)(rope + pos * 128 + pp) * rs, s = *(const f32x4*)(rope + pos * 128 + 64 + pp) * rs;
#pragma unroll
                    for (int bj = 0; bj < 2; ++bj) { const f32x4 x1 = acc[ai][bj][m][0], x2 = acc[ai][bj][m][1];
                        const f32x4 o1 = x1 * c - x2 * s, o2 = x2 * c + x1 * s;
                        bf16_t* p = O + (size_t)row * PROJ_W + u.pn * BM + bj * HALF + pp;
                        *(u32x2*)p = pack4(o1); *(u32x2*)(p + 64) = pack4(o2); } }
        } else {
            const int col0 = u.pn * BM + wc * 32 + 8 * fq;
#pragma unroll
            for (int ai = 0; ai < 2; ++ai)
#pragma unroll
                for (int m = 0; m < 4; ++m) { const int row = row0 + ai * HALF + m * 16; bf16_t* rowp = O + (size_t)row * PROJ_W + col0;
                    const float rs = __builtin_amdgcn_rsqf(ssq0[row] * (1.0f / DM) + EPS);
#pragma unroll
                    for (int bj = 0; bj < 2; ++bj) { f32x4 v0 = acc[ai][bj][m][0] * rs, v1 = acc[ai][bj][m][1] * rs;
                        if (type == 3) { v0 = silu4(v0); v1 = silu4(v1); } else if (type >= 4) { v0 = gelu4(v0); v1 = gelu4(v1); }
                        const u32x2 a = pack4(v0), b = pack4(v1); u32x4 w; w.x = a.x; w.y = a.y; w.z = b.x; w.w = b.y;
                        *(u32x4*)(rowp + bj * HALF) = w; } }
        }
    }
};

template <bool WRITE_XG> struct EpiRes {
    static constexpr bool PERM = false, AFTER_DRAIN = false, AROWPERM = false;
    const bf16_t* base; float* out; bf16_t* xg; const float* gain; float* ssq;
    __device__ __forceinline__ void operator()(const f32x4 (&acc)[2][2][4][2], const Unit& u, int wr, int wc, int fr, int fq) const {
        const int col0 = u.pn * BM + wc * 32 + 4 * fq;
        f32x4 gv[2][2];
#pragma unroll
        for (int bj = 0; bj < 2; ++bj)
#pragma unroll
            for (int n = 0; n < 2; ++n) gv[bj][n] = WRITE_XG ? *(const f32x4*)(gain + col0 + bj * HALF + n * 16) : (f32x4){0.f, 0.f, 0.f, 0.f};
#pragma unroll
        for (int ai = 0; ai < 2; ++ai)
#pragma unroll
            for (int m = 0; m < 4; ++m) { const int row = u.pm * BM + ai * HALF + wr * 64 + m * 16 + fr; const size_t off = (size_t)row * DM + col0; float s = 0.f;
#pragma unroll
                for (int bj = 0; bj < 2; ++bj)
#pragma unroll
                    for (int n = 0; n < 2; ++n) { const u32x2 xb = *(const u32x2*)(base + off + bj * HALF + n * 16);
                        const f32x4 x1 = (f32x4){__uint_as_float(xb.x << 16), __uint_as_float(xb.x & 0xffff0000u), __uint_as_float(xb.y << 16), __uint_as_float(xb.y & 0xffff0000u)} + acc[ai][bj][m][n];
                        if (!WRITE_XG) *(f32x4*)(out + off + bj * HALF + n * 16) = x1; s += (x1[0] * x1[0] + x1[1] * x1[1]) + (x1[2] * x1[2] + x1[3] * x1[3]);
                        if (WRITE_XG) *(u32x2*)(xg + off + bj * HALF + n * 16) = pack4(x1 * gv[bj][n]); }
                s += __shfl_xor(s, 16); s += __shfl_xor(s, 32);
                if (fq == 0) (void)__hip_atomic_fetch_add(ssq + row, s, __ATOMIC_RELAXED, __HIP_MEMORY_SCOPE_AGENT);
                if (m == 3) asm volatile("" ::: "memory"); }
    }
};

struct EpiFinal {
    static constexpr bool PERM = false, AFTER_DRAIN = false, AROWPERM = false;
    const bf16_t* xg; const float* gffn; float* out; const float* gain; float* ssq; unsigned* cnt;
    __device__ __forceinline__ void operator()(f32x4 (&acc)[2][2][4][2], const Unit& u, int wr, int wc, int fr, int fq) const {
        const int col0 = u.pn * BM + wc * 32 + 4 * fq;
        f32x4 gi[2][2];
#pragma unroll
        for (int bj = 0; bj < 2; ++bj)
#pragma unroll
            for (int n = 0; n < 2; ++n) { const f32x4 gf = *(const f32x4*)(gffn + col0 + bj * HALF + n * 16); gi[bj][n] = (f32x4){1.0f / gf[0], 1.0f / gf[1], 1.0f / gf[2], 1.0f / gf[3]}; }
#pragma unroll
        for (int ai = 0; ai < 2; ++ai)
#pragma unroll
            for (int m = 0; m < 4; ++m) { const int row = u.pm * BM + ai * HALF + wr * 64 + m * 16 + fr; const size_t off = (size_t)row * DM + col0; float s = 0.f;
#pragma unroll
                for (int bj = 0; bj < 2; ++bj)
#pragma unroll
                    for (int n = 0; n < 2; ++n) { const u32x2 xb = *(const u32x2*)(xg + off + bj * HALF + n * 16);
                        const f32x4 x1 = (f32x4){__uint_as_float(xb.x << 16), __uint_as_float(xb.x & 0xffff0000u), __uint_as_float(xb.y << 16), __uint_as_float(xb.y & 0xffff0000u)} * gi[bj][n];
                        const f32x4 x2 = x1 + acc[ai][bj][m][n];
                        acc[ai][bj][m][n] = x2; s += (x2[0] * x2[0] + x2[1] * x2[1]) + (x2[2] * x2[2] + x2[3] * x2[3]); }
                s += __shfl_xor(s, 16); s += __shfl_xor(s, 32);
                if (fq == 0) (void)__hip_atomic_fetch_add(ssq + row, s, __ATOMIC_RELAXED, __HIP_MEMORY_SCOPE_AGENT);
                if (m == 3) asm volatile("" ::: "memory"); }
        asm volatile("s_waitcnt vmcnt(0)" ::: "memory");
        unsigned* c = cnt + 64 * u.pm;
        if ((threadIdx.x & 63) == 0) (void)__hip_atomic_fetch_add(c, 1u, __ATOMIC_RELAXED, __HIP_MEMORY_SCOPE_AGENT);
        { unsigned sp = 0;
          while ((unsigned)__builtin_amdgcn_readfirstlane(__hip_atomic_load(c, __ATOMIC_RELAXED, __HIP_MEMORY_SCOPE_AGENT)) < 32u) { __builtin_amdgcn_s_sleep(2); if (++sp > (1u << 22)) break; } }
        __builtin_amdgcn_fence(__ATOMIC_ACQUIRE, "agent");
        f32x4 gv[2][2];
#pragma unroll
        for (int bj = 0; bj < 2; ++bj)
#pragma unroll
            for (int n = 0; n < 2; ++n) gv[bj][n] = *(const f32x4*)(gain + col0 + bj * HALF + n * 16);
#pragma unroll
        for (int ai = 0; ai < 2; ++ai)
#pragma unroll
            for (int m = 0; m < 4; ++m) { const int row = u.pm * BM + ai * HALF + wr * 64 + m * 16 + fr; const size_t off = (size_t)row * DM + col0;
                const float tot = __hip_atomic_load(ssq + row, __ATOMIC_RELAXED, __HIP_MEMORY_SCOPE_AGENT);
                const float rstd = __builtin_amdgcn_rsqf(tot * (1.0f / DM) + EPS);
#pragma unroll
                for (int bj = 0; bj < 2; ++bj)
#pragma unroll
                    for (int n = 0; n < 2; ++n) *(f32x4*)(out + off + bj * HALF + n * 16) = acc[ai][bj][m][n] * rstd * gv[bj][n]; }
    }
};

__device__ __forceinline__ float dpp_shr1(float v) { return __int_as_float(__builtin_amdgcn_update_dpp(0, __float_as_int(v), 0x111, 0xf, 0xf, true)); }
__device__ __forceinline__ f32x4 dpp_shr1_4(f32x4 v) { return (f32x4){dpp_shr1(v[0]), dpp_shr1(v[1]), dpp_shr1(v[2]), dpp_shr1(v[3])}; }
struct EpiConv {
    static constexpr bool PERM = true, AFTER_DRAIN = false, AROWPERM = true;
    const float* ssq; const float* cw; const float* cb; bf16_t* act; float* edge;
    __device__ __forceinline__ void operator()(const f32x4 (&acc)[2][2][4][2], const Unit& u, int wr, int wc, int fr, int fq) const {
        const int run = u.pm * 2 + wr; const int tok0 = u.pm * BM + wr * HALF + 8 * fr;
        float rstd[8];
        { const f32x4 s0 = *(const f32x4*)(ssq + tok0), s1 = *(const f32x4*)(ssq + tok0 + 4);
#pragma unroll
          for (int i = 0; i < 4; ++i) { rstd[i] = __builtin_amdgcn_rsqf(s0[i] * (1.0f / DM) + EPS); rstd[4 + i] = __builtin_amdgcn_rsqf(s1[i] * (1.0f / DM) + EPS); } }
        u32x2 pk0[8];
#pragma unroll
        for (int n = 0; n < 2; ++n) {
            const int ca = u.pn * HALF + wc * 32 + 8 * fq + 4 * n;
            const f32x4 w0a = *(const f32x4*)(cw + ca), w1a = *(const f32x4*)(cw + UPW + ca), w2a = *(const f32x4*)(cw + 2 * UPW + ca), ba = *(const f32x4*)(cb + ca);
            const f32x4 w0b = *(const f32x4*)(cw + DFF + ca), w1b = *(const f32x4*)(cw + UPW + DFF + ca), w2b = *(const f32x4*)(cw + 2 * UPW + DFF + ca), bb = *(const f32x4*)(cb + DFF + ca);
            f32x4 ua[8], ub[8];
#pragma unroll
            for (int t = 0; t < 8; ++t) { ua[t] = acc[t >> 2][0][t & 3][n] * rstd[t]; ub[t] = acc[t >> 2][1][t & 3][n] * rstd[t]; }
            const f32x4 pa1 = dpp_shr1_4(ua[7]), pa2 = dpp_shr1_4(ua[6]), pb1 = dpp_shr1_4(ub[7]), pb2 = dpp_shr1_4(ub[6]);
            if (fr == 0) { float* e = edge + (size_t)run * 4 * UPW; *(f32x4*)(e + ca) = ua[0]; *(f32x4*)(e + UPW + ca) = ua[1]; *(f32x4*)(e + DFF + ca) = ub[0]; *(f32x4*)(e + UPW + DFF + ca) = ub[1]; }
            if (fr == 15) { float* e = edge + (size_t)run * 4 * UPW + 2 * UPW; *(f32x4*)(e + ca) = ua[6]; *(f32x4*)(e + UPW + ca) = ua[7]; *(f32x4*)(e + DFF + ca) = ub[6]; *(f32x4*)(e + UPW + DFF + ca) = ub[7]; }
#pragma unroll
            for (int t = 0; t < 8; ++t) {
                const f32x4 am1 = (t >= 1) ? ua[t >= 1 ? t - 1 : 0] : pa1, am2 = (t >= 2) ? ua[t >= 2 ? t - 2 : 0] : (t == 1 ? pa1 : pa2);
                const f32x4 bm1 = (t >= 1) ? ub[t >= 1 ? t - 1 : 0] : pb1, bm2 = (t >= 2) ? ub[t >= 2 ? t - 2 : 0] : (t == 1 ? pb1 : pb2);
                const f32x4 ya = w2a * ua[t] + w1a * am1 + w0a * am2 + ba, yb = w2b * ub[t] + w1b * bm1 + w0b * bm2 + bb;
                const u32x2 pk = pack4(silu4(ya) * yb);
                if (n == 0) pk0[t] = pk;
                else if (!(fr == 0 && t < 2)) { u32x4 w; w.x = pk0[t].x; w.y = pk0[t].y; w.z = pk.x; w.w = pk.y;
                    *(u32x4*)(act + (size_t)(tok0 + t) * DFF + u.pn * HALF + wc * 32 + 8 * fq) = w; }
            }
        }
    }
};
template <class Epi, class Sched, bool ALIGN_EPI = false, bool SP2 = false>
__device__ __forceinline__ void gemm_phase(PG8_LAS unsigned char* lds, const Gemm g, const Sched& S, const Epi& E) {
    const int tid = threadIdx.x, wid = __builtin_amdgcn_readfirstlane(tid >> 6), lane = tid & 63, wr = wid >> 2, wc = wid & 3, fr = lane & 15, fq = lane >> 4;
    const int K = g.K, nt = K / BK;
    unsigned voffA[2], voffB[2];
#pragma unroll
    for (int i = 0; i < 2; ++i) { int R, C; stage_rc(tid * 16 + i * 8192, R, C); const int Rb = Epi::PERM ? ((R & ~31) + perm32(R & 31)) : R;
        voffA[i] = (unsigned)((Epi::AROWPERM ? tokrow(R) : R) * K + C) * 2u; voffB[i] = (unsigned)(Rb * K + C) * 2u; }
    const size_t kstep = (size_t)(BK * 2);
    const size_t hstepB = (size_t)HALF * K * 2; const size_t hstepA = Epi::AROWPERM ? (size_t)4 * K * 2 : hstepB;
    const size_t tstep = 2 * hstepB;
    const unsigned ldsw = (unsigned)wid * 1024u;
    const int aoff = lds_byte(wr * 64 + fr, fq * 8), boff = lds_byte(wc * 32 + fr, fq * 8);
#define PG8_SA(b, h) (((b) * 2 + (h)) * HTB)
#define PG8_SB(b, h) ((4 + (b) * 2 + (h)) * HTB)
#define PG8_STAGE(bufoff, gbase, voff) do { _Pragma("unroll") for (int _i = 0; _i < 2; ++_i) \
        __builtin_amdgcn_global_load_lds((const unsigned*)((const char*)(gbase) + (voff)[_i]), (PG8_LAS unsigned*)(lds + (bufoff) + ldsw + _i * 8192), 16, 0, 0); } while (0)
#define PG8_LDA(dst, b, h) do { _Pragma("unroll") for (int m = 0; m < 4; ++m) _Pragma("unroll") for (int k = 0; k < 2; ++k) dst[m][k] = *(const PG8_LAS bf16x8*)(lds + PG8_SA(b, h) + aoff + m * 2048 + k * 1024); } while (0)
#define PG8_LDB(dst, b, h) do { _Pragma("unroll") for (int n = 0; n < 2; ++n) _Pragma("unroll") for (int k = 0; k < 2; ++k) dst[n][k] = *(const PG8_LAS bf16x8*)(lds + PG8_SB(b, h) + boff + n * 2048 + k * 1024); } while (0)
#define PG8_MMA(ai, bj, At, Bt) do { __builtin_amdgcn_s_setprio(1); _Pragma("unroll") for (int m = 0; m < 4; ++m) _Pragma("unroll") for (int n = 0; n < 2; ++n) _Pragma("unroll") for (int k = 0; k < 2; ++k) \
        acc[ai][bj][m][n] = __builtin_amdgcn_mfma_f32_16x16x32_bf16(Bt[n][k], At[m][k], acc[ai][bj][m][n], 0, 0, 0); __builtin_amdgcn_s_setprio(0); } while (0)
#define PG8_WAIT_V(n) asm volatile("s_waitcnt vmcnt(" #n ")" ::: "memory")
#define PG8_WAIT_L(n) asm volatile("s_waitcnt lgkmcnt(" #n ")" ::: "memory")
#define PG8_BAR __builtin_amdgcn_s_barrier()
#define PG8_SCHED __builtin_amdgcn_sched_barrier(0)
    Unit cur, nxt; int ui = 0;
    if (!S.next(0, cur)) return;
    f32x4 acc[2][2][4][2];
#pragma unroll
    for (int a = 0; a < 2; ++a)
#pragma unroll
        for (int b = 0; b < 2; ++b)
#pragma unroll
            for (int m = 0; m < 4; ++m)
#pragma unroll
                for (int n = 0; n < 2; ++n) acc[a][b][m][n] = (f32x4){0.f, 0.f, 0.f, 0.f};
    bf16x8 At[4][2], B0[2][2], B1[2][2];
    const char* cA = (const char*)g.A + (size_t)cur.pm * tstep; const char* cB = (const char*)g.Bt + (size_t)cur.pn * tstep;
    S.a_ready(cur);
    if constexpr (SP2) {
        PG8_STAGE(PG8_SB(0, 0), cB, voffB); PG8_STAGE(PG8_SB(0, 1), cB + hstepB, voffB); PG8_STAGE(PG8_SA(0, 0), cA, voffA); PG8_STAGE(PG8_SA(0, 1), cA + hstepA, voffA);
        if (wr == 1) PG8_BAR;
        PG8_WAIT_V(2); PG8_BAR;
        PG8_STAGE(PG8_SB(1, 0), cB + kstep, voffB); PG8_STAGE(PG8_SA(1, 0), cA + kstep, voffA); PG8_STAGE(PG8_SB(1, 1), cB + hstepB + kstep, voffB);
        PG8_WAIT_V(6); PG8_BAR;
    } else {
        PG8_STAGE(PG8_SB(0, 0), cB, voffB); PG8_STAGE(PG8_SA(0, 0), cA, voffA); PG8_STAGE(PG8_SB(0, 1), cB + hstepB, voffB); PG8_STAGE(PG8_SA(0, 1), cA + hstepA, voffA);
        if (wr == 1) PG8_BAR;
        PG8_WAIT_V(4); PG8_BAR;
        PG8_STAGE(PG8_SB(1, 0), cB + kstep, voffB); PG8_STAGE(PG8_SA(1, 0), cA + kstep, voffA); PG8_STAGE(PG8_SB(1, 1), cB + hstepB + kstep, voffB);
        PG8_WAIT_V(6); PG8_BAR;
    }
    for (;;) {
        const bool has_next = S.next(ui + 1, nxt);
        const char* nA = has_next ? (const char*)g.A + (size_t)nxt.pm * tstep : cA; const char* nB = has_next ? (const char*)g.Bt + (size_t)nxt.pn * tstep : cB;
        for (int t = 0; t < nt; t += 2) {
            const bool last = (t == nt - 2);
            const char* a1 = cA + (size_t)(t + 1) * kstep;
            const char* a2 = last ? nA : cA + (size_t)(t + 2) * kstep; const char* b2 = last ? nB : cB + (size_t)(t + 2) * kstep;
            const char* a3 = a2 + kstep; const char* b3 = b2 + kstep;
            if (last && has_next) S.a_ready(nxt);
            if constexpr (SP2) {
            PG8_LDB(B0, 0, 0); PG8_LDB(B1, 0, 1); PG8_SCHED; PG8_LDA(At, 0, 0); PG8_STAGE(PG8_SA(1, 1), a1 + hstepA, voffA);
            PG8_WAIT_V(8); PG8_WAIT_L(0); PG8_BAR; PG8_MMA(0, 0, At, B0); PG8_MMA(0, 1, At, B1); PG8_BAR; PG8_SCHED;
            PG8_LDA(At, 0, 1); PG8_STAGE(PG8_SB(0, 0), b2, voffB); PG8_STAGE(PG8_SB(0, 1), b2 + hstepB, voffB); PG8_STAGE(PG8_SA(0, 0), a2, voffA);
            PG8_WAIT_V(8); PG8_WAIT_L(0); PG8_BAR; PG8_MMA(1, 0, At, B0); PG8_MMA(1, 1, At, B1); PG8_BAR; PG8_SCHED;
            PG8_LDB(B0, 1, 0); PG8_LDB(B1, 1, 1); PG8_SCHED; PG8_LDA(At, 1, 0); PG8_STAGE(PG8_SA(0, 1), a2 + hstepA, voffA);
            PG8_WAIT_V(8); PG8_WAIT_L(0); PG8_BAR; PG8_MMA(0, 0, At, B0); PG8_MMA(0, 1, At, B1); PG8_BAR; PG8_SCHED;
            PG8_LDA(At, 1, 1); PG8_STAGE(PG8_SB(1, 0), b3, voffB); PG8_STAGE(PG8_SB(1, 1), b3 + hstepB, voffB); PG8_STAGE(PG8_SA(1, 0), a3, voffA);
            PG8_WAIT_V(8); PG8_WAIT_L(0); PG8_BAR; PG8_MMA(1, 0, At, B0); PG8_MMA(1, 1, At, B1); PG8_BAR; PG8_SCHED;
            } else {
            PG8_LDB(B0, 0, 0); PG8_SCHED; PG8_LDA(At, 0, 0); PG8_STAGE(PG8_SA(1, 1), a1 + hstepA, voffA);
            PG8_WAIT_L(8); PG8_BAR; PG8_WAIT_L(0); PG8_MMA(0, 0, At, B0); PG8_BAR; PG8_SCHED;
            PG8_LDB(B1, 0, 1); PG8_STAGE(PG8_SB(0, 0), b2, voffB);
            PG8_BAR; PG8_WAIT_L(0); PG8_MMA(0, 1, At, B1); PG8_BAR;
            PG8_LDA(At, 0, 1); PG8_STAGE(PG8_SA(0, 0), a2, voffA);
            PG8_BAR; PG8_WAIT_L(0); PG8_MMA(1, 0, At, B0); PG8_BAR; PG8_SCHED;
            PG8_STAGE(PG8_SB(0, 1), b2 + hstepB, voffB);
            PG8_WAIT_V(6); PG8_BAR; PG8_MMA(1, 1, At, B1); PG8_BAR;
            PG8_LDB(B0, 1, 0); PG8_SCHED; PG8_LDA(At, 1, 0); PG8_STAGE(PG8_SA(0, 1), a2 + hstepA, voffA);
            PG8_WAIT_L(8); PG8_BAR; PG8_WAIT_L(0); PG8_MMA(0, 0, At, B0); PG8_BAR; PG8_SCHED;
            PG8_LDB(B1, 1, 1); PG8_STAGE(PG8_SB(1, 0), b3, voffB);
            PG8_BAR; PG8_WAIT_L(0); PG8_MMA(0, 1, At, B1); PG8_BAR;
            PG8_LDA(At, 1, 1); PG8_STAGE(PG8_SA(1, 0), a3, voffA);
            PG8_BAR; PG8_WAIT_L(0); PG8_MMA(1, 0, At, B0); PG8_BAR; PG8_SCHED;
            PG8_STAGE(PG8_SB(1, 1), b3 + hstepB, voffB);
            PG8_WAIT_V(6); PG8_BAR; PG8_MMA(1, 1, At, B1); PG8_BAR;
            }
        }
        if constexpr (ALIGN_EPI) { if (wr == 0) PG8_BAR; }
        if constexpr (!Epi::AFTER_DRAIN) { E(acc, cur, wr, wc, fr, fq); S.done(cur); }
        if (!has_next) break;
#pragma unroll
        for (int a = 0; a < 2; ++a)
#pragma unroll
            for (int b = 0; b < 2; ++b)
#pragma unroll
                for (int m = 0; m < 4; ++m)
#pragma unroll
                    for (int n = 0; n < 2; ++n) acc[a][b][m][n] = (f32x4){0.f, 0.f, 0.f, 0.f};
        cur = nxt; cA = nA; cB = nB; ++ui;
        if constexpr (ALIGN_EPI) { if (wr == 1) PG8_BAR; }
    }
    PG8_WAIT_V(0);
    if constexpr (!ALIGN_EPI) { if (wr == 0) PG8_BAR; }
    PG8_BAR;
    if constexpr (Epi::AFTER_DRAIN) { E.fused(acc, cur, wr, wc, fr, fq, lds, wid, lane); S.done(cur); }
#undef PG8_SA
#undef PG8_SB
#undef PG8_STAGE
#undef PG8_LDA
#undef PG8_LDB
#undef PG8_MMA
#undef PG8_WAIT_V
#undef PG8_WAIT_L
#undef PG8_BAR
#undef PG8_SCHED
}
}
#ifndef MK_MULTI
#define MK_MULTI 0
#endif
#ifndef MK_SPIN
#define MK_SPIN -1
#endif
#ifndef MK_CGSYNC
#define MK_CGSYNC 0
#endif
#ifndef MK_REPMASK
#define MK_REPMASK 0
#endif

constexpr int NWAVES = 8, NTHREADS = 512;
constexpr int BATCH = 8, SEQ = 2048, DM = 1024, M = BATCH * SEQ, PROJ_W = 3072, DFF = 2816, UPW = 5632, NCHUNK = 16;
constexpr float EPS = 1e-6f;
constexpr size_t MiB = 1u << 20;
constexpr size_t WS_SSQ1 = 0, WS_SSQ2 = 65536, WS_SSQ0 = 262144, WS_BAR = 131072, WS_BAR_BYTES = 32768, WS_PCNT = 131072 + 16384, WS_ROPE = 1 * MiB, WS_SGUW = 2 * MiB, WS_WIN = 3 * MiB, WS_WOUT = 9 * MiB, WS_WUP = 11 * MiB, WS_WDOWN = 22 * MiB,
                 WS_EDGE = 28 * MiB, WS_XN = 40 * MiB, WS_PROJ = 72 * MiB, WS_MIX = 168 * MiB, WS_KV = 200 * MiB, WS_ACT = 72 * MiB, WS_END = 216 * MiB;
constexpr int LDS_BYTES = 147456, MISC_OFF = 147456 - 64;
constexpr int LP = 272;
constexpr int TILE_LDS = 128 * LP;

#define LAS __attribute__((address_space(3)))
typedef unsigned short bf16;
typedef unsigned v4u __attribute__((ext_vector_type(4)));
typedef unsigned v2u __attribute__((ext_vector_type(2)));
typedef float f32x4 __attribute__((ext_vector_type(4)));
typedef short bf16x8 __attribute__((ext_vector_type(8)));
__device__ __forceinline__ unsigned f2bf(float f) { unsigned u = __builtin_bit_cast(unsigned, f); return (u + 0x7fffu + ((u >> 16) & 1u)) >> 16; }
__device__ __forceinline__ unsigned pk2(float lo, float hi) { return f2bf(lo) | (f2bf(hi) << 16); }
__device__ __forceinline__ float bflo(unsigned w) { return __uint_as_float(w << 16); }
__device__ __forceinline__ float bfhi(unsigned w) { return __uint_as_float(w & 0xffff0000u); }
__device__ __forceinline__ float wave_sum(float v) {
#pragma unroll
    for (int o = 1; o < 64; o <<= 1) v += __shfl_xor(v, o);
    return v;
}

struct Frame {
    LAS unsigned char* lds; unsigned char* ws;
    int tid, lane, wave, G, bid;
    const float* in[15]; float* out;
};

__device__ __forceinline__ int dest_row(int map, int n) {
    if (map == 1) { if (n >= 1024) return n; const int d = n & 127; return (n & ~127) + 32 * ((d >> 4) & 3) + 8 * ((d >> 2) & 3) + 4 * (d >> 6) + (d & 3); }
    if (map == 2) { return n < DFF ? 256 * (n >> 7) + (n & 127) : 256 * ((n - DFF) >> 7) + 128 + ((n - DFF) & 127); }
    return n;
}
struct WItem { const float* W; bf16* WT; const float* kg; int K, N, map, item; };
__device__ __forceinline__ WItem witem_in(Frame& F, int it) { WItem w; w.W = F.in[2]; w.WT = (bf16*)(F.ws + WS_WIN); w.kg = F.in[1]; w.K = DM; w.N = PROJ_W; w.map = 1; w.item = it; return w; }
constexpr int I_IN = (DM / 64) * (PROJ_W / 32), I_OUT = (DM / 64) * (DM / 32), I_UP = (DM / 64) * (UPW / 32), I_DN = (DFF / 64) * (DM / 32), I_TAIL = I_OUT + I_UP;
__device__ __forceinline__ WItem witem_tail(Frame& F, int it) {
    WItem w; w.kg = nullptr; int r = it;
    if (r < I_OUT) { w.W = F.in[8]; w.WT = (bf16*)(F.ws + WS_WOUT); w.K = DM; w.N = DM; w.map = 0; w.item = r; return w; } r -= I_OUT;
    w.W = F.in[10]; w.WT = (bf16*)(F.ws + WS_WUP); w.K = DM; w.N = UPW; w.map = 2; w.item = r; return w;
}
__device__ __forceinline__ WItem witem_down(Frame& F, int it) { WItem w; w.kg = nullptr; w.W = F.in[13]; w.WT = (bf16*)(F.ws + WS_WDOWN); w.K = DFF; w.N = DM; w.map = 0; w.item = it; return w; }
__device__ __forceinline__ void witem_load(const WItem& w, f32x4 (&v)[8], int lane) {
    const int nblk = w.N / 32, kb = w.item / nblk, nb = w.item % nblk;
    const float* p = w.W + (size_t)(64 * kb + (lane >> 3)) * w.N + 32 * nb + 4 * (lane & 7);
#pragma unroll
    for (int i = 0; i < 8; ++i) v[i] = *(const f32x4*)(p + (size_t)(8 * i) * w.N);
}
__device__ __forceinline__ void witem_finish(const WItem& w, const f32x4 (&v)[8], LAS float* scr, int lane) {
    const int nblk = w.N / 32, kb = w.item / nblk, nb = w.item % nblk, k0 = 64 * kb, n0 = 32 * nb;
#pragma unroll
    for (int i = 0; i < 8; ++i) { LAS float* d = scr + (8 * i + (lane >> 3)) * 33 + 4 * (lane & 7); d[0] = v[i].x; d[1] = v[i].y; d[2] = v[i].z; d[3] = v[i].w; }
    asm volatile("s_waitcnt lgkmcnt(0)" ::: "memory");
    const int c = lane & 7;
    f32x4 g0 = (f32x4){1.f, 1.f, 1.f, 1.f}, g1 = g0;
    if (w.kg) { g0 = *(const f32x4*)(w.kg + k0 + 8 * c); g1 = *(const f32x4*)(w.kg + k0 + 8 * c + 4); }
#pragma unroll
    for (int j = 0; j < 4; ++j) { const int n = (lane >> 3) + 8 * j; const LAS float* s = scr + (8 * c) * 33 + n;
        v4u o; o.x = pk2(s[0 * 33] * g0[0], s[1 * 33] * g0[1]); o.y = pk2(s[2 * 33] * g0[2], s[3 * 33] * g0[3]); o.z = pk2(s[4 * 33] * g1[0], s[5 * 33] * g1[1]); o.w = pk2(s[6 * 33] * g1[2], s[7 * 33] * g1[3]);
        *(v4u*)(w.WT + (size_t)dest_row(w.map, n0 + n) * w.K + k0 + 8 * c) = o; }
    asm volatile("s_waitcnt lgkmcnt(0)" ::: "memory");
}

__device__ __forceinline__ void p0_prologue(Frame& F) {
    LAS float* scr = (LAS float*)(F.lds + F.wave * 16384);
    const int gw = F.bid * NWAVES + F.wave, NGW = F.G * NWAVES;
    const int gt = F.bid * NTHREADS + F.tid, NGT = F.G * NTHREADS;
    for (int it = gw; it < I_IN; it += NGW) { const WItem w = witem_in(F, it); f32x4 v[8]; witem_load(w, v, F.lane); witem_finish(w, v, scr, F.lane); }
    { float* rope = (float*)(F.ws + WS_ROPE);
      for (int i = gt; i < SEQ * 64; i += NGT) { const int pos = i >> 6, f = i & 63;
          const float inv = exp2f(-(float)f * (13.287712379549449f / 64.0f));
          const float ang = (float)pos * inv;
          double t = (double)ang * 0.15915494309189535; t -= rint(t); const float rv = (float)t;
          rope[pos * 128 + f] = __builtin_amdgcn_cosf(rv); rope[pos * 128 + 64 + f] = __builtin_amdgcn_sinf(rv); } }
    { float* z = (float*)(F.ws + WS_SSQ1); for (int i = gt; i < 2 * M; i += NGT) z[i] = 0.f; }
    { bf16* XB = (bf16*)(F.ws + WS_XN); float* ssq0 = (float*)(F.ws + WS_SSQ0);
      for (int m0 = gw * 4; m0 < M; m0 += NGW * 4) {
          f32x4 v[4][4]; float s[4];
#pragma unroll
          for (int r = 0; r < 4; ++r) { const f32x4* xr = (const f32x4*)(F.in[0] + (size_t)(m0 + r) * DM) + F.lane;
#pragma unroll
              for (int j = 0; j < 4; ++j) v[r][j] = xr[64 * j]; }
#pragma unroll
          for (int r = 0; r < 4; ++r) { s[r] = 0.f; v2u* o8 = (v2u*)(XB + (size_t)(m0 + r) * DM) + F.lane;
#pragma unroll
              for (int j = 0; j < 4; ++j) { const f32x4 y = v[r][j]; s[r] += (y.x * y.x + y.y * y.y) + (y.z * y.z + y.w * y.w); v2u w; w.x = pk2(y.x, y.y); w.y = pk2(y.z, y.w); o8[64 * j] = w; } }
#pragma unroll
          for (int o = 1; o < 64; o <<= 1) {
#pragma unroll
              for (int r = 0; r < 4; ++r) s[r] += __shfl_xor(s[r], o); }
          if (F.lane < 4) ssq0[m0 + F.lane] = F.lane == 0 ? s[0] : F.lane == 1 ? s[1] : F.lane == 2 ? s[2] : s[3]; } }
}

__device__ __forceinline__ void p1_tail(Frame& F) {
    LAS float* scr = (LAS float*)(F.lds + F.wave * 16384);
    const int gw = F.bid * NWAVES + F.wave, NGW = F.G * NWAVES;
    const int gt = F.bid * NTHREADS + F.tid, NGT = F.G * NTHREADS;
    int it = gw; f32x4 v[8];
    if (it < I_TAIL) { const WItem w = witem_tail(F, it); witem_load(w, v, F.lane); }
    while (it < I_TAIL) {
        const int nx = it + NGW; f32x4 vn[8];
#pragma unroll
        for (int i = 0; i < 8; ++i) vn[i] = v[i];
        if (nx < I_TAIL) { const WItem wn = witem_tail(F, nx); witem_load(wn, vn, F.lane); }
        { const WItem w = witem_tail(F, it); witem_finish(w, v, scr, F.lane); }
#pragma unroll
        for (int i = 0; i < 8; ++i) v[i] = vn[i];
        it = nx;
    }
    { const float* w = F.in[6]; bf16* o = (bf16*)(F.ws + WS_SGUW);
      for (int i = gt; i < 4 * 128 * 128; i += NGT) { const int t = (i >> 7) & 127, s = i & 127; o[i] = (bf16)f2bf(s <= t ? w[i] : 0.f); } }
}

typedef short s16x4 __attribute__((ext_vector_type(4)));
struct TileRegs { v4u v[4]; };
__device__ __forceinline__ void tile_fetch(TileRegs& t, const bf16* src, int ld, int tid) {
#pragma unroll
    for (int i = 0; i < 4; ++i) { const int c = tid + NTHREADS * i, row = c >> 4, ch = c & 15; t.v[i] = *(const v4u*)(src + (size_t)row * ld + ch * 8); }
}
template <bool SCALE> __device__ __forceinline__ void tile_stage(LAS unsigned char* dst, TileRegs& t, int tid, float lg) {
#pragma unroll
    for (int i = 0; i < 4; ++i) { const int c = tid + NTHREADS * i, row = c >> 4, ch = c & 15;
        if (SCALE) { const float sc = exp2f(lg * (float)(127 - row));
#pragma unroll
            for (int j = 0; j < 4; ++j) t.v[i][j] = pk2(bflo(t.v[i][j]) * sc, bfhi(t.v[i][j]) * sc); }
        *(LAS v4u*)(dst + row * LP + ch * 16) = t.v[i]; }
}
__device__ __forceinline__ bf16x8 frag_row(const LAS unsigned char* T, int r0, int ks, int fr, int fq) { return *(const LAS bf16x8*)(T + (r0 + fr) * LP + (32 * ks + 8 * fq) * 2); }
__device__ __forceinline__ bf16x8 frag_tr(const LAS unsigned char* T, int c0, int ks, int fr, int fq) {
    const LAS unsigned char* a = T + (32 * ks + 8 * fq + (fr >> 2)) * LP + c0 * 2 + 8 * (fr & 3);
    const s16x4 lo = __builtin_bit_cast(s16x4, __builtin_amdgcn_ds_read_tr16_b64_v4i16((LAS s16x4*)a));
    const s16x4 hi = __builtin_bit_cast(s16x4, __builtin_amdgcn_ds_read_tr16_b64_v4i16((LAS s16x4*)(a + 4 * LP)));
    return __builtin_shufflevector(lo, hi, 0, 1, 2, 3, 4, 5, 6, 7);
}
template <bool XTR, bool YTR> __device__ __forceinline__ void mm16(f32x4 (&acc)[8], const LAS unsigned char* X, const LAS unsigned char* Y, int w, int fr, int fq) {
#pragma unroll
    for (int ks = 0; ks < 4; ++ks) {
        const bf16x8 a = XTR ? frag_tr(X, 16 * w, ks, fr, fq) : frag_row(X, 16 * w, ks, fr, fq);
#pragma unroll
        for (int jh = 0; jh < 8; jh += 4) {
            bf16x8 bfr[4];
#pragma unroll
            for (int j = 0; j < 4; ++j) bfr[j] = YTR ? frag_tr(Y, 16 * (jh + j), ks, fr, fq) : frag_row(Y, 16 * (jh + j), ks, fr, fq);
#pragma unroll
            for (int j = 0; j < 4; ++j) acc[jh + j] = __builtin_amdgcn_mfma_f32_16x16x32_bf16(bfr[j], a, acc[jh + j], 0, 0, 0);
            __builtin_amdgcn_sched_barrier(0);
        }
    }
}
__device__ __forceinline__ float head_log2g(int h) { return log2f(1.0f - exp2f(-5.0f - (float)h)); }

struct KvRegs { TileRegs k, v; };
__device__ __forceinline__ void kv_fetch(Frame& F, KvRegs& r, int it) {
    const int bh = it >> 4, n = it & 15; const size_t tok0 = (size_t)(bh >> 2) * SEQ + 128 * n; const bf16* PROJ = (const bf16*)(F.ws + WS_PROJ);
    tile_fetch(r.k, PROJ + tok0 * PROJ_W + 512 + 128 * (bh & 3), PROJ_W, F.tid); tile_fetch(r.v, PROJ + tok0 * PROJ_W + 1024 + 128 * (bh & 3), PROJ_W, F.tid);
}
__device__ __forceinline__ void kv_stage(Frame& F, KvRegs& r, int it) {
    tile_stage<true>(F.lds, r.k, F.tid, head_log2g((it >> 4) & 3)); tile_stage<false>(F.lds + TILE_LDS, r.v, F.tid, 0.f);
}
__device__ __forceinline__ void kv_compute(Frame& F, int it, f32x4 (&acc)[8], bool first) {
    const int bh = it >> 4, n = it & 15; const int w = F.wave, fr = F.lane & 15, fq = F.lane >> 4;
    const float cd = first ? 0.f : exp2f(head_log2g(bh & 3) * 128.0f);
#pragma unroll
    for (int j = 0; j < 8; ++j) acc[j] = acc[j] * cd;
    mm16<true, true>(acc, F.lds + TILE_LDS, F.lds, w, fr, fq);
    bf16* o = (bf16*)(F.ws + WS_KV) + ((size_t)(bh * NCHUNK + n) * 128 + 16 * w + fr) * 128 + 4 * fq;
#pragma unroll
    for (int j = 0; j < 8; ++j) { v2u wv; wv.x = pk2(acc[j][0], acc[j][1]); wv.y = pk2(acc[j][2], acc[j][3]); *(v2u*)(o + 16 * j) = wv; }
}

struct SguRegs { TileRegs wt; v4u sv[4]; v2u up[8]; float bs; };
__device__ __forceinline__ void sgu_fetch(Frame& F, SguRegs& r, int it) {
    const int b = it >> 6, n = (it >> 2) & 15, g = it & 3; const size_t tok0 = (size_t)b * SEQ + 128 * n; const bf16* PROJ = (const bf16*)(F.ws + WS_PROJ);
    tile_fetch(r.wt, (const bf16*)(F.ws + WS_SGUW) + g * 16384, 128, F.tid);
    { const int t = F.tid >> 2, qd = F.tid & 3; const v4u* p = (const v4u*)(PROJ + (tok0 + t) * PROJ_W + 2560 + 128 * g + 32 * qd);
#pragma unroll
      for (int c = 0; c < 4; ++c) r.sv[c] = p[c]; }
    { const int t = 16 * F.wave + (F.lane & 15); const bf16* up = PROJ + (tok0 + t) * PROJ_W + 2048 + 128 * g + 4 * (F.lane >> 4);
#pragma unroll
      for (int j = 0; j < 8; ++j) r.up[j] = *(const v2u*)(up + 16 * j);
      r.bs = F.in[7][128 * g + t]; }
}
__device__ __forceinline__ void sgu_stage(Frame& F, SguRegs& r, int it) {
    const int g = it & 3; LAS unsigned char* vn = F.lds + TILE_LDS;
    tile_stage<false>(F.lds, r.wt, F.tid, 0.f);
    const int t = F.tid >> 2, qd = F.tid & 3;
    float v[32];
#pragma unroll
    for (int c = 0; c < 4; ++c)
#pragma unroll
        for (int j = 0; j < 4; ++j) { v[8 * c + 2 * j] = bflo(r.sv[c][j]); v[8 * c + 2 * j + 1] = bfhi(r.sv[c][j]); }
    float s = 0.f;
#pragma unroll
    for (int i = 0; i < 32; ++i) s += v[i];
    s += __shfl_xor(s, 1); s += __shfl_xor(s, 2);
    const float mu = s * (1.0f / 128.0f); float q = 0.f;
#pragma unroll
    for (int i = 0; i < 32; ++i) { v[i] -= mu; q += v[i] * v[i]; }
    q += __shfl_xor(q, 1); q += __shfl_xor(q, 2);
    const float rstd = 1.0f / sqrtf(q * (1.0f / 128.0f) + EPS);
    const f32x4* lng = (const f32x4*)(F.in[4] + 128 * g + 32 * qd); const f32x4* lnb = (const f32x4*)(F.in[5] + 128 * g + 32 * qd);
#pragma unroll
    for (int c = 0; c < 4; ++c) { const f32x4 g0 = lng[2 * c], g1 = lng[2 * c + 1], b0 = lnb[2 * c], b1 = lnb[2 * c + 1]; v4u o;
        o.x = pk2(v[8 * c + 0] * rstd * g0[0] + b0[0], v[8 * c + 1] * rstd * g0[1] + b0[1]); o.y = pk2(v[8 * c + 2] * rstd * g0[2] + b0[2], v[8 * c + 3] * rstd * g0[3] + b0[3]);
        o.z = pk2(v[8 * c + 4] * rstd * g1[0] + b1[0], v[8 * c + 5] * rstd * g1[1] + b1[1]); o.w = pk2(v[8 * c + 6] * rstd * g1[2] + b1[2], v[8 * c + 7] * rstd * g1[3] + b1[3]);
        *(LAS v4u*)(vn + t * LP + qd * 64 + c * 16) = o; }
}
__device__ __forceinline__ void sgu_compute(Frame& F, const v2u (&upv)[8], float bs, int it) {
    const int b = it >> 6, n = (it >> 2) & 15, g = it & 3; const size_t tok0 = (size_t)b * SEQ + 128 * n;
    const int w = F.wave, fr = F.lane & 15, fq = F.lane >> 4;
    f32x4 acc[8];
#pragma unroll
    for (int j = 0; j < 8; ++j) acc[j] = (f32x4){0.f, 0.f, 0.f, 0.f};
    mm16<false, true>(acc, F.lds, F.lds + TILE_LDS, w, fr, fq);
    const int t = 16 * w + fr;
    bf16* o = (bf16*)(F.ws + WS_MIX) + (tok0 + t) * DM + 512 + 128 * g + 4 * fq;
#pragma unroll
    for (int j = 0; j < 8; ++j) { const v2u uu = upv[j];
        v2u wv; wv.x = pk2(bflo(uu.x) * (acc[j][0] + bs), bfhi(uu.x) * (acc[j][1] + bs)); wv.y = pk2(bflo(uu.y) * (acc[j][2] + bs), bfhi(uu.y) * (acc[j][3] + bs));
        *(v2u*)(o + 16 * j) = wv; }
}
__device__ __forceinline__ void p2_phase(Frame& F) {
    const int k0 = 2 * F.bid, k1 = 2 * F.bid + 1, s0 = F.bid, s1 = F.bid + 256;
    KvRegs kr; SguRegs sr; f32x4 kacc[8];
#pragma unroll
    for (int j = 0; j < 8; ++j) kacc[j] = (f32x4){0.f, 0.f, 0.f, 0.f};
    kv_fetch(F, kr, k0);
    __syncthreads(); kv_stage(F, kr, k0); kv_fetch(F, kr, k1); __syncthreads(); kv_compute(F, k0, kacc, true);
    __syncthreads(); kv_stage(F, kr, k1); sgu_fetch(F, sr, s0); __syncthreads(); kv_compute(F, k1, kacc, false);
    v2u upv[8]; float bs;
    __syncthreads(); sgu_stage(F, sr, s0);
#pragma unroll
    for (int j = 0; j < 8; ++j) upv[j] = sr.up[j];
    bs = sr.bs; sgu_fetch(F, sr, s1); __syncthreads(); sgu_compute(F, upv, bs, s0);
    __syncthreads(); sgu_stage(F, sr, s1); __syncthreads(); sgu_compute(F, sr.up, sr.bs, s1);
}

template <int NB> __device__ __forceinline__ void kv_horner(float (&s)[4][8], const bf16* kv, int slot0, int cnt, float f) {
#pragma unroll 1
    for (int jc = 0; jc < cnt; jc += NB) {
        const bf16* kp = kv + (size_t)(slot0 + 2 * jc) * 16384;
        v4u x[NB][4];
#pragma unroll
        for (int u = 0; u < NB; ++u) if (jc + u < cnt) {
#pragma unroll
            for (int i = 0; i < 4; ++i) x[u][i] = *(const v4u*)(kp + (size_t)u * 32768 + (size_t)(NTHREADS * i) * 8); }
#pragma unroll
        for (int u = 0; u < NB; ++u) if (jc + u < cnt) {
#pragma unroll
            for (int i = 0; i < 4; ++i)
#pragma unroll
                for (int j = 0; j < 4; ++j) { s[i][2 * j] = s[i][2 * j] * f + bflo(x[u][i][j]); s[i][2 * j + 1] = s[i][2 * j + 1] * f + bfhi(x[u][i][j]); } }
    }
}
__device__ __forceinline__ void kv_step1(float (&s)[4][8], const bf16* kv, int slot, bool take, float f) {
    v4u x[4];
#pragma unroll
    for (int i = 0; i < 4; ++i) x[i] = (v4u){0u, 0u, 0u, 0u};
    if (take) {
#pragma unroll
        for (int i = 0; i < 4; ++i) x[i] = *(const v4u*)(kv + (size_t)slot * 16384 + (size_t)(NTHREADS * i) * 8); }
#pragma unroll
    for (int i = 0; i < 4; ++i)
#pragma unroll
        for (int j = 0; j < 4; ++j) { s[i][2 * j] = s[i][2 * j] * f + bflo(x[i][j]); s[i][2 * j + 1] = s[i][2 * j + 1] * f + bfhi(x[i][j]); }
}
__device__ __forceinline__ void ret_pair(Frame& F, int bh, int n_small) {
    const int b = bh >> 2, h = bh & 3;
    const bf16* PROJ = (const bf16*)(F.ws + WS_PROJ);
    LAS unsigned char* Qs = F.lds; LAS unsigned char* Ks = F.lds + TILE_LDS; LAS unsigned char* Vs = F.lds + 2 * TILE_LDS; LAS unsigned char* St = F.lds + 3 * TILE_LDS;
    const float lg = head_log2g(h); const float cd = exp2f(lg * 128.0f);
    const int w = F.wave, fr = F.lane & 15, fq = F.lane >> 4; const int q = 16 * w + fr;
    const int n_big = 15 - n_small;
    v4u sb[4]; TileRegs tq, tk, tv;
    { const size_t tok0 = (size_t)b * SEQ + 128 * n_small;
      tile_fetch(tq, PROJ + tok0 * PROJ_W + 128 * h, PROJ_W, F.tid); tile_fetch(tk, PROJ + tok0 * PROJ_W + 512 + 128 * h, PROJ_W, F.tid); tile_fetch(tv, PROJ + tok0 * PROJ_W + 1024 + 128 * h, PROJ_W, F.tid); }
    __syncthreads();
    { const bf16* kv = (const bf16*)(F.ws + WS_KV) + (size_t)bh * NCHUNK * 16384 + (size_t)F.tid * 8;
      float s[4][8];
#pragma unroll
      for (int i = 0; i < 4; ++i)
#pragma unroll
          for (int j = 0; j < 8; ++j) s[i][j] = 0.f;
      const int a = n_small >> 1; const bool odd = (n_small & 1) != 0; const float cd2 = cd * cd;
      kv_horner<4>(s, kv, 1, a, cd2);
      { v4u x[4];
#pragma unroll
        for (int i = 0; i < 4; ++i) x[i] = (v4u){0u, 0u, 0u, 0u};
        if (odd) {
#pragma unroll
            for (int i = 0; i < 4; ++i) x[i] = *(const v4u*)(kv + (size_t)(2 * a) * 16384 + (size_t)(NTHREADS * i) * 8); }
        const float f1 = odd ? cd : 1.0f;
        if (n_small > 0) {
#pragma unroll
            for (int i = 0; i < 4; ++i) { const int c = F.tid + NTHREADS * i, e = c >> 4, ch = c & 15; v4u o;
#pragma unroll
                for (int j = 0; j < 4; ++j) o[j] = pk2(s[i][2 * j] * f1 + bflo(x[i][j]), s[i][2 * j + 1] * f1 + bfhi(x[i][j]));
                *(LAS v4u*)(St + e * LP + ch * 16) = o; } } }
      kv_horner<4>(s, kv, 2 * a + 1, 7 - 2 * a, cd2);
      kv_step1(s, kv, 14 - 2 * a, !odd, odd ? 1.0f : cd);
#pragma unroll
      for (int i = 0; i < 4; ++i) { sb[i].x = pk2(s[i][0], s[i][1]); sb[i].y = pk2(s[i][2], s[i][3]); sb[i].z = pk2(s[i][4], s[i][5]); sb[i].w = pk2(s[i][6], s[i][7]); }
    }
#pragma unroll 1
    for (int pass = 0; pass < 2; ++pass) {
        const int n = pass == 0 ? n_small : n_big; const size_t tok0 = (size_t)b * SEQ + 128 * n;
        int opq = 0; asm volatile("" : "+v"(opq));
        if (pass == 1) { __syncthreads();
#pragma unroll
            for (int i = 0; i < 4; ++i) { const int c = F.tid + NTHREADS * i, e = c >> 4, ch = c & 15; *(LAS v4u*)(St + e * LP + ch * 16) = sb[i]; } }
        if (pass == 1) { tile_fetch(tq, PROJ + tok0 * PROJ_W + 128 * h, PROJ_W, F.tid); tile_fetch(tk, PROJ + tok0 * PROJ_W + 512 + 128 * h, PROJ_W, F.tid); tile_fetch(tv, PROJ + tok0 * PROJ_W + 1024 + 128 * h, PROJ_W, F.tid); }
        tile_stage<false>(Qs, tq, F.tid, 0.f); tile_stage<false>(Ks, tk, F.tid, 0.f); tile_stage<false>(Vs, tv, F.tid, 0.f);
        v2u gg[8]; const bf16* gp = PROJ + (tok0 + q) * PROJ_W + 1536 + 128 * h + 4 * fq;
#pragma unroll
        for (int j = 0; j < 8; ++j) gg[j] = *(const v2u*)(gp + 16 * j);
        __syncthreads();
        f32x4 sc[8], oc[8];
#pragma unroll
        for (int j = 0; j < 8; ++j) { sc[j] = (f32x4){0.f, 0.f, 0.f, 0.f}; oc[j] = (f32x4){0.f, 0.f, 0.f, 0.f}; }
        mm16<false, false>(sc, Qs, Ks, w, fr, fq);
        if (n > 0) { mm16<false, false>(oc, Qs, St, w, fr, fq); const float qd = exp2f(lg * (float)(q + 1 + opq));
#pragma unroll
            for (int j = 0; j < 8; ++j) oc[j] = oc[j] * qd; }
#pragma unroll
        for (int j = 0; j < 8; ++j) { float pv[4];
#pragma unroll
            for (int i = 0; i < 4; ++i) { const int k = 16 * j + 4 * fq + i; pv[i] = (q >= k) ? sc[j][i] * exp2f(lg * (float)(q - k + opq)) : 0.f; }
            v2u wv; wv.x = pk2(pv[0], pv[1]); wv.y = pk2(pv[2], pv[3]); *(LAS v2u*)(Qs + q * LP + (16 * j + 4 * fq) * 2) = wv; }
        asm volatile("s_waitcnt lgkmcnt(0)" ::: "memory");
        mm16<false, true>(oc, Qs, Vs, w, fr, fq);
        float ss = 0.f;
#pragma unroll
        for (int j = 0; j < 8; ++j) ss += (oc[j][0] * oc[j][0] + oc[j][1] * oc[j][1]) + (oc[j][2] * oc[j][2] + oc[j][3] * oc[j][3]);
        ss += __shfl_xor(ss, 16); ss += __shfl_xor(ss, 32);
        const float rstd = 1.0f / sqrtf(ss * (1.0f / 128.0f) + EPS);
        const float* rg = F.in[3] + 128 * h + 4 * fq + opq;
        bf16* o = (bf16*)(F.ws + WS_MIX) + (tok0 + q) * DM + 128 * h + 4 * fq;
#pragma unroll
        for (int j = 0; j < 8; ++j) { const f32x4 rgv = *(const f32x4*)(rg + 16 * j);
            v2u wv; wv.x = pk2(oc[j][0] * rstd * rgv[0] * bflo(gg[j].x), oc[j][1] * rstd * rgv[1] * bfhi(gg[j].x));
            wv.y = pk2(oc[j][2] * rstd * rgv[2] * bflo(gg[j].y), oc[j][3] * rstd * rgv[3] * bfhi(gg[j].y));
            *(v2u*)(o + 16 * j) = wv; }
    }
}

#define XB_TMO      128
#define XB_XCNT(j)  (256  + 64 * (j))
#define XB_XSUB(j)  (1280 + 64 * (j))
#define XB_XGEN(j)  (2304 + 64 * (j))
#define XB_TOP      3328
#define XB_TOPGEN   3392
#define XCD_BAR_WORDS 3456
#define XB_SPIN_CAP (1u << 18)
__device__ __forceinline__ unsigned xb_ld(unsigned* p)              { return __hip_atomic_load(p, __ATOMIC_RELAXED, __HIP_MEMORY_SCOPE_AGENT); }
__device__ __forceinline__ unsigned xb_add(unsigned* p, unsigned v) { return __hip_atomic_fetch_add(p, v, __ATOMIC_RELAXED, __HIP_MEMORY_SCOPE_AGENT); }
__device__ __forceinline__ unsigned xb_xcc_id() { return (unsigned)__builtin_amdgcn_s_getreg((3 << 11) | 20) & 0xFu; }
#define XB_SPIN(cond, bar) do { unsigned _sp = 0; while (cond) { __builtin_amdgcn_s_sleep(1); \
    if ((++_sp & 255u) == 0u) { if (xb_ld(&(bar)[XB_TMO])) break; if (_sp > XB_SPIN_CAP) { atomicAdd(&(bar)[XB_TMO], 1u); break; } } } } while (0)
struct XcdBarrier { unsigned* bar; unsigned x; volatile LAS unsigned* st; };
__device__ __forceinline__ XcdBarrier xcd_barrier_post(unsigned* bar, volatile LAS unsigned* st) {
    XcdBarrier b; b.bar = bar; b.x = xb_xcc_id(); b.st = st;
    if (threadIdx.x == 0) (void)xb_add(&bar[XB_XCNT(b.x)], 1u);
    return b;
}
__device__ __forceinline__ void xcd_barrier_complete(unsigned* bar, unsigned x, unsigned& nloc, unsigned& nx) {
    const unsigned G = gridDim.x * gridDim.y * gridDim.z;
    unsigned sum, cnt, mine, sp = 0u;
    for (;;) {
        sum = 0u; cnt = 0u; mine = 0u;
#pragma unroll
        for (unsigned j = 0; j < 16; ++j) { const unsigned c = xb_ld(&bar[XB_XCNT(j)]); sum += c; cnt += (c > 0u) ? 1u : 0u; mine = (j == x) ? c : mine; }
        if (sum == G) break;
        __builtin_amdgcn_s_sleep(1);
        if ((++sp & 255u) == 0u) { if (xb_ld(&bar[XB_TMO])) break; if (sp > XB_SPIN_CAP) { atomicAdd(&bar[XB_TMO], 1u); break; } }
    }
    nloc = mine > 0u ? mine : 1u; nx = cnt > 0u ? cnt : 1u;
}
__device__ __forceinline__ void xcd_barrier(const XcdBarrier& b) {
    asm volatile("s_waitcnt vmcnt(0)" ::: "memory");
    __syncthreads();
    if (threadIdx.x == 0) {
        unsigned* bar = b.bar;
        __builtin_amdgcn_s_waitcnt(0);
        unsigned nloc = b.st[0], nx = b.st[1];
        if (nloc == 0u) { xcd_barrier_complete(bar, b.x, nloc, nx); b.st[0] = nloc; b.st[1] = nx; }
        const unsigned old = xb_add(&bar[XB_XSUB(b.x)], 1u);
        const unsigned gen = old / nloc;
        if (old + 1u == (gen + 1u) * nloc) {
            __builtin_amdgcn_fence(__ATOMIC_RELEASE, "agent");
            asm volatile("s_waitcnt vmcnt(0)" ::: "memory");
            const unsigned og = xb_add(&bar[XB_TOP], 1u);
            const unsigned tg = og / nx;
            if (og + 1u == (tg + 1u) * nx) xb_add(&bar[XB_TOPGEN], 1u);
            else XB_SPIN(xb_ld(&bar[XB_TOPGEN]) == tg, bar);
            __builtin_amdgcn_fence(__ATOMIC_ACQUIRE, "agent");
            xb_add(&bar[XB_XGEN(b.x)], 1u);
            asm volatile("s_waitcnt vmcnt(0)" ::: "memory");
        } else {
            XB_SPIN(xb_ld(&bar[XB_XGEN(b.x)]) == gen, bar);
            __builtin_amdgcn_fence(__ATOMIC_ACQUIRE, "agent");
            asm volatile("s_waitcnt vmcnt(0)" ::: "memory");
        }
    }
    __syncthreads();
}

struct Args { const float* in[15]; float* out; unsigned char* ws; int ph_lo, ph_hi; };
constexpr int NPHASE = 7;
__global__ void __launch_bounds__(NTHREADS, 2) fwd_megakernel(Args args) {
    extern __shared__ __attribute__((aligned(16))) unsigned char lds[];
    Frame F;
    F.lds = (LAS unsigned char*)lds; F.ws = args.ws;
    F.tid = threadIdx.x; F.lane = F.tid & 63; F.wave = __builtin_amdgcn_readfirstlane(F.tid >> 6);
    F.G = gridDim.x; F.bid = blockIdx.x;
#pragma unroll
    for (int i = 0; i < 15; ++i) F.in[i] = args.in[i];
    F.out = args.out;
    const int lo = args.ph_lo, hi = args.ph_hi;
    volatile LAS unsigned* MISC = (volatile LAS unsigned*)(F.lds + MISC_OFF);
    if (F.tid < 16) MISC[F.tid] = 0u;
    __syncthreads();
    XcdBarrier bar; bar.bar = (unsigned*)(F.ws + WS_BAR); bar.x = 0; bar.st = nullptr;
    if (hi - lo > 1) bar = xcd_barrier_post((unsigned*)(F.ws + WS_BAR), MISC);
    if (lo < 0) cg::this_grid().sync();
#define IN(k) (lo <= (k) && (k) < hi)
#if MK_CGSYNC
#define SEAM(k) do { if (IN(k) && IN((k) + 1)) cg::this_grid().sync(); } while (0)
#else
#define SEAM(k) do { if (IN(k) && IN((k) + 1)) xcd_barrier(bar); } while (0)
#endif
#if MK_SPIN >= 0
    unsigned long long t0_ = 0;
#define PH_BEGIN(k) do { if ((k) == MK_SPIN) t0_ = __builtin_amdgcn_s_memrealtime(); } while (0)
#define PH_END(k) do { if ((k) == MK_SPIN) { asm volatile("s_waitcnt vmcnt(0)" ::: "memory"); const unsigned long long t1_ = __builtin_amdgcn_s_memrealtime(); while (__builtin_amdgcn_s_memrealtime() - t1_ < (t1_ - t0_)) __builtin_amdgcn_s_sleep(8); } } while (0)
#else
#define PH_BEGIN(k) do {} while (0)
#define PH_END(k) do {} while (0)
#endif

    PH_BEGIN(0);
    if (IN(0)) p0_prologue(F);
    PH_END(0);
    SEAM(0);
    PH_BEGIN(1);
    if (IN(1)) {
        pg8::Gemm g{(const bf16*)(F.ws + WS_XN), (const bf16*)(F.ws + WS_WIN), M, PROJ_W, DM}; pg8::StaticOrder S; S.init(M, PROJ_W, F.G, F.bid);
        pg8::EpiProj E{(bf16*)(F.ws + WS_PROJ), (const float*)(F.ws + WS_ROPE), (const float*)(F.ws + WS_SSQ0)};
        pg8::gemm_phase<pg8::EpiProj, pg8::StaticOrder, true, true>(F.lds, g, S, E);
        p1_tail(F);
    }
    PH_END(1);
    SEAM(1);
    PH_BEGIN(2);
    if (IN(2)) p2_phase(F);
    PH_END(2);
    SEAM(2);
    PH_BEGIN(3);
    if (IN(3)) {
        for (int it = F.bid; it < 256; it += F.G) ret_pair(F, it >> 3, it & 7);
        __syncthreads();
    }
    PH_END(3);
    SEAM(3);
    PH_BEGIN(4);
    if (IN(4)) {
        pg8::Gemm g{(const bf16*)(F.ws + WS_MIX), (const bf16*)(F.ws + WS_WOUT), M, DM, DM}; pg8::StaticOrder S; S.init(M, DM, F.G, F.bid);
        pg8::EpiRes<true> E{(const bf16*)(F.ws + WS_XN), F.out, (bf16*)(F.ws + WS_XN), F.in[9], (float*)(F.ws + WS_SSQ1)};
        pg8::gemm_phase<pg8::EpiRes<true>, pg8::StaticOrder, false, true>(F.lds, g, S, E);
    }
    PH_END(4);
    SEAM(4);
    PH_BEGIN(5);
    if (IN(5)) {
        pg8::Gemm g{(const bf16*)(F.ws + WS_XN), (const bf16*)(F.ws + WS_WUP), M, UPW, DM}; pg8::StaticOrder S; S.init(M, UPW, F.G, F.bid);
        pg8::EpiConv E{(const float*)(F.ws + WS_SSQ1), F.in[11], F.in[12], (bf16*)(F.ws + WS_ACT), (float*)(F.ws + WS_EDGE)};
        pg8::gemm_phase<pg8::EpiConv, pg8::StaticOrder, true, true>(F.lds, g, S, E);
        if (2 * F.bid >= F.G) { LAS float* scr = (LAS float*)(F.lds + F.wave * 16384); const int hw = (F.bid - F.G / 2) * NWAVES + F.wave, NHW = (F.G - F.G / 2) * NWAVES;
            for (int it = hw; it < I_DN; it += NHW) { const WItem w = witem_down(F, it); f32x4 v[8]; witem_load(w, v, F.lane); witem_finish(w, v, scr, F.lane); } }
    }
    PH_END(5);
    SEAM(5);
    PH_BEGIN(6);
    if (IN(6)) {
        pg8::Gemm g{(const bf16*)(F.ws + WS_ACT), (const bf16*)(F.ws + WS_WDOWN), M, DM, DFF}; pg8::StaticOrder S; S.init(M, DM, F.G, F.bid);
        pg8::Unit u0;
        if (S.next(0, u0)) {
            const float* edge = (const float*)(F.ws + WS_EDGE); const float* cw = F.in[11]; const float* cb = F.in[12]; bf16* act = (bf16*)(F.ws + WS_ACT);
            for (int i = F.tid; i < 2 * (DFF / 4); i += NTHREADS) { const int rl = i >= (DFF / 4) ? 1 : 0; const int run = 2 * u0.pm + rl, c = 4 * (i - rl * (DFF / 4));
                const float* e = edge + (size_t)run * 4 * UPW; const bool first = (run & 15) == 0;
                f32x4 y0[2], y1[2];
#pragma unroll
                for (int hb = 0; hb < 2; ++hb) { const int cc = c + hb * DFF; const f32x4 z = (f32x4){0.f, 0.f, 0.f, 0.f};
                    const f32x4 f0 = *(const f32x4*)(e + cc), f1 = *(const f32x4*)(e + UPW + cc);
                    const f32x4 p2 = first ? z : *(const f32x4*)(e + cc - 2 * UPW), p1 = first ? z : *(const f32x4*)(e + cc - UPW);
                    const f32x4 w0 = *(const f32x4*)(cw + cc), w1 = *(const f32x4*)(cw + UPW + cc), w2 = *(const f32x4*)(cw + 2 * UPW + cc), bb = *(const f32x4*)(cb + cc);
                    y0[hb] = w2 * f0 + w1 * p1 + w0 * p2 + bb; y1[hb] = w2 * f1 + w1 * f0 + w0 * p1 + bb; }
                *(v2u*)(act + (size_t)(128 * run) * DFF + c) = (v2u){pk2(pg8::silu_f(y0[0][0]) * y0[1][0], pg8::silu_f(y0[0][1]) * y0[1][1]), pk2(pg8::silu_f(y0[0][2]) * y0[1][2], pg8::silu_f(y0[0][3]) * y0[1][3])};
                *(v2u*)(act + (size_t)(128 * run + 1) * DFF + c) = (v2u){pk2(pg8::silu_f(y1[0][0]) * y1[1][0], pg8::silu_f(y1[0][1]) * y1[1][1]), pk2(pg8::silu_f(y1[0][2]) * y1[1][2], pg8::silu_f(y1[0][3]) * y1[1][3])}; }
            asm volatile("s_waitcnt vmcnt(0)" ::: "memory");
            __syncthreads();
        }
        pg8::EpiFinal E{(const bf16*)(F.ws + WS_XN), F.in[9], F.out, F.in[14], (float*)(F.ws + WS_SSQ2), (unsigned*)(F.ws + WS_PCNT)};
        pg8::gemm_phase<pg8::EpiFinal, pg8::StaticOrder, true, true>(F.lds, g, S, E);
    }
    PH_END(6);
#undef IN
#undef SEAM
}

extern "C" void kernel_launch(void* const* d_in, const int* in_sizes, int n_in, void* d_out, int out_size, void* d_ws, size_t ws_size, hipStream_t stream) {
    static int grid = 0;
    if (grid == 0) {
        if (n_in != 15 || out_size != M * DM || ws_size < WS_END) { fprintf(stderr, "kernel_launch: unexpected shapes (n_in %d out %d ws %zu)\n", n_in, out_size, ws_size); grid = -1; return; }
        if (hipFuncSetAttribute((const void*)fwd_megakernel, hipFuncAttributeMaxDynamicSharedMemorySize, LDS_BYTES) != hipSuccess) { fprintf(stderr, "kernel_launch: hipFuncSetAttribute failed\n"); grid = -1; return; }
        int dev = 0, cus = 0, per_cu = 0;
        (void)hipGetDevice(&dev); (void)hipDeviceGetAttribute(&cus, hipDeviceAttributeMultiprocessorCount, dev);
        (void)hipOccupancyMaxActiveBlocksPerMultiprocessor(&per_cu, (const void*)fwd_megakernel, NTHREADS, LDS_BYTES);
        (void)hipGetLastError();
        if (per_cu < 1) per_cu = 1;
        grid = cus > 0 ? cus : 256;
    }
    if (grid < 0) return;
    Args a{};
    for (int i = 0; i < 15; ++i) a.in[i] = (const float*)d_in[i];
    a.out = (float*)d_out; a.ws = (unsigned char*)d_ws;
    if (hipMemsetAsync((char*)d_ws + WS_BAR, 0, WS_BAR_BYTES, stream) != hipSuccess) { fprintf(stderr, "kernel_launch: memset failed\n"); return; }
#if MK_MULTI
    for (int p = 0; p < NPHASE; ++p) { a.ph_lo = p; a.ph_hi = p + 1; const int reps = ((MK_REPMASK >> p) & 1) ? 2 : 1;
        for (int r = 0; r < reps; ++r) hipLaunchKernelGGL(fwd_megakernel, dim3(grid), dim3(NTHREADS), LDS_BYTES, stream, a); }
#else
    a.ph_lo = 0; a.ph_hi = NPHASE;
    void* kargs[] = {&a};
    hipError_t e = hipLaunchCooperativeKernel((const void*)fwd_megakernel, dim3(grid), dim3(NTHREADS), kargs, LDS_BYTES, stream);
    if (e != hipSuccess) fprintf(stderr, "cooperative launch failed: %s (grid %d)\n", hipGetErrorString(e), grid);
#endif
}
```

```cpp
#include <hip/hip_runtime.h>
#include <hip/hip_cooperative_groups.h>
#include <cstdio>
#include <cstdint>
namespace cg = cooperative_groups;
#ifndef MK_SPIN_EPI
#define MK_SPIN_EPI 0
#endif

namespace pg8 {
#define PG8_LAS __attribute__((address_space(3)))
typedef unsigned short bf16_t;
typedef short bf16x8 __attribute__((ext_vector_type(8)));
typedef float f32x4 __attribute__((ext_vector_type(4)));
typedef float f32x2 __attribute__((ext_vector_type(2)));
typedef unsigned u32x4 __attribute__((ext_vector_type(4)));
typedef unsigned u32x2 __attribute__((ext_vector_type(2)));
constexpr int BM = 256, BK = 64, HALF = 128, HTB = HALF * BK * 2  , STAGE_BYTES = 8 * HTB, NXCD = 8, WGM = 8;

__host__ __device__ __forceinline__ int lds_byte(int r, int c) { const int st = (r >> 4) * 2 + (c >> 5), rr = r & 15, cc = c & 31, ob = rr * 64 + cc * 2; return st * 1024 + (ob ^ (((ob >> 9) & 1) << 5)); }
__host__ __device__ __forceinline__ void stage_rc(int b, int& R, int& C) { const int st = b / 1024, sb = b % 1024, swz = sb ^ (((sb >> 9) & 1) << 5); R = (st >> 1) * 16 + swz / 64; C = (st & 1) * 32 + (swz % 64) / 2; }
__host__ __device__ __forceinline__ int perm32(int rho) { const int n = rho >> 4, i = rho & 15; return 8 * (i >> 2) + 4 * n + (i & 3); }
__host__ __device__ __forceinline__ int tokrow(int R) { return 128 * (R >> 6) + 8 * (R & 15) + ((R >> 4) & 3); }

struct Unit { int pm, pn; };
struct Gemm { const bf16_t* A; const bf16_t* Bt; int M, N, K; };

struct StaticOrder {
    int nM, nN, nwg, G, c;
    __host__ __device__ void init(int M, int N, int G_, int c_) { nM = M / BM; nN = N / BM; nwg = nM * nN; G = G_; c = c_; }
    __host__ __device__ bool next(int i, Unit& u) const {
        const long L = (long)i * G + c; if (L >= nwg) return false;
        int wgid = (int)L; { const int q = nwg / NXCD, r = nwg % NXCD, xcd = wgid % NXCD, off = wgid / NXCD; wgid = (xcd < r ? xcd * (q + 1) : r * (q + 1) + (xcd - r) * q) + off; }
        const int nig = WGM * nN, gid = wgid / nig, fm = gid * WGM, gsz = (nM - fm) < WGM ? (nM - fm) : WGM;
        u.pm = fm + ((wgid % nig) % gsz); u.pn = (wgid % nig) / gsz; return true;
    }
    __device__ __forceinline__ void a_ready(const Unit&) const {}
    __device__ __forceinline__ void done(const Unit&) const {}
};

__device__ __forceinline__ unsigned cvt_pk_bf16(float lo, float hi) { unsigned r; asm volatile("v_cvt_pk_bf16_f32 %0, %1, %2" : "=v"(r) : "v"(lo), "v"(hi)); return r; }
__device__ __forceinline__ f32x2 gelu_pk(f32x2 v) {
    const f32x2 av = __builtin_elementwise_abs(v), d = av * 0.2316418882f + 1.0f;
    f32x2 t; t.x = __builtin_amdgcn_rcpf(d.x); t.y = __builtin_amdgcn_rcpf(d.y);
    f32x2 q = t * 0.5307027145f + (-0.7265760135f); q = q * t + 0.7107068705f; q = q * t + (-0.142248368f); q = q * t + 0.127414796f; q = q * t;
    const f32x2 s = (v * v) * (-0.72134752044f);
    f32x2 e; e.x = __builtin_amdgcn_exp2f(s.x); e.y = __builtin_amdgcn_exp2f(s.y);
    const f32x2 m = v * (q * e), r = v - m;
    f32x2 o; o.x = v.x < 0.f ? m.x : r.x; o.y = v.y < 0.f ? m.y : r.y; return o;
}
__device__ __forceinline__ float silu_f(float v) { return v * __builtin_amdgcn_rcpf(1.f + __builtin_amdgcn_exp2f(-1.4426950408889634f * v)); }
__device__ __forceinline__ f32x4 silu4(f32x4 v) { return (f32x4){silu_f(v[0]), silu_f(v[1]), silu_f(v[2]), silu_f(v[3])}; }
__device__ __forceinline__ f32x4 gelu4(f32x4 v) { const f32x2 a = gelu_pk((f32x2){v[0], v[1]}), b = gelu_pk((f32x2){v[2], v[3]}); return (f32x4){a.x, a.y, b.x, b.y}; }
__device__ __forceinline__ u32x2 pack4(f32x4 v) { u32x2 w; w.x = cvt_pk_bf16(v[0], v[1]); w.y = cvt_pk_bf16(v[2], v[3]); return w; }

constexpr int PROJ_W = 3072, DM = 1024, DFF = 2816, UPW = 5632, SEQ = 2048;
constexpr float EPS = 1e-6f;

struct EpiProj {
    static constexpr bool PERM = true, AFTER_DRAIN = false, AROWPERM = false; static constexpr int PROBE_ID = 1;
    bf16_t* O; const float* rope; const float* ssq0;
    __device__ __forceinline__ void operator()(const f32x4 (&acc)[2][2][4][2], const Unit& u, int wr, int wc, int fr, int fq) const {
        const int row0 = u.pm * BM + wr * 64 + fr; const int type = u.pn >> 1;
        if (type < 2) {
            const float sc = (type == 1) ? 0.08838834764831845f : 1.0f; const int pp = 16 * wc + 4 * fq;
#pragma unroll
            for (int ai = 0; ai < 2; ++ai)
#pragma unroll
                for (int m = 0; m < 4; ++m) { const int row = row0 + ai * HALF + m * 16; const int pos = row & (SEQ - 1);
                    const float rs = __builtin_amdgcn_rsqf(ssq0[row] * (1.0f / DM) + EPS) * sc;
                    const f32x4 c = *(const f32x4*)(rope + pos * 128 + pp) * rs, s = *(const f32x4*)(rope + pos * 128 + 64 + pp) * rs;
#pragma unroll
                    for (int bj = 0; bj < 2; ++bj) { const f32x4 x1 = acc[ai][bj][m][0], x2 = acc[ai][bj][m][1];
                        const f32x4 o1 = x1 * c - x2 * s, o2 = x2 * c + x1 * s;
                        bf16_t* p = O + (size_t)row * PROJ_W + u.pn * BM + bj * HALF + pp;
                        *(u32x2*)p = pack4(o1); *(u32x2*)(p + 64) = pack4(o2); } }
        } else {
            const int col0 = u.pn * BM + wc * 32 + 8 * fq;
#pragma unroll
            for (int ai = 0; ai < 2; ++ai)
#pragma unroll
                for (int m = 0; m < 4; ++m) { const int row = row0 + ai * HALF + m * 16; bf16_t* rowp = O + (size_t)row * PROJ_W + col0;
                    const float rs = __builtin_amdgcn_rsqf(ssq0[row] * (1.0f / DM) + EPS);
#pragma unroll
                    for (int bj = 0; bj < 2; ++bj) { f32x4 v0 = acc[ai][bj][m][0] * rs, v1 = acc[ai][bj][m][1] * rs;
                        if (type == 3) { v0 = silu4(v0); v1 = silu4(v1); } else if (type >= 4) { v0 = gelu4(v0); v1 = gelu4(v1); }
                        const u32x2 a = pack4(v0), b = pack4(v1); u32x4 w; w.x = a.x; w.y = a.y; w.z = b.x; w.w = b.y;
                        *(u32x4*)(rowp + bj * HALF) = w; } }
        }
    }
};

template <bool WRITE_XG> struct EpiRes {
    static constexpr bool PERM = false, AFTER_DRAIN = false, AROWPERM = false; static constexpr int PROBE_ID = 4;
    const bf16_t* base; float* out; bf16_t* xg; const float* gain; float* ssq;
    __device__ __forceinline__ void operator()(const f32x4 (&acc)[2][2][4][2], const Unit& u, int wr, int wc, int fr, int fq) const {
        const int col0 = u.pn * BM + wc * 32 + 4 * fq;
        f32x4 gv[2][2];
#pragma unroll
        for (int bj = 0; bj < 2; ++bj)
#pragma unroll
            for (int n = 0; n < 2; ++n) gv[bj][n] = WRITE_XG ? *(const f32x4*)(gain + col0 + bj * HALF + n * 16) : (f32x4){0.f, 0.f, 0.f, 0.f};
#pragma unroll
        for (int ai = 0; ai < 2; ++ai)
#pragma unroll
            for (int m = 0; m < 4; ++m) { const int row = u.pm * BM + ai * HALF + wr * 64 + m * 16 + fr; const size_t off = (size_t)row * DM + col0; float s = 0.f;
#pragma unroll
                for (int bj = 0; bj < 2; ++bj)
#pragma unroll
                    for (int n = 0; n < 2; ++n) { const u32x2 xb = *(const u32x2*)(base + off + bj * HALF + n * 16);
                        const f32x4 x1 = (f32x4){__uint_as_float(xb.x << 16), __uint_as_float(xb.x & 0xffff0000u), __uint_as_float(xb.y << 16), __uint_as_float(xb.y & 0xffff0000u)} + acc[ai][bj][m][n];
                        if (!WRITE_XG) *(f32x4*)(out + off + bj * HALF + n * 16) = x1; s += (x1[0] * x1[0] + x1[1] * x1[1]) + (x1[2] * x1[2] + x1[3] * x1[3]);
                        if (WRITE_XG) *(u32x2*)(xg + off + bj * HALF + n * 16) = pack4(x1 * gv[bj][n]); }
                s += __shfl_xor(s, 16); s += __shfl_xor(s, 32);
                if (fq == 0) (void)__hip_atomic_fetch_add(ssq + row, s, __ATOMIC_RELAXED, __HIP_MEMORY_SCOPE_AGENT);
                if (m == 3) asm volatile("" ::: "memory"); }
    }
};

struct EpiFinal {
    static constexpr bool PERM = false, AFTER_DRAIN = false, AROWPERM = false; static constexpr int PROBE_ID = 6;
    const bf16_t* xg; const float* gffn; float* out; const float* gain; float* ssq; unsigned* cnt;
    __device__ __forceinline__ void operator()(f32x4 (&acc)[2][2][4][2], const Unit& u, int wr, int wc, int fr, int fq) const {
        const int col0 = u.pn * BM + wc * 32 + 4 * fq;
        f32x4 gi[2][2];
#pragma unroll
        for (int bj = 0; bj < 2; ++bj)
#pragma unroll
            for (int n = 0; n < 2; ++n) { const f32x4 gf = *(const f32x4*)(gffn + col0 + bj * HALF + n * 16); gi[bj][n] = (f32x4){1.0f / gf[0], 1.0f / gf[1], 1.0f / gf[2], 1.0f / gf[3]}; }
#pragma unroll
        for (int ai = 0; ai < 2; ++ai)
#pragma unroll
            for (int m = 0; m < 4; ++m) { const int row = u.pm * BM + ai * HALF + wr * 64 + m * 16 + fr; const size_t off = (size_t)row * DM + col0; float s = 0.f;
#pragma unroll
                for (int bj = 0; bj < 2; ++bj)
#pragma unroll
                    for (int n = 0; n < 2; ++n) { const u32x2 xb = *(const u32x2*)(xg + off + bj * HALF + n * 16);
                        const f32x4 x1 = (f32x4){__uint_as_float(xb.x << 16), __uint_as_float(xb.x & 0xffff0000u), __uint_as_float(xb.y << 16), __uint_as_float(xb.y & 0xffff0000u)} * gi[bj][n];
                        const f32x4 x2 = x1 + acc[ai][bj][m][n];
                        acc[ai][bj][m][n] = x2; s += (x2[0] * x2[0] + x2[1] * x2[1]) + (x2[2] * x2[2] + x2[3] * x2[3]); }
                s += __shfl_xor(s, 16); s += __shfl_xor(s, 32);
                if (fq == 0) (void)__hip_atomic_fetch_add(ssq + row, s, __ATOMIC_RELAXED, __HIP_MEMORY_SCOPE_AGENT);
                if (m == 3) asm volatile("" ::: "memory"); }
        asm volatile("s_waitcnt vmcnt(0)" ::: "memory");
        unsigned* c = cnt + 64 * u.pm;
        if ((threadIdx.x & 63) == 0) (void)__hip_atomic_fetch_add(c, 1u, __ATOMIC_RELAXED, __HIP_MEMORY_SCOPE_AGENT);
        { unsigned sp = 0;
          while ((unsigned)__builtin_amdgcn_readfirstlane(__hip_atomic_load(c, __ATOMIC_RELAXED, __HIP_MEMORY_SCOPE_AGENT)) < 32u) { __builtin_amdgcn_s_sleep(2); if (++sp > (1u << 22)) break; } }
        __builtin_amdgcn_fence(__ATOMIC_ACQUIRE, "agent");
        f32x4 gv[2][2];
#pragma unroll
        for (int bj = 0; bj < 2; ++bj)
#pragma unroll
            for (int n = 0; n < 2; ++n) gv[bj][n] = *(const f32x4*)(gain + col0 + bj * HALF + n * 16);
#pragma unroll
        for (int ai = 0; ai < 2; ++ai)
#pragma unroll
            for (int m = 0; m < 4; ++m) { const int row = u.pm * BM + ai * HALF + wr * 64 + m * 16 + fr; const size_t off = (size_t)row * DM + col0;
                const float tot = __hip_atomic_load(ssq + row, __ATOMIC_RELAXED, __HIP_MEMORY_SCOPE_AGENT);
                const float rstd = __builtin_amdgcn_rsqf(tot * (1.0f / DM) + EPS);
#pragma unroll
                for (int bj = 0; bj < 2; ++bj)
#pragma unroll
                    for (int n = 0; n < 2; ++n) *(f32x4*)(out + off + bj * HALF + n * 16) = acc[ai][bj][m][n] * rstd * gv[bj][n]; }
    }
};

__device__ __forceinline__ float dpp_shr1(float v) { return __int_as_float(__builtin_amdgcn_update_dpp(0, __float_as_int(v), 0x111, 0xf, 0xf, true)); }
__device__ __forceinline__ f32x4 dpp_shr1_4(f32x4 v) { return (f32x4){dpp_shr1(v[0]), dpp_shr1(v[1]), dpp_shr1(v[2]), dpp_shr1(v[3])}; }
struct EpiConv {
    static constexpr bool PERM = true, AFTER_DRAIN = false, AROWPERM = true; static constexpr int PROBE_ID = 5;
    const float* ssq; const float* cw; const float* cb; bf16_t* act; float* edge;
    __device__ __forceinline__ void operator()(const f32x4 (&acc)[2][2][4][2], const Unit& u, int wr, int wc, int fr, int fq) const {
        const int run = u.pm * 2 + wr; const int tok0 = u.pm * BM + wr * HALF + 8 * fr;
        float rstd[8];
        { const f32x4 s0 = *(const f32x4*)(ssq + tok0), s1 = *(const f32x4*)(ssq + tok0 + 4);
#pragma unroll
          for (int i = 0; i < 4; ++i) { rstd[i] = __builtin_amdgcn_rsqf(s0[i] * (1.0f / DM) + EPS); rstd[4 + i] = __builtin_amdgcn_rsqf(s1[i] * (1.0f / DM) + EPS); } }
        u32x2 pk0[8];
#pragma unroll
        for (int n = 0; n < 2; ++n) {
            const int ca = u.pn * HALF + wc * 32 + 8 * fq + 4 * n;
            const f32x4 w0a = *(const f32x4*)(cw + ca), w1a = *(const f32x4*)(cw + UPW + ca), w2a = *(const f32x4*)(cw + 2 * UPW + ca), ba = *(const f32x4*)(cb + ca);
            const f32x4 w0b = *(const f32x4*)(cw + DFF + ca), w1b = *(const f32x4*)(cw + UPW + DFF + ca), w2b = *(const f32x4*)(cw + 2 * UPW + DFF + ca), bb = *(const f32x4*)(cb + DFF + ca);
            f32x4 ua[8], ub[8];
#pragma unroll
            for (int t = 0; t < 8; ++t) { ua[t] = acc[t >> 2][0][t & 3][n] * rstd[t]; ub[t] = acc[t >> 2][1][t & 3][n] * rstd[t]; }
            const f32x4 pa1 = dpp_shr1_4(ua[7]), pa2 = dpp_shr1_4(ua[6]), pb1 = dpp_shr1_4(ub[7]), pb2 = dpp_shr1_4(ub[6]);
            if (fr == 0) { float* e = edge + (size_t)run * 4 * UPW; *(f32x4*)(e + ca) = ua[0]; *(f32x4*)(e + UPW + ca) = ua[1]; *(f32x4*)(e + DFF + ca) = ub[0]; *(f32x4*)(e + UPW + DFF + ca) = ub[1]; }
            if (fr == 15) { float* e = edge + (size_t)run * 4 * UPW + 2 * UPW; *(f32x4*)(e + ca) = ua[6]; *(f32x4*)(e + UPW + ca) = ua[7]; *(f32x4*)(e + DFF + ca) = ub[6]; *(f32x4*)(e + UPW + DFF + ca) = ub[7]; }
#pragma unroll
            for (int t = 0; t < 8; ++t) {
                const f32x4 am1 = (t >= 1) ? ua[t >= 1 ? t - 1 : 0] : pa1, am2 = (t >= 2) ? ua[t >= 2 ? t - 2 : 0] : (t == 1 ? pa1 : pa2);
                const f32x4 bm1 = (t >= 1) ? ub[t >= 1 ? t - 1 : 0] : pb1, bm2 = (t >= 2) ? ub[t >= 2 ? t - 2 : 0] : (t == 1 ? pb1 : pb2);
                const f32x4 ya = w2a * ua[t] + w1a * am1 + w0a * am2 + ba, yb = w2b * ub[t] + w1b * bm1 + w0b * bm2 + bb;
                const u32x2 pk = pack4(silu4(ya) * yb);
                if (n == 0) pk0[t] = pk;
                else if (!(fr == 0 && t < 2)) { u32x4 w; w.x = pk0[t].x; w.y = pk0[t].y; w.z = pk.x; w.w = pk.y;
                    *(u32x4*)(act + (size_t)(tok0 + t) * DFF + u.pn * HALF + wc * 32 + 8 * fq) = w; }
            }
        }
    }
};
template <class Epi, class Sched, bool ALIGN_EPI = false, bool SP2 = false>
__device__ __forceinline__ void gemm_phase(PG8_LAS unsigned char* lds, const Gemm g, const Sched& S, const Epi& E) {
    const int tid = threadIdx.x, wid = __builtin_amdgcn_readfirstlane(tid >> 6), lane = tid & 63, wr = wid >> 2, wc = wid & 3, fr = lane & 15, fq = lane >> 4;
    const int K = g.K, nt = K / BK;
    unsigned voffA[2], voffB[2];
#pragma unroll
    for (int i = 0; i < 2; ++i) { int R, C; stage_rc(tid * 16 + i * 8192, R, C); const int Rb = Epi::PERM ? ((R & ~31) + perm32(R & 31)) : R;
        voffA[i] = (unsigned)((Epi::AROWPERM ? tokrow(R) : R) * K + C) * 2u; voffB[i] = (unsigned)(Rb * K + C) * 2u; }
    const size_t kstep = (size_t)(BK * 2);
    const size_t hstepB = (size_t)HALF * K * 2; const size_t hstepA = Epi::AROWPERM ? (size_t)4 * K * 2 : hstepB;
    const size_t tstep = 2 * hstepB;
    const unsigned ldsw = (unsigned)wid * 1024u;
    const int aoff = lds_byte(wr * 64 + fr, fq * 8), boff = lds_byte(wc * 32 + fr, fq * 8);
#define PG8_SA(b, h) (((b) * 2 + (h)) * HTB)
#define PG8_SB(b, h) ((4 + (b) * 2 + (h)) * HTB)
#define PG8_STAGE(bufoff, gbase, voff) do { _Pragma("unroll") for (int _i = 0; _i < 2; ++_i) \
        __builtin_amdgcn_global_load_lds((const unsigned*)((const char*)(gbase) + (voff)[_i]), (PG8_LAS unsigned*)(lds + (bufoff) + ldsw + _i * 8192), 16, 0, 0); } while (0)
#define PG8_LDA(dst, b, h) do { _Pragma("unroll") for (int m = 0; m < 4; ++m) _Pragma("unroll") for (int k = 0; k < 2; ++k) dst[m][k] = *(const PG8_LAS bf16x8*)(lds + PG8_SA(b, h) + aoff + m * 2048 + k * 1024); } while (0)
#define PG8_LDB(dst, b, h) do { _Pragma("unroll") for (int n = 0; n < 2; ++n) _Pragma("unroll") for (int k = 0; k < 2; ++k) dst[n][k] = *(const PG8_LAS bf16x8*)(lds + PG8_SB(b, h) + boff + n * 2048 + k * 1024); } while (0)
#define PG8_MMA(ai, bj, At, Bt) do { __builtin_amdgcn_s_setprio(1); _Pragma("unroll") for (int m = 0; m < 4; ++m) _Pragma("unroll") for (int n = 0; n < 2; ++n) _Pragma("unroll") for (int k = 0; k < 2; ++k) \
        acc[ai][bj][m][n] = __builtin_amdgcn_mfma_f32_16x16x32_bf16(Bt[n][k], At[m][k], acc[ai][bj][m][n], 0, 0, 0); __builtin_amdgcn_s_setprio(0); } while (0)
#define PG8_WAIT_V(n) asm volatile("s_waitcnt vmcnt(" #n ")" ::: "memory")
#define PG8_WAIT_L(n) asm volatile("s_waitcnt lgkmcnt(" #n ")" ::: "memory")
#define PG8_BAR __builtin_amdgcn_s_barrier()
#define PG8_SCHED __builtin_amdgcn_sched_barrier(0)
    Unit cur, nxt; int ui = 0;
    if (!S.next(0, cur)) return;
    f32x4 acc[2][2][4][2];
#pragma unroll
    for (int a = 0; a < 2; ++a)
#pragma unroll
        for (int b = 0; b < 2; ++b)
#pragma unroll
            for (int m = 0; m < 4; ++m)
#pragma unroll
                for (int n = 0; n < 2; ++n) acc[a][b][m][n] = (f32x4){0.f, 0.f, 0.f, 0.f};
    bf16x8 At[4][2], B0[2][2], B1[2][2];
    const char* cA = (const char*)g.A + (size_t)cur.pm * tstep; const char* cB = (const char*)g.Bt + (size_t)cur.pn * tstep;
    S.a_ready(cur);
    if constexpr (SP2) {
        PG8_STAGE(PG8_SB(0, 0), cB, voffB); PG8_STAGE(PG8_SB(0, 1), cB + hstepB, voffB); PG8_STAGE(PG8_SA(0, 0), cA, voffA); PG8_STAGE(PG8_SA(0, 1), cA + hstepA, voffA);
        if (wr == 1) PG8_BAR;
        PG8_WAIT_V(2); PG8_BAR;
        PG8_STAGE(PG8_SB(1, 0), cB + kstep, voffB); PG8_STAGE(PG8_SA(1, 0), cA + kstep, voffA); PG8_STAGE(PG8_SB(1, 1), cB + hstepB + kstep, voffB);
        PG8_WAIT_V(6); PG8_BAR;
    } else {
        PG8_STAGE(PG8_SB(0, 0), cB, voffB); PG8_STAGE(PG8_SA(0, 0), cA, voffA); PG8_STAGE(PG8_SB(0, 1), cB + hstepB, voffB); PG8_STAGE(PG8_SA(0, 1), cA + hstepA, voffA);
        if (wr == 1) PG8_BAR;
        PG8_WAIT_V(4); PG8_BAR;
        PG8_STAGE(PG8_SB(1, 0), cB + kstep, voffB); PG8_STAGE(PG8_SA(1, 0), cA + kstep, voffA); PG8_STAGE(PG8_SB(1, 1), cB + hstepB + kstep, voffB);
        PG8_WAIT_V(6); PG8_BAR;
    }
    for (;;) {
        const bool has_next = S.next(ui + 1, nxt);
        const char* nA = has_next ? (const char*)g.A + (size_t)nxt.pm * tstep : cA; const char* nB = has_next ? (const char*)g.Bt + (size_t)nxt.pn * tstep : cB;
        for (int t = 0; t < nt; t += 2) {
            const bool last = (t == nt - 2);
            const char* a1 = cA + (size_t)(t + 1) * kstep;
            const char* a2 = last ? nA : cA + (size_t)(t + 2) * kstep; const char* b2 = last ? nB : cB + (size_t)(t + 2) * kstep;
            const char* a3 = a2 + kstep; const char* b3 = b2 + kstep;
            if (last && has_next) S.a_ready(nxt);
            if constexpr (SP2) {
            PG8_LDB(B0, 0, 0); PG8_LDB(B1, 0, 1); PG8_SCHED; PG8_LDA(At, 0, 0); PG8_STAGE(PG8_SA(1, 1), a1 + hstepA, voffA);
            PG8_WAIT_V(8); PG8_WAIT_L(0); PG8_BAR; PG8_MMA(0, 0, At, B0); PG8_MMA(0, 1, At, B1); PG8_BAR; PG8_SCHED;
            PG8_LDA(At, 0, 1); PG8_STAGE(PG8_SB(0, 0), b2, voffB); PG8_STAGE(PG8_SB(0, 1), b2 + hstepB, voffB); PG8_STAGE(PG8_SA(0, 0), a2, voffA);
            PG8_WAIT_V(8); PG8_WAIT_L(0); PG8_BAR; PG8_MMA(1, 0, At, B0); PG8_MMA(1, 1, At, B1); PG8_BAR; PG8_SCHED;
            PG8_LDB(B0, 1, 0); PG8_LDB(B1, 1, 1); PG8_SCHED; PG8_LDA(At, 1, 0); PG8_STAGE(PG8_SA(0, 1), a2 + hstepA, voffA);
            PG8_WAIT_V(8); PG8_WAIT_L(0); PG8_BAR; PG8_MMA(0, 0, At, B0); PG8_MMA(0, 1, At, B1); PG8_BAR; PG8_SCHED;
            PG8_LDA(At, 1, 1); PG8_STAGE(PG8_SB(1, 0), b3, voffB); PG8_STAGE(PG8_SB(1, 1), b3 + hstepB, voffB); PG8_STAGE(PG8_SA(1, 0), a3, voffA);
            PG8_WAIT_V(8); PG8_WAIT_L(0); PG8_BAR; PG8_MMA(1, 0, At, B0); PG8_MMA(1, 1, At, B1); PG8_BAR; PG8_SCHED;
            } else {
            PG8_LDB(B0, 0, 0); PG8_SCHED; PG8_LDA(At, 0, 0); PG8_STAGE(PG8_SA(1, 1), a1 + hstepA, voffA);
            PG8_WAIT_L(8); PG8_BAR; PG8_WAIT_L(0); PG8_MMA(0, 0, At, B0); PG8_BAR; PG8_SCHED;
            PG8_LDB(B1, 0, 1); PG8_STAGE(PG8_SB(0, 0), b2, voffB);
            PG8_BAR; PG8_WAIT_L(0); PG8_MMA(0, 1, At, B1); PG8_BAR;
            PG8_LDA(At, 0, 1); PG8_STAGE(PG8_SA(0, 0), a2, voffA);
            PG8_BAR; PG8_WAIT_L(0); PG8_MMA(1, 0, At, B0); PG8_BAR; PG8_SCHED;
            PG8_STAGE(PG8_SB(0, 1), b2 + hstepB, voffB);
            PG8_WAIT_V(6); PG8_BAR; PG8_MMA(1, 1, At, B1); PG8_BAR;
            PG8_LDB(B0, 1, 0); PG8_SCHED; PG8_LDA(At, 1, 0); PG8_STAGE(PG8_SA(0, 1), a2 + hstepA, voffA);
            PG8_WAIT_L(8); PG8_BAR; PG8_WAIT_L(0); PG8_MMA(0, 0, At, B0); PG8_BAR; PG8_SCHED;
            PG8_LDB(B1, 1, 1); PG8_STAGE(PG8_SB(1, 0), b3, voffB);
            PG8_BAR; PG8_WAIT_L(0); PG8_MMA(0, 1, At, B1); PG8_BAR;
            PG8_LDA(At, 1, 1); PG8_STAGE(PG8_SA(1, 0), a3, voffA);
            PG8_BAR; PG8_WAIT_L(0); PG8_MMA(1, 0, At, B0); PG8_BAR; PG8_SCHED;
            PG8_STAGE(PG8_SB(1, 1), b3 + hstepB, voffB);
            PG8_WAIT_V(6); PG8_BAR; PG8_MMA(1, 1, At, B1); PG8_BAR;
            }
        }
        if constexpr (ALIGN_EPI) { if (wr == 0) PG8_BAR; }
#if MK_SPIN_EPI
        const unsigned long long te0_ = __builtin_amdgcn_s_memrealtime();
#endif
        if constexpr (!Epi::AFTER_DRAIN) { E(acc, cur, wr, wc, fr, fq); S.done(cur); }
#if MK_SPIN_EPI
        if (Epi::PROBE_ID == MK_SPIN_EPI) { const unsigned long long te1_ = __builtin_amdgcn_s_memrealtime(); while (__builtin_amdgcn_s_memrealtime() - te1_ < (te1_ - te0_)) __builtin_amdgcn_s_sleep(2); }
#endif
        if (!has_next) break;
#pragma unroll
        for (int a = 0; a < 2; ++a)
#pragma unroll
            for (int b = 0; b < 2; ++b)
#pragma unroll
                for (int m = 0; m < 4; ++m)
#pragma unroll
                    for (int n = 0; n < 2; ++n) acc[a][b][m][n] = (f32x4){0.f, 0.f, 0.f, 0.f};
        cur = nxt; cA = nA; cB = nB; ++ui;
        if constexpr (ALIGN_EPI) { if (wr == 1) PG8_BAR; }
    }
    PG8_WAIT_V(0);
    if constexpr (!ALIGN_EPI) { if (wr == 0) PG8_BAR; }
    PG8_BAR;
    if constexpr (Epi::AFTER_DRAIN) { E.fused(acc, cur, wr, wc, fr, fq, lds, wid, lane); S.done(cur); }
#undef PG8_SA
#undef PG8_SB
#undef PG8_STAGE
#undef PG8_LDA
#undef PG8_LDB
#undef PG8_MMA
#undef PG8_WAIT_V
#undef PG8_WAIT_L
#undef PG8_BAR
#undef PG8_SCHED
}
}
#ifndef MK_MULTI
#define MK_MULTI 0
#endif
#ifndef MK_SPIN
#define MK_SPIN -1
#endif
#ifndef MK_CGSYNC
#define MK_CGSYNC 0
#endif
#ifndef MK_REPMASK
#define MK_REPMASK 0
#endif

constexpr int NWAVES = 8, NTHREADS = 512;
constexpr int BATCH = 8, SEQ = 2048, DM = 1024, M = BATCH * SEQ, PROJ_W = 3072, DFF = 2816, UPW = 5632, NCHUNK = 16;
constexpr float EPS = 1e-6f;
constexpr size_t MiB = 1u << 20;
constexpr size_t WS_SSQ1 = 0, WS_SSQ2 = 65536, WS_SSQ0 = 262144, WS_BAR = 131072, WS_BAR_BYTES = 32768, WS_PCNT = 131072 + 16384, WS_ROPE = 1 * MiB, WS_SGUW = 2 * MiB, WS_WIN = 3 * MiB, WS_WOUT = 9 * MiB, WS_WUP = 11 * MiB, WS_WDOWN = 22 * MiB,
                 WS_EDGE = 28 * MiB, WS_XN = 40 * MiB, WS_PROJ = 72 * MiB, WS_MIX = 168 * MiB, WS_KV = 200 * MiB, WS_ACT = 72 * MiB, WS_END = 216 * MiB;
constexpr int LDS_BYTES = 147456, MISC_OFF = 147456 - 64;
constexpr int LP = 272;
constexpr int TILE_LDS = 128 * LP;

#define LAS __attribute__((address_space(3)))
typedef unsigned short bf16;
typedef unsigned v4u __attribute__((ext_vector_type(4)));
typedef unsigned v2u __attribute__((ext_vector_type(2)));
typedef float f32x4 __attribute__((ext_vector_type(4)));
typedef short bf16x8 __attribute__((ext_vector_type(8)));
__device__ __forceinline__ unsigned f2bf(float f) { unsigned u = __builtin_bit_cast(unsigned, f); return (u + 0x7fffu + ((u >> 16) & 1u)) >> 16; }
__device__ __forceinline__ unsigned pk2(float lo, float hi) { return f2bf(lo) | (f2bf(hi) << 16); }
__device__ __forceinline__ float bflo(unsigned w) { return __uint_as_float(w << 16); }
__device__ __forceinline__ float bfhi(unsigned w) { return __uint_as_float(w & 0xffff0000u); }
__device__ __forceinline__ float wave_sum(float v) {
#pragma unroll
    for (int o = 1; o < 64; o <<= 1) v += __shfl_xor(v, o);
    return v;
}

struct Frame {
    LAS unsigned char* lds; unsigned char* ws;
    int tid, lane, wave, G, bid;
    const float* in[15]; float* out;
};

__device__ __forceinline__ int dest_row(int map, int n) {
    if (map == 1) { if (n >= 1024) return n; const int d = n & 127; return (n & ~127) + 32 * ((d >> 4) & 3) + 8 * ((d >> 2) & 3) + 4 * (d >> 6) + (d & 3); }
    if (map == 2) { return n < DFF ? 256 * (n >> 7) + (n & 127) : 256 * ((n - DFF) >> 7) + 128 + ((n - DFF) & 127); }
    return n;
}
struct WItem { const float* W; bf16* WT; const float* kg; int K, N, map, item; };
__device__ __forceinline__ WItem witem_in(Frame& F, int it) { WItem w; w.W = F.in[2]; w.WT = (bf16*)(F.ws + WS_WIN); w.kg = F.in[1]; w.K = DM; w.N = PROJ_W; w.map = 1; w.item = it; return w; }
constexpr int I_IN = (DM / 64) * (PROJ_W / 32), I_OUT = (DM / 64) * (DM / 32), I_UP = (DM / 64) * (UPW / 32), I_DN = (DFF / 64) * (DM / 32), I_TAIL = I_OUT + I_UP;
__device__ __forceinline__ WItem witem_tail(Frame& F, int it) {
    WItem w; w.kg = nullptr; int r = it;
    if (r < I_OUT) { w.W = F.in[8]; w.WT = (bf16*)(F.ws + WS_WOUT); w.K = DM; w.N = DM; w.map = 0; w.item = r; return w; } r -= I_OUT;
    w.W = F.in[10]; w.WT = (bf16*)(F.ws + WS_WUP); w.K = DM; w.N = UPW; w.map = 2; w.item = r; return w;
}
__device__ __forceinline__ WItem witem_down(Frame& F, int it) { WItem w; w.kg = nullptr; w.W = F.in[13]; w.WT = (bf16*)(F.ws + WS_WDOWN); w.K = DFF; w.N = DM; w.map = 0; w.item = it; return w; }
__device__ __forceinline__ void witem_load(const WItem& w, f32x4 (&v)[8], int lane) {
    const int nblk = w.N / 32, kb = w.item / nblk, nb = w.item % nblk;
    const float* p = w.W + (size_t)(64 * kb + (lane >> 3)) * w.N + 32 * nb + 4 * (lane & 7);
#pragma unroll
    for (int i = 0; i < 8; ++i) v[i] = *(const f32x4*)(p + (size_t)(8 * i) * w.N);
}
__device__ __forceinline__ void witem_finish(const WItem& w, const f32x4 (&v)[8], LAS float* scr, int lane) {
    const int nblk = w.N / 32, kb = w.item / nblk, nb = w.item % nblk, k0 = 64 * kb, n0 = 32 * nb;
#pragma unroll
    for (int i = 0; i < 8; ++i) { LAS float* d = scr + (8 * i + (lane >> 3)) * 33 + 4 * (lane & 7); d[0] = v[i].x; d[1] = v[i].y; d[2] = v[i].z; d[3] = v[i].w; }
    asm volatile("s_waitcnt lgkmcnt(0)" ::: "memory");
    const int c = lane & 7;
    f32x4 g0 = (f32x4){1.f, 1.f, 1.f, 1.f}, g1 = g0;
    if (w.kg) { g0 = *(const f32x4*)(w.kg + k0 + 8 * c); g1 = *(const f32x4*)(w.kg + k0 + 8 * c + 4); }
#pragma unroll
    for (int j = 0; j < 4; ++j) { const int n = (lane >> 3) + 8 * j; const LAS float* s = scr + (8 * c) * 33 + n;
        v4u o; o.x = pk2(s[0 * 33] * g0[0], s[1 * 33] * g0[1]); o.y = pk2(s[2 * 33] * g0[2], s[3 * 33] * g0[3]); o.z = pk2(s[4 * 33] * g1[0], s[5 * 33] * g1[1]); o.w = pk2(s[6 * 33] * g1[2], s[7 * 33] * g1[3]);
        *(v4u*)(w.WT + (size_t)dest_row(w.map, n0 + n) * w.K + k0 + 8 * c) = o; }
    asm volatile("s_waitcnt lgkmcnt(0)" ::: "memory");
}

__device__ __forceinline__ void p0_prologue(Frame& F) {
    LAS float* scr = (LAS float*)(F.lds + F.wave * 16384);
    const int gw = F.bid * NWAVES + F.wave, NGW = F.G * NWAVES;
    const int gt = F.bid * NTHREADS + F.tid, NGT = F.G * NTHREADS;
    for (int it = gw; it < I_IN; it += NGW) { const WItem w = witem_in(F, it); f32x4 v[8]; witem_load(w, v, F.lane); witem_finish(w, v, scr, F.lane); }
    { float* rope = (float*)(F.ws + WS_ROPE);
      for (int i = gt; i < SEQ * 64; i += NGT) { const int pos = i >> 6, f = i & 63;
          const float inv = exp2f(-(float)f * (13.287712379549449f / 64.0f));
          const float ang = (float)pos * inv;
          double t = (double)ang * 0.15915494309189535; t -= rint(t); const float rv = (float)t;
          rope[pos * 128 + f] = __builtin_amdgcn_cosf(rv); rope[pos * 128 + 64 + f] = __builtin_amdgcn_sinf(rv); } }
    { float* z = (float*)(F.ws + WS_SSQ1); for (int i = gt; i < 2 * M; i += NGT) z[i] = 0.f; }
    { bf16* XB = (bf16*)(F.ws + WS_XN); float* ssq0 = (float*)(F.ws + WS_SSQ0);
      for (int m0 = gw * 4; m0 < M; m0 += NGW * 4) {
          f32x4 v[4][4]; float s[4];
#pragma unroll
          for (int r = 0; r < 4; ++r) { const f32x4* xr = (const f32x4*)(F.in[0] + (size_t)(m0 + r) * DM) + F.lane;
#pragma unroll
              for (int j = 0; j < 4; ++j) v[r][j] = __builtin_nontemporal_load(xr + 64 * j); }
#pragma unroll
          for (int r = 0; r < 4; ++r) { s[r] = 0.f; v2u* o8 = (v2u*)(XB + (size_t)(m0 + r) * DM) + F.lane;
#pragma unroll
              for (int j = 0; j < 4; ++j) { const f32x4 y = v[r][j]; s[r] += (y.x * y.x + y.y * y.y) + (y.z * y.z + y.w * y.w); v2u w; w.x = pk2(y.x, y.y); w.y = pk2(y.z, y.w); o8[64 * j] = w; } }
#pragma unroll
          for (int o = 1; o < 64; o <<= 1) {
#pragma unroll
              for (int r = 0; r < 4; ++r) s[r] += __shfl_xor(s[r], o); }
          if (F.lane < 4) ssq0[m0 + F.lane] = F.lane == 0 ? s[0] : F.lane == 1 ? s[1] : F.lane == 2 ? s[2] : s[3]; } }
}

__device__ __forceinline__ void p1_tail(Frame& F) {
    LAS float* scr = (LAS float*)(F.lds + F.wave * 16384);
    const int gw = F.bid * NWAVES + F.wave, NGW = F.G * NWAVES;
    const int gt = F.bid * NTHREADS + F.tid, NGT = F.G * NTHREADS;
    int it = gw; f32x4 v[8];
    if (it < I_TAIL) { const WItem w = witem_tail(F, it); witem_load(w, v, F.lane); }
    while (it < I_TAIL) {
        const int nx = it + NGW; f32x4 vn[8];
#pragma unroll
        for (int i = 0; i < 8; ++i) vn[i] = v[i];
        if (nx < I_TAIL) { const WItem wn = witem_tail(F, nx); witem_load(wn, vn, F.lane); }
        { const WItem w = witem_tail(F, it); witem_finish(w, v, scr, F.lane); }
#pragma unroll
        for (int i = 0; i < 8; ++i) v[i] = vn[i];
        it = nx;
    }
    { const float* w = F.in[6]; bf16* o = (bf16*)(F.ws + WS_SGUW);
      for (int i = gt; i < 4 * 128 * 128; i += NGT) { const int t = (i >> 7) & 127, s = i & 127; o[i] = (bf16)f2bf(s <= t ? w[i] : 0.f); } }
}

typedef short s16x4 __attribute__((ext_vector_type(4)));
struct TileRegs { v4u v[4]; };
__device__ __forceinline__ void tile_fetch(TileRegs& t, const bf16* src, int ld, int tid) {
#pragma unroll
    for (int i = 0; i < 4; ++i) { const int c = tid + NTHREADS * i, row = c >> 4, ch = c & 15; t.v[i] = *(const v4u*)(src + (size_t)row * ld + ch * 8); }
}
template <bool SCALE> __device__ __forceinline__ void tile_stage(LAS unsigned char* dst, TileRegs& t, int tid, float lg) {
#pragma unroll
    for (int i = 0; i < 4; ++i) { const int c = tid + NTHREADS * i, row = c >> 4, ch = c & 15;
        if (SCALE) { const float sc = exp2f(lg * (float)(127 - row));
#pragma unroll
            for (int j = 0; j < 4; ++j) t.v[i][j] = pk2(bflo(t.v[i][j]) * sc, bfhi(t.v[i][j]) * sc); }
        *(LAS v4u*)(dst + row * LP + ch * 16) = t.v[i]; }
}
__device__ __forceinline__ bf16x8 frag_row(const LAS unsigned char* T, int r0, int ks, int fr, int fq) { return *(const LAS bf16x8*)(T + (r0 + fr) * LP + (32 * ks + 8 * fq) * 2); }
__device__ __forceinline__ bf16x8 frag_tr(const LAS unsigned char* T, int c0, int ks, int fr, int fq) {
    const LAS unsigned char* a = T + (32 * ks + 8 * fq + (fr >> 2)) * LP + c0 * 2 + 8 * (fr & 3);
    const s16x4 lo = __builtin_bit_cast(s16x4, __builtin_amdgcn_ds_read_tr16_b64_v4i16((LAS s16x4*)a));
    const s16x4 hi = __builtin_bit_cast(s16x4, __builtin_amdgcn_ds_read_tr16_b64_v4i16((LAS s16x4*)(a + 4 * LP)));
    return __builtin_shufflevector(lo, hi, 0, 1, 2, 3, 4, 5, 6, 7);
}
template <bool XTR, bool YTR> __device__ __forceinline__ void mm16(f32x4 (&acc)[8], const LAS unsigned char* X, const LAS unsigned char* Y, int w, int fr, int fq) {
#pragma unroll
    for (int ks = 0; ks < 4; ++ks) {
        const bf16x8 a = XTR ? frag_tr(X, 16 * w, ks, fr, fq) : frag_row(X, 16 * w, ks, fr, fq);
#pragma unroll
        for (int jh = 0; jh < 8; jh += 4) {
            bf16x8 bfr[4];
#pragma unroll
            for (int j = 0; j < 4; ++j) bfr[j] = YTR ? frag_tr(Y, 16 * (jh + j), ks, fr, fq) : frag_row(Y, 16 * (jh + j), ks, fr, fq);
#pragma unroll
            for (int j = 0; j < 4; ++j) acc[jh + j] = __builtin_amdgcn_mfma_f32_16x16x32_bf16(bfr[j], a, acc[jh + j], 0, 0, 0);
            __builtin_amdgcn_sched_barrier(0);
        }
    }
}
__device__ __forceinline__ float head_log2g(int h) { return log2f(1.0f - exp2f(-5.0f - (float)h)); }

struct KvRegs { TileRegs k, v; };
__device__ __forceinline__ void kv_fetch(Frame& F, KvRegs& r, int it) {
    const int bh = it >> 4, n = it & 15; const size_t tok0 = (size_t)(bh >> 2) * SEQ + 128 * n; const bf16* PROJ = (const bf16*)(F.ws + WS_PROJ);
    tile_fetch(r.k, PROJ + tok0 * PROJ_W + 512 + 128 * (bh & 3), PROJ_W, F.tid); tile_fetch(r.v, PROJ + tok0 * PROJ_W + 1024 + 128 * (bh & 3), PROJ_W, F.tid);
}
__device__ __forceinline__ void kv_stage(Frame& F, KvRegs& r, int it) {
    tile_stage<true>(F.lds, r.k, F.tid, head_log2g((it >> 4) & 3)); tile_stage<false>(F.lds + TILE_LDS, r.v, F.tid, 0.f);
}
__device__ __forceinline__ void kv_compute(Frame& F, int it, f32x4 (&acc)[8], bool first) {
    const int bh = it >> 4, n = it & 15; const int w = F.wave, fr = F.lane & 15, fq = F.lane >> 4;
    const float cd = first ? 0.f : exp2f(head_log2g(bh & 3) * 128.0f);
#pragma unroll
    for (int j = 0; j < 8; ++j) acc[j] = acc[j] * cd;
    mm16<true, true>(acc, F.lds + TILE_LDS, F.lds, w, fr, fq);
    bf16* o = (bf16*)(F.ws + WS_KV) + ((size_t)(bh * NCHUNK + n) * 128 + 16 * w + fr) * 128 + 4 * fq;
#pragma unroll
    for (int j = 0; j < 8; ++j) { v2u wv; wv.x = pk2(acc[j][0], acc[j][1]); wv.y = pk2(acc[j][2], acc[j][3]); *(v2u*)(o + 16 * j) = wv; }
}

struct SguRegs { TileRegs wt; v4u sv[4]; v2u up[8]; float bs; };
__device__ __forceinline__ void sgu_fetch(Frame& F, SguRegs& r, int it) {
    const int b = it >> 6, n = (it >> 2) & 15, g = it & 3; const size_t tok0 = (size_t)b * SEQ + 128 * n; const bf16* PROJ = (const bf16*)(F.ws + WS_PROJ);
    tile_fetch(r.wt, (const bf16*)(F.ws + WS_SGUW) + g * 16384, 128, F.tid);
    { const int t = F.tid >> 2, qd = F.tid & 3; const v4u* p = (const v4u*)(PROJ + (tok0 + t) * PROJ_W + 2560 + 128 * g + 32 * qd);
#pragma unroll
      for (int c = 0; c < 4; ++c) r.sv[c] = p[c]; }
    { const int t = 16 * F.wave + (F.lane & 15); const bf16* up = PROJ + (tok0 + t) * PROJ_W + 2048 + 128 * g + 4 * (F.lane >> 4);
#pragma unroll
      for (int j = 0; j < 8; ++j) r.up[j] = *(const v2u*)(up + 16 * j);
      r.bs = F.in[7][128 * g + t]; }
}
__device__ __forceinline__ void sgu_stage(Frame& F, SguRegs& r, int it) {
    const int g = it & 3; LAS unsigned char* vn = F.lds + TILE_LDS;
    tile_stage<false>(F.lds, r.wt, F.tid, 0.f);
    const int t = F.tid >> 2, qd = F.tid & 3;
    float v[32];
#pragma unroll
    for (int c = 0; c < 4; ++c)
#pragma unroll
        for (int j = 0; j < 4; ++j) { v[8 * c + 2 * j] = bflo(r.sv[c][j]); v[8 * c + 2 * j + 1] = bfhi(r.sv[c][j]); }
    float s = 0.f;
#pragma unroll
    for (int i = 0; i < 32; ++i) s += v[i];
    s += __shfl_xor(s, 1); s += __shfl_xor(s, 2);
    const float mu = s * (1.0f / 128.0f); float q = 0.f;
#pragma unroll
    for (int i = 0; i < 32; ++i) { v[i] -= mu; q += v[i] * v[i]; }
    q += __shfl_xor(q, 1); q += __shfl_xor(q, 2);
    const float rstd = 1.0f / sqrtf(q * (1.0f / 128.0f) + EPS);
    const f32x4* lng = (const f32x4*)(F.in[4] + 128 * g + 32 * qd); const f32x4* lnb = (const f32x4*)(F.in[5] + 128 * g + 32 * qd);
#pragma unroll
    for (int c = 0; c < 4; ++c) { const f32x4 g0 = lng[2 * c], g1 = lng[2 * c + 1], b0 = lnb[2 * c], b1 = lnb[2 * c + 1]; v4u o;
        o.x = pk2(v[8 * c + 0] * rstd * g0[0] + b0[0], v[8 * c + 1] * rstd * g0[1] + b0[1]); o.y = pk2(v[8 * c + 2] * rstd * g0[2] + b0[2], v[8 * c + 3] * rstd * g0[3] + b0[3]);
        o.z = pk2(v[8 * c + 4] * rstd * g1[0] + b1[0], v[8 * c + 5] * rstd * g1[1] + b1[1]); o.w = pk2(v[8 * c + 6] * rstd * g1[2] + b1[2], v[8 * c + 7] * rstd * g1[3] + b1[3]);
        *(LAS v4u*)(vn + t * LP + qd * 64 + c * 16) = o; }
}
__device__ __forceinline__ void sgu_compute(Frame& F, const v2u (&upv)[8], float bs, int it) {
    const int b = it >> 6, n = (it >> 2) & 15, g = it & 3; const size_t tok0 = (size_t)b * SEQ + 128 * n;
    const int w = F.wave, fr = F.lane & 15, fq = F.lane >> 4;
    f32x4 acc[8];
#pragma unroll
    for (int j = 0; j < 8; ++j) acc[j] = (f32x4){0.f, 0.f, 0.f, 0.f};
    mm16<false, true>(acc, F.lds, F.lds + TILE_LDS, w, fr, fq);
    const int t = 16 * w + fr;
    bf16* o = (bf16*)(F.ws + WS_MIX) + (tok0 + t) * DM + 512 + 128 * g + 4 * fq;
#pragma unroll
    for (int j = 0; j < 8; ++j) { const v2u uu = upv[j];
        v2u wv; wv.x = pk2(bflo(uu.x) * (acc[j][0] + bs), bfhi(uu.x) * (acc[j][1] + bs)); wv.y = pk2(bflo(uu.y) * (acc[j][2] + bs), bfhi(uu.y) * (acc[j][3] + bs));
        *(v2u*)(o + 16 * j) = wv; }
}
__device__ __forceinline__ void p2_phase(Frame& F) {
    const int k0 = 2 * F.bid, k1 = 2 * F.bid + 1, s0 = F.bid, s1 = F.bid + 256;
    KvRegs kr; SguRegs sr; f32x4 kacc[8];
#pragma unroll
    for (int j = 0; j < 8; ++j) kacc[j] = (f32x4){0.f, 0.f, 0.f, 0.f};
    kv_fetch(F, kr, k0);
    __syncthreads(); kv_stage(F, kr, k0); kv_fetch(F, kr, k1); __syncthreads(); kv_compute(F, k0, kacc, true);
    __syncthreads(); kv_stage(F, kr, k1); sgu_fetch(F, sr, s0); __syncthreads(); kv_compute(F, k1, kacc, false);
    v2u upv[8]; float bs;
    __syncthreads(); sgu_stage(F, sr, s0);
#pragma unroll
    for (int j = 0; j < 8; ++j) upv[j] = sr.up[j];
    bs = sr.bs; sgu_fetch(F, sr, s1); __syncthreads(); sgu_compute(F, upv, bs, s0);
    __syncthreads(); sgu_stage(F, sr, s1); __syncthreads(); sgu_compute(F, sr.up, sr.bs, s1);
}

template <int NB> __device__ __forceinline__ void kv_horner(float (&s)[4][8], const bf16* kv, int slot0, int cnt, float f) {
#pragma unroll 1
    for (int jc = 0; jc < cnt; jc += NB) {
        const bf16* kp = kv + (size_t)(slot0 + 2 * jc) * 16384;
        v4u x[NB][4];
#pragma unroll
        for (int u = 0; u < NB; ++u) if (jc + u < cnt) {
#pragma unroll
            for (int i = 0; i < 4; ++i) x[u][i] = *(const v4u*)(kp + (size_t)u * 32768 + (size_t)(NTHREADS * i) * 8); }
#pragma unroll
        for (int u = 0; u < NB; ++u) if (jc + u < cnt) {
#pragma unroll
            for (int i = 0; i < 4; ++i)
#pragma unroll
                for (int j = 0; j < 4; ++j) { s[i][2 * j] = s[i][2 * j] * f + bflo(x[u][i][j]); s[i][2 * j + 1] = s[i][2 * j + 1] * f + bfhi(x[u][i][j]); } }
    }
}
__device__ __forceinline__ void kv_step1(float (&s)[4][8], const bf16* kv, int slot, bool take, float f) {
    v4u x[4];
#pragma unroll
    for (int i = 0; i < 4; ++i) x[i] = (v4u){0u, 0u, 0u, 0u};
    if (take) {
#pragma unroll
        for (int i = 0; i < 4; ++i) x[i] = *(const v4u*)(kv + (size_t)slot * 16384 + (size_t)(NTHREADS * i) * 8); }
#pragma unroll
    for (int i = 0; i < 4; ++i)
#pragma unroll
        for (int j = 0; j < 4; ++j) { s[i][2 * j] = s[i][2 * j] * f + bflo(x[i][j]); s[i][2 * j + 1] = s[i][2 * j + 1] * f + bfhi(x[i][j]); }
}
__device__ __forceinline__ void ret_pair(Frame& F, int bh, int n_small) {
    const int b = bh >> 2, h = bh & 3;
    const bf16* PROJ = (const bf16*)(F.ws + WS_PROJ);
    LAS unsigned char* Qs = F.lds; LAS unsigned char* Ks = F.lds + TILE_LDS; LAS unsigned char* Vs = F.lds + 2 * TILE_LDS; LAS unsigned char* St = F.lds + 3 * TILE_LDS;
    const float lg = head_log2g(h); const float cd = exp2f(lg * 128.0f);
    const int w = F.wave, fr = F.lane & 15, fq = F.lane >> 4; const int q = 16 * w + fr;
    const int n_big = 15 - n_small;
    v4u sb[4]; TileRegs tq, tk, tv;
    { const size_t tok0 = (size_t)b * SEQ + 128 * n_small;
      tile_fetch(tq, PROJ + tok0 * PROJ_W + 128 * h, PROJ_W, F.tid); tile_fetch(tk, PROJ + tok0 * PROJ_W + 512 + 128 * h, PROJ_W, F.tid); tile_fetch(tv, PROJ + tok0 * PROJ_W + 1024 + 128 * h, PROJ_W, F.tid); }
    __syncthreads();
    { const bf16* kv = (const bf16*)(F.ws + WS_KV) + (size_t)bh * NCHUNK * 16384 + (size_t)F.tid * 8;
      float s[4][8];
#pragma unroll
      for (int i = 0; i < 4; ++i)
#pragma unroll
          for (int j = 0; j < 8; ++j) s[i][j] = 0.f;
      const int a = n_small >> 1; const bool odd = (n_small & 1) != 0; const float cd2 = cd * cd;
      kv_horner<4>(s, kv, 1, a, cd2);
      { v4u x[4];
#pragma unroll
        for (int i = 0; i < 4; ++i) x[i] = (v4u){0u, 0u, 0u, 0u};
        if (odd) {
#pragma unroll
            for (int i = 0; i < 4; ++i) x[i] = *(const v4u*)(kv + (size_t)(2 * a) * 16384 + (size_t)(NTHREADS * i) * 8); }
        const float f1 = odd ? cd : 1.0f;
        if (n_small > 0) {
#pragma unroll
            for (int i = 0; i < 4; ++i) { const int c = F.tid + NTHREADS * i, e = c >> 4, ch = c & 15; v4u o;
#pragma unroll
                for (int j = 0; j < 4; ++j) o[j] = pk2(s[i][2 * j] * f1 + bflo(x[i][j]), s[i][2 * j + 1] * f1 + bfhi(x[i][j]));
                *(LAS v4u*)(St + e * LP + ch * 16) = o; } } }
      kv_horner<4>(s, kv, 2 * a + 1, 7 - 2 * a, cd2);
      kv_step1(s, kv, 14 - 2 * a, !odd, odd ? 1.0f : cd);
#pragma unroll
      for (int i = 0; i < 4; ++i) { sb[i].x = pk2(s[i][0], s[i][1]); sb[i].y = pk2(s[i][2], s[i][3]); sb[i].z = pk2(s[i][4], s[i][5]); sb[i].w = pk2(s[i][6], s[i][7]); }
    }
#pragma unroll 1
    for (int pass = 0; pass < 2; ++pass) {
        const int n = pass == 0 ? n_small : n_big; const size_t tok0 = (size_t)b * SEQ + 128 * n;
        int opq = 0; asm volatile("" : "+v"(opq));
        if (pass == 1) { __syncthreads();
#pragma unroll
            for (int i = 0; i < 4; ++i) { const int c = F.tid + NTHREADS * i, e = c >> 4, ch = c & 15; *(LAS v4u*)(St + e * LP + ch * 16) = sb[i]; } }
        if (pass == 1) { tile_fetch(tq, PROJ + tok0 * PROJ_W + 128 * h, PROJ_W, F.tid); tile_fetch(tk, PROJ + tok0 * PROJ_W + 512 + 128 * h, PROJ_W, F.tid); tile_fetch(tv, PROJ + tok0 * PROJ_W + 1024 + 128 * h, PROJ_W, F.tid); }
        tile_stage<false>(Qs, tq, F.tid, 0.f); tile_stage<false>(Ks, tk, F.tid, 0.f); tile_stage<false>(Vs, tv, F.tid, 0.f);
        v2u gg[8]; const bf16* gp = PROJ + (tok0 + q) * PROJ_W + 1536 + 128 * h + 4 * fq;
#pragma unroll
        for (int j = 0; j < 8; ++j) gg[j] = *(const v2u*)(gp + 16 * j);
        __syncthreads();
        f32x4 sc[8], oc[8];
#pragma unroll
        for (int j = 0; j < 8; ++j) { sc[j] = (f32x4){0.f, 0.f, 0.f, 0.f}; oc[j] = (f32x4){0.f, 0.f, 0.f, 0.f}; }
        mm16<false, false>(sc, Qs, Ks, w, fr, fq);
        if (n > 0) { mm16<false, false>(oc, Qs, St, w, fr, fq); const float qd = exp2f(lg * (float)(q + 1 + opq));
#pragma unroll
            for (int j = 0; j < 8; ++j) oc[j] = oc[j] * qd; }
#pragma unroll
        for (int j = 0; j < 8; ++j) { float pv[4];
#pragma unroll
            for (int i = 0; i < 4; ++i) { const int k = 16 * j + 4 * fq + i; pv[i] = (q >= k) ? sc[j][i] * exp2f(lg * (float)(q - k + opq)) : 0.f; }
            v2u wv; wv.x = pk2(pv[0], pv[1]); wv.y = pk2(pv[2], pv[3]); *(LAS v2u*)(Qs + q * LP + (16 * j + 4 * fq) * 2) = wv; }
        asm volatile("s_waitcnt lgkmcnt(0)" ::: "memory");
        mm16<false, true>(oc, Qs, Vs, w, fr, fq);
        float ss = 0.f;
#pragma unroll
        for (int j = 0; j < 8; ++j) ss += (oc[j][0] * oc[j][0] + oc[j][1] * oc[j][1]) + (oc[j][2] * oc[j][2] + oc[j][3] * oc[j][3]);
        ss += __shfl_xor(ss, 16); ss += __shfl_xor(ss, 32);
        const float rstd = 1.0f / sqrtf(ss * (1.0f / 128.0f) + EPS);
        const float* rg = F.in[3] + 128 * h + 4 * fq + opq;
        bf16* o = (bf16*)(F.ws + WS_MIX) + (tok0 + q) * DM + 128 * h + 4 * fq;
#pragma unroll
        for (int j = 0; j < 8; ++j) { const f32x4 rgv = *(const f32x4*)(rg + 16 * j);
            v2u wv; wv.x = pk2(oc[j][0] * rstd * rgv[0] * bflo(gg[j].x), oc[j][1] * rstd * rgv[1] * bfhi(gg[j].x));
            wv.y = pk2(oc[j][2] * rstd * rgv[2] * bflo(gg[j].y), oc[j][3] * rstd * rgv[3] * bfhi(gg[j].y));
            *(v2u*)(o + 16 * j) = wv; }
    }
}

#define XB_TMO      128
#define XB_XCNT(j)  (256  + 64 * (j))
#define XB_XSUB(j)  (1280 + 64 * (j))
#define XB_XGEN(j)  (2304 + 64 * (j))
#define XB_TOP      3328
#define XB_TOPGEN   3392
#define XCD_BAR_WORDS 3456
#define XB_SPIN_CAP (1u << 18)
__device__ __forceinline__ unsigned xb_ld(unsigned* p)              { return __hip_atomic_load(p, __ATOMIC_RELAXED, __HIP_MEMORY_SCOPE_AGENT); }
__device__ __forceinline__ unsigned xb_add(unsigned* p, unsigned v) { return __hip_atomic_fetch_add(p, v, __ATOMIC_RELAXED, __HIP_MEMORY_SCOPE_AGENT); }
__device__ __forceinline__ unsigned xb_xcc_id() { return (unsigned)__builtin_amdgcn_s_getreg((3 << 11) | 20) & 0xFu; }
#define XB_SPIN(cond, bar) do { unsigned _sp = 0; while (cond) { __builtin_amdgcn_s_sleep(1); \
    if ((++_sp & 255u) == 0u) { if (xb_ld(&(bar)[XB_TMO])) break; if (_sp > XB_SPIN_CAP) { atomicAdd(&(bar)[XB_TMO], 1u); break; } } } } while (0)
struct XcdBarrier { unsigned* bar; unsigned x; volatile LAS unsigned* st; };
__device__ __forceinline__ XcdBarrier xcd_barrier_post(unsigned* bar, volatile LAS unsigned* st) {
    XcdBarrier b; b.bar = bar; b.x = xb_xcc_id(); b.st = st;
    if (threadIdx.x == 0) (void)xb_add(&bar[XB_XCNT(b.x)], 1u);
    return b;
}
__device__ __forceinline__ void xcd_barrier_complete(unsigned* bar, unsigned x, unsigned& nloc, unsigned& nx) {
    const unsigned G = gridDim.x * gridDim.y * gridDim.z;
    unsigned sum, cnt, mine, sp = 0u;
    for (;;) {
        sum = 0u; cnt = 0u; mine = 0u;
#pragma unroll
        for (unsigned j = 0; j < 16; ++j) { const unsigned c = xb_ld(&bar[XB_XCNT(j)]); sum += c; cnt += (c > 0u) ? 1u : 0u; mine = (j == x) ? c : mine; }
        if (sum == G) break;
        __builtin_amdgcn_s_sleep(1);
        if ((++sp & 255u) == 0u) { if (xb_ld(&bar[XB_TMO])) break; if (sp > XB_SPIN_CAP) { atomicAdd(&bar[XB_TMO], 1u); break; } }
    }
    nloc = mine > 0u ? mine : 1u; nx = cnt > 0u ? cnt : 1u;
}
__device__ __forceinline__ void xcd_barrier(const XcdBarrier& b) {
    asm volatile("s_waitcnt vmcnt(0)" ::: "memory");
    __syncthreads();
    if (threadIdx.x == 0) {
        unsigned* bar = b.bar;
        __builtin_amdgcn_s_waitcnt(0);
        unsigned nloc = b.st[0], nx = b.st[1];
        if (nloc == 0u) { xcd_barrier_complete(bar, b.x, nloc, nx); b.st[0] = nloc; b.st[1] = nx; }
        const unsigned old = xb_add(&bar[XB_XSUB(b.x)], 1u);
        const unsigned gen = old / nloc;
        if (old + 1u == (gen + 1u) * nloc) {
            __builtin_amdgcn_fence(__ATOMIC_RELEASE, "agent");
            asm volatile("s_waitcnt vmcnt(0)" ::: "memory");
            const unsigned og = xb_add(&bar[XB_TOP], 1u);
            const unsigned tg = og / nx;
            if (og + 1u == (tg + 1u) * nx) xb_add(&bar[XB_TOPGEN], 1u);
            else XB_SPIN(xb_ld(&bar[XB_TOPGEN]) == tg, bar);
            __builtin_amdgcn_fence(__ATOMIC_ACQUIRE, "agent");
            xb_add(&bar[XB_XGEN(b.x)], 1u);
            asm volatile("s_waitcnt vmcnt(0)" ::: "memory");
        } else {
            XB_SPIN(xb_ld(&bar[XB_XGEN(b.x)]) == gen, bar);
            __builtin_amdgcn_fence(__ATOMIC_ACQUIRE, "agent");
            asm volatile("s_waitcnt vmcnt(0)" ::: "memory");
        }
    }
    __syncthreads();
}

struct Args { const float* in[15]; float* out; unsigned char* ws; int ph_lo, ph_hi; };
constexpr int NPHASE = 7;
__global__ void __launch_bounds__(NTHREADS, 2) fwd_megakernel(Args args) {
    extern __shared__ __attribute__((aligned(16))) unsigned char lds[];
    Frame F;
    F.lds = (LAS unsigned char*)lds; F.ws = args.ws;
    F.tid = threadIdx.x; F.lane = F.tid & 63; F.wave = __builtin_amdgcn_readfirstlane(F.tid >> 6);
    F.G = gridDim.x; F.bid = blockIdx.x;
#pragma unroll
    for (int i = 0; i < 15; ++i) F.in[i] = args.in[i];
    F.out = args.out;
    const int lo = args.ph_lo, hi = args.ph_hi;
    volatile LAS unsigned* MISC = (volatile LAS unsigned*)(F.lds + MISC_OFF);
    if (F.tid < 16) MISC[F.tid] = 0u;
    __syncthreads();
    XcdBarrier bar; bar.bar = (unsigned*)(F.ws + WS_BAR); bar.x = 0; bar.st = nullptr;
    if (hi - lo > 1) bar = xcd_barrier_post((unsigned*)(F.ws + WS_BAR), MISC);
    if (lo < 0) cg::this_grid().sync();
#define IN(k) (lo <= (k) && (k) < hi)
#if MK_CGSYNC
#define SEAM(k) do { if (IN(k) && IN((k) + 1)) cg::this_grid().sync(); } while (0)
#else
#define SEAM(k) do { if (IN(k) && IN((k) + 1)) xcd_barrier(bar); } while (0)
#endif
#if MK_SPIN >= 0
    unsigned long long t0_ = 0;
#define PH_BEGIN(k) do { if ((k) == MK_SPIN) t0_ = __builtin_amdgcn_s_memrealtime(); } while (0)
#define PH_END(k) do { if ((k) == MK_SPIN) { asm volatile("s_waitcnt vmcnt(0)" ::: "memory"); const unsigned long long t1_ = __builtin_amdgcn_s_memrealtime(); while (__builtin_amdgcn_s_memrealtime() - t1_ < (t1_ - t0_)) __builtin_amdgcn_s_sleep(8); } } while (0)
#else
#define PH_BEGIN(k) do {} while (0)
#define PH_END(k) do {} while (0)
#endif

    PH_BEGIN(0);
    if (IN(0)) p0_prologue(F);
    PH_END(0);
    SEAM(0);
    PH_BEGIN(1);
    if (IN(1)) {
        pg8::Gemm g{(const bf16*)(F.ws + WS_XN), (const bf16*)(F.ws + WS_WIN), M, PROJ_W, DM}; pg8::StaticOrder S; S.init(M, PROJ_W, F.G, F.bid);
        pg8::EpiProj E{(bf16*)(F.ws + WS_PROJ), (const float*)(F.ws + WS_ROPE), (const float*)(F.ws + WS_SSQ0)};
        pg8::gemm_phase<pg8::EpiProj, pg8::StaticOrder, true, true>(F.lds, g, S, E);
        p1_tail(F);
    }
    PH_END(1);
    SEAM(1);
    PH_BEGIN(2);
    if (IN(2)) p2_phase(F);
    PH_END(2);
    SEAM(2);
    PH_BEGIN(3);
    if (IN(3)) {
        for (int it = F.bid; it < 256; it += F.G) ret_pair(F, it >> 3, it & 7);
        __syncthreads();
    }
    PH_END(3);
    SEAM(3);
    PH_BEGIN(4);
    if (IN(4)) {
        pg8::Gemm g{(const bf16*)(F.ws + WS_MIX), (const bf16*)(F.ws + WS_WOUT), M, DM, DM}; pg8::StaticOrder S; S.init(M, DM, F.G, F.bid);
        pg8::EpiRes<true> E{(const bf16*)(F.ws + WS_XN), F.out, (bf16*)(F.ws + WS_XN), F.in[9], (float*)(F.ws + WS_SSQ1)};
        pg8::gemm_phase<pg8::EpiRes<true>, pg8::StaticOrder, false, true>(F.lds, g, S, E);
    }
    PH_END(4);
    SEAM(4);
    PH_BEGIN(5);
    if (IN(5)) {
        pg8::Gemm g{(const bf16*)(F.ws + WS_XN), (const bf16*)(F.ws + WS_WUP), M, UPW, DM}; pg8::StaticOrder S; S.init(M, UPW, F.G, F.bid);
        pg8::EpiConv E{(const float*)(F.ws + WS_SSQ1), F.in[11], F.in[12], (bf16*)(F.ws + WS_ACT), (float*)(F.ws + WS_EDGE)};
        pg8::gemm_phase<pg8::EpiConv, pg8::StaticOrder, true, true>(F.lds, g, S, E);
        if (2 * F.bid >= F.G) { LAS float* scr = (LAS float*)(F.lds + F.wave * 16384); const int hw = (F.bid - F.G / 2) * NWAVES + F.wave, NHW = (F.G - F.G / 2) * NWAVES;
            for (int it = hw; it < I_DN; it += NHW) { const WItem w = witem_down(F, it); f32x4 v[8]; witem_load(w, v, F.lane); witem_finish(w, v, scr, F.lane); } }
    }
    PH_END(5);
    SEAM(5);
    PH_BEGIN(6);
    if (IN(6)) {
        pg8::Gemm g{(const bf16*)(F.ws + WS_ACT), (const bf16*)(F.ws + WS_WDOWN), M, DM, DFF}; pg8::StaticOrder S; S.init(M, DM, F.G, F.bid);
        pg8::Unit u0;
        if (S.next(0, u0)) {
            const float* edge = (const float*)(F.ws + WS_EDGE); const float* cw = F.in[11]; const float* cb = F.in[12]; bf16* act = (bf16*)(F.ws + WS_ACT);
            for (int i = F.tid; i < 2 * (DFF / 4); i += NTHREADS) { const int rl = i >= (DFF / 4) ? 1 : 0; const int run = 2 * u0.pm + rl, c = 4 * (i - rl * (DFF / 4));
                const float* e = edge + (size_t)run * 4 * UPW; const bool first = (run & 15) == 0;
                f32x4 y0[2], y1[2];
#pragma unroll
                for (int hb = 0; hb < 2; ++hb) { const int cc = c + hb * DFF; const f32x4 z = (f32x4){0.f, 0.f, 0.f, 0.f};
                    const f32x4 f0 = *(const f32x4*)(e + cc), f1 = *(const f32x4*)(e + UPW + cc);
                    const f32x4 p2 = first ? z : *(const f32x4*)(e + cc - 2 * UPW), p1 = first ? z : *(const f32x4*)(e + cc - UPW);
                    const f32x4 w0 = *(const f32x4*)(cw + cc), w1 = *(const f32x4*)(cw + UPW + cc), w2 = *(const f32x4*)(cw + 2 * UPW + cc), bb = *(const f32x4*)(cb + cc);
                    y0[hb] = w2 * f0 + w1 * p1 + w0 * p2 + bb; y1[hb] = w2 * f1 + w1 * f0 + w0 * p1 + bb; }
                *(v2u*)(act + (size_t)(128 * run) * DFF + c) = (v2u){pk2(pg8::silu_f(y0[0][0]) * y0[1][0], pg8::silu_f(y0[0][1]) * y0[1][1]), pk2(pg8::silu_f(y0[0][2]) * y0[1][2], pg8::silu_f(y0[0][3]) * y0[1][3])};
                *(v2u*)(act + (size_t)(128 * run + 1) * DFF + c) = (v2u){pk2(pg8::silu_f(y1[0][0]) * y1[1][0], pg8::silu_f(y1[0][1]) * y1[1][1]), pk2(pg8::silu_f(y1[0][2]) * y1[1][2], pg8::silu_f(y1[0][3]) * y1[1][3])}; }
            asm volatile("s_waitcnt vmcnt(0)" ::: "memory");
            __syncthreads();
        }
        pg8::EpiFinal E{(const bf16*)(F.ws + WS_XN), F.in[9], F.out, F.in[14], (float*)(F.ws + WS_SSQ2), (unsigned*)(F.ws + WS_PCNT)};
        pg8::gemm_phase<pg8::EpiFinal, pg8::StaticOrder, true, true>(F.lds, g, S, E);
    }
    PH_END(6);
#undef IN
#undef SEAM
}

extern "C" void kernel_launch(void* const* d_in, const int* in_sizes, int n_in, void* d_out, int out_size, void* d_ws, size_t ws_size, hipStream_t stream) {
    static int grid = 0;
    if (grid == 0) {
        if (n_in != 15 || out_size != M * DM || ws_size < WS_END) { fprintf(stderr, "kernel_launch: unexpected shapes (n_in %d out %d ws %zu)\n", n_in, out_size, ws_size); grid = -1; return; }
        if (hipFuncSetAttribute((const void*)fwd_megakernel, hipFuncAttributeMaxDynamicSharedMemorySize, LDS_BYTES) != hipSuccess) { fprintf(stderr, "kernel_launch: hipFuncSetAttribute failed\n"); grid = -1; return; }
        int dev = 0, cus = 0, per_cu = 0;
        (void)hipGetDevice(&dev); (void)hipDeviceGetAttribute(&cus, hipDeviceAttributeMultiprocessorCount, dev);
        (void)hipOccupancyMaxActiveBlocksPerMultiprocessor(&per_cu, (const void*)fwd_megakernel, NTHREADS, LDS_BYTES);
        (void)hipGetLastError();
        if (per_cu < 1) per_cu = 1;
        grid = cus > 0 ? cus : 256;
    }
    if (grid < 0) return;
    Args a{};
    for (int i = 0; i < 15; ++i) a.in[i] = (const float*)d_in[i];
    a.out = (float*)d_out; a.ws = (unsigned char*)d_ws;
    if (hipMemsetAsync((char*)d_ws + WS_BAR, 0, WS_BAR_BYTES, stream) != hipSuccess) { fprintf(stderr, "kernel_launch: memset failed\n"); return; }
#if MK_MULTI
    for (int p = 0; p < NPHASE; ++p) { a.ph_lo = p; a.ph_hi = p + 1; const int reps = ((MK_REPMASK >> p) & 1) ? 2 : 1;
        for (int r = 0; r < reps; ++r) hipLaunchKernelGGL(fwd_megakernel, dim3(grid), dim3(NTHREADS), LDS_BYTES, stream, a); }
#else
    a.ph_lo = 0; a.ph_hi = NPHASE;
    void* kargs[] = {&a};
    hipError_t e = hipLaunchCooperativeKernel((const void*)fwd_megakernel, dim3(grid), dim3(NTHREADS), kargs, LDS_BYTES, stream);
    if (e != hipSuccess) fprintf(stderr, "cooperative launch failed: %s (grid %d)\n", hipGetErrorString(e), grid);
#endif
}
```

```cpp
#include <hip/hip_runtime.h>
#include <hip/hip_cooperative_groups.h>
#include <cstdio>
#include <cstdint>
namespace cg = cooperative_groups;
#ifndef MK_SPIN_EPI
#define MK_SPIN_EPI 0
#endif

namespace pg8 {
#define PG8_LAS __attribute__((address_space(3)))
typedef unsigned short bf16_t;
typedef short bf16x8 __attribute__((ext_vector_type(8)));
typedef float f32x4 __attribute__((ext_vector_type(4)));
typedef float f32x2 __attribute__((ext_vector_type(2)));
typedef unsigned u32x4 __attribute__((ext_vector_type(4)));
typedef unsigned u32x2 __attribute__((ext_vector_type(2)));
constexpr int BM = 256, BK = 64, HALF = 128, HTB = HALF * BK * 2  , STAGE_BYTES = 8 * HTB, NXCD = 8, WGM = 8;

__host__ __device__ __forceinline__ int lds_byte(int r, int c) { const int st = (r >> 4) * 2 + (c >> 5), rr = r & 15, cc = c & 31, ob = rr * 64 + cc * 2; return st * 1024 + (ob ^ (((ob >> 9) & 1) << 5)); }
__host__ __device__ __forceinline__ void stage_rc(int b, int& R, int& C) { const int st = b / 1024, sb = b % 1024, swz = sb ^ (((sb >> 9) & 1) << 5); R = (st >> 1) * 16 + swz / 64; C = (st & 1) * 32 + (swz % 64) / 2; }
__host__ __device__ __forceinline__ int perm32(int rho) { const int n = rho >> 4, i = rho & 15; return 8 * (i >> 2) + 4 * n + (i & 3); }
__host__ __device__ __forceinline__ int tokrow(int R) { return 128 * (R >> 6) + 8 * (R & 15) + ((R >> 4) & 3); }

struct Unit { int pm, pn; };
struct Gemm { const bf16_t* A; const bf16_t* Bt; int M, N, K; };

struct StaticOrder {
    int nM, nN, nwg, G, c;
    __host__ __device__ void init(int M, int N, int G_, int c_) { nM = M / BM; nN = N / BM; nwg = nM * nN; G = G_; c = c_; }
    __host__ __device__ bool next(int i, Unit& u) const {
        const long L = (long)i * G + c; if (L >= nwg) return false;
        int wgid = (int)L; { const int q = nwg / NXCD, r = nwg % NXCD, xcd = wgid % NXCD, off = wgid / NXCD; wgid = (xcd < r ? xcd * (q + 1) : r * (q + 1) + (xcd - r) * q) + off; }
        const int nig = WGM * nN, gid = wgid / nig, fm = gid * WGM, gsz = (nM - fm) < WGM ? (nM - fm) : WGM;
        u.pm = fm + ((wgid % nig) % gsz); u.pn = (wgid % nig) / gsz; return true;
    }
    __device__ __forceinline__ void a_ready(const Unit&) const {}
    __device__ __forceinline__ void done(const Unit&) const {}
};

__device__ __forceinline__ unsigned cvt_pk_bf16(float lo, float hi) { unsigned r; asm volatile("v_cvt_pk_bf16_f32 %0, %1, %2" : "=v"(r) : "v"(lo), "v"(hi)); return r; }
__device__ __forceinline__ f32x2 gelu_pk(f32x2 v) {
    const f32x2 av = __builtin_elementwise_abs(v), d = av * 0.2316418882f + 1.0f;
    f32x2 t; t.x = __builtin_amdgcn_rcpf(d.x); t.y = __builtin_amdgcn_rcpf(d.y);
    f32x2 q = t * 0.5307027145f + (-0.7265760135f); q = q * t + 0.7107068705f; q = q * t + (-0.142248368f); q = q * t + 0.127414796f; q = q * t;
    const f32x2 s = (v * v) * (-0.72134752044f);
    f32x2 e; e.x = __builtin_amdgcn_exp2f(s.x); e.y = __builtin_amdgcn_exp2f(s.y);
    const f32x2 m = v * (q * e), r = v - m;
    f32x2 o; o.x = v.x < 0.f ? m.x : r.x; o.y = v.y < 0.f ? m.y : r.y; return o;
}
__device__ __forceinline__ float silu_f(float v) { return v * __builtin_amdgcn_rcpf(1.f + __builtin_amdgcn_exp2f(-1.4426950408889634f * v)); }
__device__ __forceinline__ f32x4 silu4(f32x4 v) { return (f32x4){silu_f(v[0]), silu_f(v[1]), silu_f(v[2]), silu_f(v[3])}; }
__device__ __forceinline__ f32x4 gelu4(f32x4 v) { const f32x2 a = gelu_pk((f32x2){v[0], v[1]}), b = gelu_pk((f32x2){v[2], v[3]}); return (f32x4){a.x, a.y, b.x, b.y}; }
__device__ __forceinline__ u32x2 pack4(f32x4 v) { u32x2 w; w.x = cvt_pk_bf16(v[0], v[1]); w.y = cvt_pk_bf16(v[2], v[3]); return w; }

constexpr int PROJ_W = 3072, DM = 1024, DFF = 2816, UPW = 5632, SEQ = 2048;
constexpr float EPS = 1e-6f;

struct EpiProj {
    static constexpr bool PERM = true, AFTER_DRAIN = false, AROWPERM = false; static constexpr int PROBE_ID = 1;
    bf16_t* O; const float* rope; const float* ssq0;
    __device__ __forceinline__ void operator()(const f32x4 (&acc)[2][2][4][2], const Unit& u, int wr, int wc, int fr, int fq) const {
        const int row0 = u.pm * BM + wr * 64 + fr; const int type = u.pn >> 1;
        if (type < 2) {
            const float sc = (type == 1) ? 0.08838834764831845f : 1.0f; const int pp = 16 * wc + 4 * fq;
#pragma unroll
            for (int ai = 0; ai < 2; ++ai)
#pragma unroll
                for (int m = 0; m < 4; ++m) { const int row = row0 + ai * HALF + m * 16; const int pos = row & (SEQ - 1);
                    const float rs = __builtin_amdgcn_rsqf(ssq0[row] * (1.0f / DM) + EPS) * sc;
                    const f32x4 c = *(const f32x4*)(rope + pos * 128 + pp) * rs, s = *(const f32x4*)(rope + pos * 128 + 64 + pp) * rs;
#pragma unroll
                    for (int bj = 0; bj < 2; ++bj) { const f32x4 x1 = acc[ai][bj][m][0], x2 = acc[ai][bj][m][1];
                        const f32x4 o1 = x1 * c - x2 * s, o2 = x2 * c + x1 * s;
                        bf16_t* p = O + (size_t)row * PROJ_W + u.pn * BM + bj * HALF + pp;
                        *(u32x2*)p = pack4(o1); *(u32x2*)(p + 64) = pack4(o2); } }
        } else {
            const int col0 = u.pn * BM + wc * 32 + 8 * fq;
#pragma unroll
            for (int ai = 0; ai < 2; ++ai)
#pragma unroll
                for (int m = 0; m < 4; ++m) { const int row = row0 + ai * HALF + m * 16; bf16_t* rowp = O + (size_t)row * PROJ_W + col0;
                    const float rs = __builtin_amdgcn_rsqf(ssq0[row] * (1.0f / DM) + EPS);
#pragma unroll
                    for (int bj = 0; bj < 2; ++bj) { f32x4 v0 = acc[ai][bj][m][0] * rs, v1 = acc[ai][bj][m][1] * rs;
                        if (type == 3) { v0 = silu4(v0); v1 = silu4(v1); } else if (type >= 4) { v0 = gelu4(v0); v1 = gelu4(v1); }
                        const u32x2 a = pack4(v0), b = pack4(v1); u32x4 w; w.x = a.x; w.y = a.y; w.z = b.x; w.w = b.y;
                        *(u32x4*)(rowp + bj * HALF) = w; } }
        }
    }
};

template <bool WRITE_XG> struct EpiRes {
    static constexpr bool PERM = false, AFTER_DRAIN = false, AROWPERM = false; static constexpr int PROBE_ID = 4;
    const bf16_t* base; float* out; bf16_t* xg; const float* gain; float* ssq;
    __device__ __forceinline__ void operator()(const f32x4 (&acc)[2][2][4][2], const Unit& u, int wr, int wc, int fr, int fq) const {
        const int col0 = u.pn * BM + wc * 32 + 4 * fq;
        f32x4 gv[2][2];
#pragma unroll
        for (int bj = 0; bj < 2; ++bj)
#pragma unroll
            for (int n = 0; n < 2; ++n) gv[bj][n] = WRITE_XG ? *(const f32x4*)(gain + col0 + bj * HALF + n * 16) : (f32x4){0.f, 0.f, 0.f, 0.f};
#pragma unroll
        for (int ai = 0; ai < 2; ++ai)
#pragma unroll
            for (int m = 0; m < 4; ++m) { const int row = u.pm * BM + ai * HALF + wr * 64 + m * 16 + fr; const size_t off = (size_t)row * DM + col0; float s = 0.f;
#pragma unroll
                for (int bj = 0; bj < 2; ++bj)
#pragma unroll
                    for (int n = 0; n < 2; ++n) { const u32x2 xb = *(const u32x2*)(base + off + bj * HALF + n * 16);
                        const f32x4 x1 = (f32x4){__uint_as_float(xb.x << 16), __uint_as_float(xb.x & 0xffff0000u), __uint_as_float(xb.y << 16), __uint_as_float(xb.y & 0xffff0000u)} + acc[ai][bj][m][n];
                        if (!WRITE_XG) *(f32x4*)(out + off + bj * HALF + n * 16) = x1; s += (x1[0] * x1[0] + x1[1] * x1[1]) + (x1[2] * x1[2] + x1[3] * x1[3]);
                        if (WRITE_XG) *(u32x2*)(xg + off + bj * HALF + n * 16) = pack4(x1 * gv[bj][n]); }
                s += __shfl_xor(s, 16); s += __shfl_xor(s, 32);
                if (fq == 0) (void)__hip_atomic_fetch_add(ssq + row, s, __ATOMIC_RELAXED, __HIP_MEMORY_SCOPE_AGENT);
                if (m == 3) asm volatile("" ::: "memory"); }
    }
};

struct EpiFinal {
    static constexpr bool PERM = false, AFTER_DRAIN = false, AROWPERM = false; static constexpr int PROBE_ID = 6;
    const bf16_t* xg; const float* gffn; float* out; const float* gain; float* ssq; unsigned* cnt;
    __device__ __forceinline__ void operator()(f32x4 (&acc)[2][2][4][2], const Unit& u, int wr, int wc, int fr, int fq) const {
        const int col0 = u.pn * BM + wc * 32 + 4 * fq;
        f32x4 gi[2][2];
#pragma unroll
        for (int bj = 0; bj < 2; ++bj)
#pragma unroll
            for (int n = 0; n < 2; ++n) { const f32x4 gf = *(const f32x4*)(gffn + col0 + bj * HALF + n * 16); gi[bj][n] = (f32x4){1.0f / gf[0], 1.0f / gf[1], 1.0f / gf[2], 1.0f / gf[3]}; }
#pragma unroll
        for (int ai = 0; ai < 2; ++ai)
#pragma unroll
            for (int m = 0; m < 4; ++m) { const int row = u.pm * BM + ai * HALF + wr * 64 + m * 16 + fr; const size_t off = (size_t)row * DM + col0; float s = 0.f;
#pragma unroll
                for (int bj = 0; bj < 2; ++bj)
#pragma unroll
                    for (int n = 0; n < 2; ++n) { const u32x2 xb = *(const u32x2*)(xg + off + bj * HALF + n * 16);
                        const f32x4 x1 = (f32x4){__uint_as_float(xb.x << 16), __uint_as_float(xb.x & 0xffff0000u), __uint_as_float(xb.y << 16), __uint_as_float(xb.y & 0xffff0000u)} * gi[bj][n];
                        const f32x4 x2 = x1 + acc[ai][bj][m][n];
                        acc[ai][bj][m][n] = x2; s += (x2[0] * x2[0] + x2[1] * x2[1]) + (x2[2] * x2[2] + x2[3] * x2[3]); }
                s += __shfl_xor(s, 16); s += __shfl_xor(s, 32);
                if (fq == 0) (void)__hip_atomic_fetch_add(ssq + row, s, __ATOMIC_RELAXED, __HIP_MEMORY_SCOPE_AGENT);
                if (m == 3) asm volatile("" ::: "memory"); }
        asm volatile("s_waitcnt vmcnt(0)" ::: "memory");
        unsigned* c = cnt + 64 * u.pm;
        if ((threadIdx.x & 63) == 0) (void)__hip_atomic_fetch_add(c, 1u, __ATOMIC_RELAXED, __HIP_MEMORY_SCOPE_AGENT);
        { unsigned sp = 0;
          while ((unsigned)__builtin_amdgcn_readfirstlane(__hip_atomic_load(c, __ATOMIC_RELAXED, __HIP_MEMORY_SCOPE_AGENT)) < 32u) { __builtin_amdgcn_s_sleep(2); if (++sp > (1u << 22)) break; } }
        __builtin_amdgcn_fence(__ATOMIC_ACQUIRE, "agent");
        f32x4 gv[2][2];
#pragma unroll
        for (int bj = 0; bj < 2; ++bj)
#pragma unroll
            for (int n = 0; n < 2; ++n) gv[bj][n] = *(const f32x4*)(gain + col0 + bj * HALF + n * 16);
#pragma unroll
        for (int ai = 0; ai < 2; ++ai)
#pragma unroll
            for (int m = 0; m < 4; ++m) { const int row = u.pm * BM + ai * HALF + wr * 64 + m * 16 + fr; const size_t off = (size_t)row * DM + col0;
                const float tot = __hip_atomic_load(ssq + row, __ATOMIC_RELAXED, __HIP_MEMORY_SCOPE_AGENT);
                const float rstd = __builtin_amdgcn_rsqf(tot * (1.0f / DM) + EPS);
#pragma unroll
                for (int bj = 0; bj < 2; ++bj)
#pragma unroll
                    for (int n = 0; n < 2; ++n) *(f32x4*)(out + off + bj * HALF + n * 16) = acc[ai][bj][m][n] * rstd * gv[bj][n]; }
    }
};

__device__ __forceinline__ float dpp_shr1(float v) { return __int_as_float(__builtin_amdgcn_update_dpp(0, __float_as_int(v), 0x111, 0xf, 0xf, true)); }
__device__ __forceinline__ f32x4 dpp_shr1_4(f32x4 v) { return (f32x4){dpp_shr1(v[0]), dpp_shr1(v[1]), dpp_shr1(v[2]), dpp_shr1(v[3])}; }
struct EpiConv {
    static constexpr bool PERM = true, AFTER_DRAIN = false, AROWPERM = true; static constexpr int PROBE_ID = 5;
    const float* ssq; const float* cw; const float* cb; bf16_t* act; float* edge;
    __device__ __forceinline__ void operator()(const f32x4 (&acc)[2][2][4][2], const Unit& u, int wr, int wc, int fr, int fq) const {
        const int run = u.pm * 2 + wr; const int tok0 = u.pm * BM + wr * HALF + 8 * fr;
        float rstd[8];
        { const f32x4 s0 = *(const f32x4*)(ssq + tok0), s1 = *(const f32x4*)(ssq + tok0 + 4);
#pragma unroll
          for (int i = 0; i < 4; ++i) { rstd[i] = __builtin_amdgcn_rsqf(s0[i] * (1.0f / DM) + EPS); rstd[4 + i] = __builtin_amdgcn_rsqf(s1[i] * (1.0f / DM) + EPS); } }
        u32x2 pk0[8];
#pragma unroll
        for (int n = 0; n < 2; ++n) {
            const int ca = u.pn * HALF + wc * 32 + 8 * fq + 4 * n;
            const f32x4 w0a = *(const f32x4*)(cw + ca), w1a = *(const f32x4*)(cw + UPW + ca), w2a = *(const f32x4*)(cw + 2 * UPW + ca), ba = *(const f32x4*)(cb + ca);
            const f32x4 w0b = *(const f32x4*)(cw + DFF + ca), w1b = *(const f32x4*)(cw + UPW + DFF + ca), w2b = *(const f32x4*)(cw + 2 * UPW + DFF + ca), bb = *(const f32x4*)(cb + DFF + ca);
            f32x4 ua[8], ub[8];
#pragma unroll
            for (int t = 0; t < 8; ++t) { ua[t] = acc[t >> 2][0][t & 3][n] * rstd[t]; ub[t] = acc[t >> 2][1][t & 3][n] * rstd[t]; }
            const f32x4 pa1 = dpp_shr1_4(ua[7]), pa2 = dpp_shr1_4(ua[6]), pb1 = dpp_shr1_4(ub[7]), pb2 = dpp_shr1_4(ub[6]);
            if (fr == 0) { float* e = edge + (size_t)run * 4 * UPW; *(f32x4*)(e + ca) = ua[0]; *(f32x4*)(e + UPW + ca) = ua[1]; *(f32x4*)(e + DFF + ca) = ub[0]; *(f32x4*)(e + UPW + DFF + ca) = ub[1]; }
            if (fr == 15) { float* e = edge + (size_t)run * 4 * UPW + 2 * UPW; *(f32x4*)(e + ca) = ua[6]; *(f32x4*)(e + UPW + ca) = ua[7]; *(f32x4*)(e + DFF + ca) = ub[6]; *(f32x4*)(e + UPW + DFF + ca) = ub[7]; }
#pragma unroll
            for (int t = 0; t < 8; ++t) {
                const f32x4 am1 = (t >= 1) ? ua[t >= 1 ? t - 1 : 0] : pa1, am2 = (t >= 2) ? ua[t >= 2 ? t - 2 : 0] : (t == 1 ? pa1 : pa2);
                const f32x4 bm1 = (t >= 1) ? ub[t >= 1 ? t - 1 : 0] : pb1, bm2 = (t >= 2) ? ub[t >= 2 ? t - 2 : 0] : (t == 1 ? pb1 : pb2);
                const f32x4 ya = w2a * ua[t] + w1a * am1 + w0a * am2 + ba, yb = w2b * ub[t] + w1b * bm1 + w0b * bm2 + bb;
                const u32x2 pk = pack4(silu4(ya) * yb);
                if (n == 0) pk0[t] = pk;
                else if (!(fr == 0 && t < 2)) { u32x4 w; w.x = pk0[t].x; w.y = pk0[t].y; w.z = pk.x; w.w = pk.y;
                    *(u32x4*)(act + (size_t)(tok0 + t) * DFF + u.pn * HALF + wc * 32 + 8 * fq) = w; }
            }
        }
    }
};
template <class Epi, class Sched, bool ALIGN_EPI = false, bool SP2 = false>
__device__ __forceinline__ void gemm_phase(PG8_LAS unsigned char* lds, const Gemm g, const Sched& S, const Epi& E) {
    const int tid = threadIdx.x, wid = __builtin_amdgcn_readfirstlane(tid >> 6), lane = tid & 63, wr = wid >> 2, wc = wid & 3, fr = lane & 15, fq = lane >> 4;
    const int K = g.K, nt = K / BK;
    unsigned voffA[2], voffB[2];
#pragma unroll
    for (int i = 0; i < 2; ++i) { int R, C; stage_rc(tid * 16 + i * 8192, R, C); const int Rb = Epi::PERM ? ((R & ~31) + perm32(R & 31)) : R;
        voffA[i] = (unsigned)((Epi::AROWPERM ? tokrow(R) : R) * K + C) * 2u; voffB[i] = (unsigned)(Rb * K + C) * 2u; }
    const size_t kstep = (size_t)(BK * 2);
    const size_t hstepB = (size_t)HALF * K * 2; const size_t hstepA = Epi::AROWPERM ? (size_t)4 * K * 2 : hstepB;
    const size_t tstep = 2 * hstepB;
    const unsigned ldsw = (unsigned)wid * 1024u;
    const int aoff = lds_byte(wr * 64 + fr, fq * 8), boff = lds_byte(wc * 32 + fr, fq * 8);
#define PG8_SA(b, h) (((b) * 2 + (h)) * HTB)
#define PG8_SB(b, h) ((4 + (b) * 2 + (h)) * HTB)
#define PG8_STAGE(bufoff, gbase, voff) do { _Pragma("unroll") for (int _i = 0; _i < 2; ++_i) \
        __builtin_amdgcn_global_load_lds((const unsigned*)((const char*)(gbase) + (voff)[_i]), (PG8_LAS unsigned*)(lds + (bufoff) + ldsw + _i * 8192), 16, 0, 0); } while (0)
#define PG8_LDA(dst, b, h) do { _Pragma("unroll") for (int m = 0; m < 4; ++m) _Pragma("unroll") for (int k = 0; k < 2; ++k) dst[m][k] = *(const PG8_LAS bf16x8*)(lds + PG8_SA(b, h) + aoff + m * 2048 + k * 1024); } while (0)
#define PG8_LDB(dst, b, h) do { _Pragma("unroll") for (int n = 0; n < 2; ++n) _Pragma("unroll") for (int k = 0; k < 2; ++k) dst[n][k] = *(const PG8_LAS bf16x8*)(lds + PG8_SB(b, h) + boff + n * 2048 + k * 1024); } while (0)
#define PG8_MMA(ai, bj, At, Bt) do { __builtin_amdgcn_s_setprio(1); _Pragma("unroll") for (int m = 0; m < 4; ++m) _Pragma("unroll") for (int n = 0; n < 2; ++n) _Pragma("unroll") for (int k = 0; k < 2; ++k) \
        acc[ai][bj][m][n] = __builtin_amdgcn_mfma_f32_16x16x32_bf16(Bt[n][k], At[m][k], acc[ai][bj][m][n], 0, 0, 0); __builtin_amdgcn_s_setprio(0); } while (0)
#define PG8_WAIT_V(n) asm volatile("s_waitcnt vmcnt(" #n ")" ::: "memory")
#define PG8_WAIT_L(n) asm volatile("s_waitcnt lgkmcnt(" #n ")" ::: "memory")
#define PG8_BAR __builtin_amdgcn_s_barrier()
#define PG8_SCHED __builtin_amdgcn_sched_barrier(0)
    Unit cur, nxt; int ui = 0;
    if (!S.next(0, cur)) return;
    f32x4 acc[2][2][4][2];
#pragma unroll
    for (int a = 0; a < 2; ++a)
#pragma unroll
        for (int b = 0; b < 2; ++b)
#pragma unroll
            for (int m = 0; m < 4; ++m)
#pragma unroll
                for (int n = 0; n < 2; ++n) acc[a][b][m][n] = (f32x4){0.f, 0.f, 0.f, 0.f};
    bf16x8 At[4][2], B0[2][2], B1[2][2];
    const char* cA = (const char*)g.A + (size_t)cur.pm * tstep; const char* cB = (const char*)g.Bt + (size_t)cur.pn * tstep;
    S.a_ready(cur);
    if constexpr (SP2) {
        PG8_STAGE(PG8_SB(0, 0), cB, voffB); PG8_STAGE(PG8_SB(0, 1), cB + hstepB, voffB); PG8_STAGE(PG8_SA(0, 0), cA, voffA); PG8_STAGE(PG8_SA(0, 1), cA + hstepA, voffA);
        if (wr == 1) PG8_BAR;
        PG8_WAIT_V(2); PG8_BAR;
        PG8_STAGE(PG8_SB(1, 0), cB + kstep, voffB); PG8_STAGE(PG8_SA(1, 0), cA + kstep, voffA); PG8_STAGE(PG8_SB(1, 1), cB + hstepB + kstep, voffB);
        PG8_WAIT_V(6); PG8_BAR;
    } else {
        PG8_STAGE(PG8_SB(0, 0), cB, voffB); PG8_STAGE(PG8_SA(0, 0), cA, voffA); PG8_STAGE(PG8_SB(0, 1), cB + hstepB, voffB); PG8_STAGE(PG8_SA(0, 1), cA + hstepA, voffA);
        if (wr == 1) PG8_BAR;
        PG8_WAIT_V(4); PG8_BAR;
        PG8_STAGE(PG8_SB(1, 0), cB + kstep, voffB); PG8_STAGE(PG8_SA(1, 0), cA + kstep, voffA); PG8_STAGE(PG8_SB(1, 1), cB + hstepB + kstep, voffB);
        PG8_WAIT_V(6); PG8_BAR;
    }
    for (;;) {
        const bool has_next = S.next(ui + 1, nxt);
        const char* nA = has_next ? (const char*)g.A + (size_t)nxt.pm * tstep : cA; const char* nB = has_next ? (const char*)g.Bt + (size_t)nxt.pn * tstep : cB;
        for (int t = 0; t < nt; t += 2) {
            const bool last = (t == nt - 2);
            const char* a1 = cA + (size_t)(t + 1) * kstep;
            const char* a2 = last ? nA : cA + (size_t)(t + 2) * kstep; const char* b2 = last ? nB : cB + (size_t)(t + 2) * kstep;
            const char* a3 = a2 + kstep; const char* b3 = b2 + kstep;
            if (last && has_next) S.a_ready(nxt);
            if constexpr (SP2) {
            PG8_LDB(B0, 0, 0); PG8_LDB(B1, 0, 1); PG8_SCHED; PG8_LDA(At, 0, 0); PG8_STAGE(PG8_SA(1, 1), a1 + hstepA, voffA);
            PG8_WAIT_V(8); PG8_WAIT_L(0); PG8_BAR; PG8_MMA(0, 0, At, B0); PG8_MMA(0, 1, At, B1); PG8_BAR; PG8_SCHED;
            PG8_LDA(At, 0, 1); PG8_STAGE(PG8_SB(0, 0), b2, voffB); PG8_STAGE(PG8_SB(0, 1), b2 + hstepB, voffB); PG8_STAGE(PG8_SA(0, 0), a2, voffA);
            PG8_WAIT_V(8); PG8_WAIT_L(0); PG8_BAR; PG8_MMA(1, 0, At, B0); PG8_MMA(1, 1, At, B1); PG8_BAR; PG8_SCHED;
            PG8_LDB(B0, 1, 0); PG8_LDB(B1, 1, 1); PG8_SCHED; PG8_LDA(At, 1, 0); PG8_STAGE(PG8_SA(0, 1), a2 + hstepA, voffA);
            PG8_WAIT_V(8); PG8_WAIT_L(0); PG8_BAR; PG8_MMA(0, 0, At, B0); PG8_MMA(0, 1, At, B1); PG8_BAR; PG8_SCHED;
            PG8_LDA(At, 1, 1); PG8_STAGE(PG8_SB(1, 0), b3, voffB); PG8_STAGE(PG8_SB(1, 1), b3 + hstepB, voffB); PG8_STAGE(PG8_SA(1, 0), a3, voffA);
            PG8_WAIT_V(8); PG8_WAIT_L(0); PG8_BAR; PG8_MMA(1, 0, At, B0); PG8_MMA(1, 1, At, B1); PG8_BAR; PG8_SCHED;
            } else {
            PG8_LDB(B0, 0, 0); PG8_SCHED; PG8_LDA(At, 0, 0); PG8_STAGE(PG8_SA(1, 1), a1 + hstepA, voffA);
            PG8_WAIT_L(8); PG8_BAR; PG8_WAIT_L(0); PG8_MMA(0, 0, At, B0); PG8_BAR; PG8_SCHED;
            PG8_LDB(B1, 0, 1); PG8_STAGE(PG8_SB(0, 0), b2, voffB);
            PG8_BAR; PG8_WAIT_L(0); PG8_MMA(0, 1, At, B1); PG8_BAR;
            PG8_LDA(At, 0, 1); PG8_STAGE(PG8_SA(0, 0), a2, voffA);
            PG8_BAR; PG8_WAIT_L(0); PG8_MMA(1, 0, At, B0); PG8_BAR; PG8_SCHED;
            PG8_STAGE(PG8_SB(0, 1), b2 + hstepB, voffB);
            PG8_WAIT_V(6); PG8_BAR; PG8_MMA(1, 1, At, B1); PG8_BAR;
            PG8_LDB(B0, 1, 0); PG8_SCHED; PG8_LDA(At, 1, 0); PG8_STAGE(PG8_SA(0, 1), a2 + hstepA, voffA);
            PG8_WAIT_L(8); PG8_BAR; PG8_WAIT_L(0); PG8_MMA(0, 0, At, B0); PG8_BAR; PG8_SCHED;
            PG8_LDB(B1, 1, 1); PG8_STAGE(PG8_SB(1, 0), b3, voffB);
            PG8_BAR; PG8_WAIT_L(0); PG8_MMA(0, 1, At, B1); PG8_BAR;
            PG8_LDA(At, 1, 1); PG8_STAGE(PG8_SA(1, 0), a3, voffA);
            PG8_BAR; PG8_WAIT_L(0); PG8_MMA(1, 0, At, B0); PG8_BAR; PG8_SCHED;
            PG8_STAGE(PG8_SB(1, 1), b3 + hstepB, voffB);
            PG8_WAIT_V(6); PG8_BAR; PG8_MMA(1, 1, At, B1); PG8_BAR;
            }
        }
        if constexpr (ALIGN_EPI) { if (wr == 0) PG8_BAR; }
#if MK_SPIN_EPI
        const unsigned long long te0_ = __builtin_amdgcn_s_memrealtime();
#endif
        if constexpr (!Epi::AFTER_DRAIN) { E(acc, cur, wr, wc, fr, fq); S.done(cur); }
#if MK_SPIN_EPI
        if (Epi::PROBE_ID == MK_SPIN_EPI) { const unsigned long long te1_ = __builtin_amdgcn_s_memrealtime(); while (__builtin_amdgcn_s_memrealtime() - te1_ < (te1_ - te0_)) __builtin_amdgcn_s_sleep(2); }
#endif
        if (!has_next) break;
#pragma unroll
        for (int a = 0; a < 2; ++a)
#pragma unroll
            for (int b = 0; b < 2; ++b)
#pragma unroll
                for (int m = 0; m < 4; ++m)
#pragma unroll
                    for (int n = 0; n < 2; ++n) acc[a][b][m][n] = (f32x4){0.f, 0.f, 0.f, 0.f};
        cur = nxt; cA = nA; cB = nB; ++ui;
        if constexpr (ALIGN_EPI) { if (wr == 1) PG8_BAR; }
    }
    PG8_WAIT_V(0);
    if constexpr (!ALIGN_EPI) { if (wr == 0) PG8_BAR; }
    PG8_BAR;
    if constexpr (Epi::AFTER_DRAIN) { E.fused(acc, cur, wr, wc, fr, fq, lds, wid, lane); S.done(cur); }
#undef PG8_SA
#undef PG8_SB
#undef PG8_STAGE
#undef PG8_LDA
#undef PG8_LDB
#undef PG8_MMA
#undef PG8_WAIT_V
#undef PG8_WAIT_L
#undef PG8_BAR
#undef PG8_SCHED
}
}
#ifndef MK_MULTI
#define MK_MULTI 0
#endif
#ifndef MK_SPIN
#define MK_SPIN -1
#endif
#ifndef MK_CGSYNC
#define MK_CGSYNC 0
#endif
#ifndef MK_REPMASK
#define MK_REPMASK 0
#endif

constexpr int NWAVES = 8, NTHREADS = 512;
constexpr int BATCH = 8, SEQ = 2048, DM = 1024, M = BATCH * SEQ, PROJ_W = 3072, DFF = 2816, UPW = 5632, NCHUNK = 16;
constexpr float EPS = 1e-6f;
constexpr size_t MiB = 1u << 20;
constexpr size_t WS_SSQ1 = 0, WS_SSQ2 = 65536, WS_SSQ0 = 262144, WS_BAR = 131072, WS_BAR_BYTES = 32768, WS_PCNT = 131072 + 16384, WS_ROPE = 1 * MiB, WS_SGUW = 2 * MiB, WS_WIN = 3 * MiB, WS_WOUT = 9 * MiB, WS_WUP = 11 * MiB, WS_WDOWN = 22 * MiB,
                 WS_EDGE = 28 * MiB, WS_XN = 40 * MiB, WS_PROJ = 72 * MiB, WS_MIX = 168 * MiB, WS_KV = 200 * MiB, WS_ACT = 72 * MiB, WS_END = 216 * MiB;
constexpr int LDS_BYTES = 147456, MISC_OFF = 147456 - 64;
constexpr int LP = 272;
constexpr int TILE_LDS = 128 * LP;

#define LAS __attribute__((address_space(3)))
typedef unsigned short bf16;
typedef unsigned v4u __attribute__((ext_vector_type(4)));
typedef unsigned v2u __attribute__((ext_vector_type(2)));
typedef float f32x4 __attribute__((ext_vector_type(4)));
typedef short bf16x8 __attribute__((ext_vector_type(8)));
__device__ __forceinline__ unsigned f2bf(float f) { unsigned u = __builtin_bit_cast(unsigned, f); return (u + 0x7fffu + ((u >> 16) & 1u)) >> 16; }
__device__ __forceinline__ unsigned pk2(float lo, float hi) { return f2bf(lo) | (f2bf(hi) << 16); }
__device__ __forceinline__ float bflo(unsigned w) { return __uint_as_float(w << 16); }
__device__ __forceinline__ float bfhi(unsigned w) { return __uint_as_float(w & 0xffff0000u); }
__device__ __forceinline__ float wave_sum(float v) {
#pragma unroll
    for (int o = 1; o < 64; o <<= 1) v += __shfl_xor(v, o);
    return v;
}

struct Frame {
    LAS unsigned char* lds; unsigned char* ws;
    int tid, lane, wave, G, bid;
    const float* in[15]; float* out;
};

__device__ __forceinline__ int dest_row(int map, int n) {
    if (map == 1) { if (n >= 1024) return n; const int d = n & 127; return (n & ~127) + 32 * ((d >> 4) & 3) + 8 * ((d >> 2) & 3) + 4 * (d >> 6) + (d & 3); }
    if (map == 2) { return n < DFF ? 256 * (n >> 7) + (n & 127) : 256 * ((n - DFF) >> 7) + 128 + ((n - DFF) & 127); }
    return n;
}
struct WItem { const float* W; bf16* WT; const float* kg; int K, N, map, item; };
__device__ __forceinline__ WItem witem_in(Frame& F, int it) { WItem w; w.W = F.in[2]; w.WT = (bf16*)(F.ws + WS_WIN); w.kg = F.in[1]; w.K = DM; w.N = PROJ_W; w.map = 1; w.item = it; return w; }
constexpr int I_IN = (DM / 64) * (PROJ_W / 32), I_OUT = (DM / 64) * (DM / 32), I_UP = (DM / 64) * (UPW / 32), I_DN = (DFF / 64) * (DM / 32), I_TAIL = I_OUT + I_UP;
__device__ __forceinline__ WItem witem_tail(Frame& F, int it) {
    WItem w; w.kg = nullptr; int r = it;
    if (r < I_OUT) { w.W = F.in[8]; w.WT = (bf16*)(F.ws + WS_WOUT); w.K = DM; w.N = DM; w.map = 0; w.item = r; return w; } r -= I_OUT;
    w.W = F.in[10]; w.WT = (bf16*)(F.ws + WS_WUP); w.K = DM; w.N = UPW; w.map = 2; w.item = r; return w;
}
__device__ __forceinline__ WItem witem_down(Frame& F, int it) { WItem w; w.kg = nullptr; w.W = F.in[13]; w.WT = (bf16*)(F.ws + WS_WDOWN); w.K = DFF; w.N = DM; w.map = 0; w.item = it; return w; }
__device__ __forceinline__ void witem_load(const WItem& w, f32x4 (&v)[8], int lane) {
    const int nblk = w.N / 32, kb = w.item / nblk, nb = w.item % nblk;
    const float* p = w.W + (size_t)(64 * kb + (lane >> 3)) * w.N + 32 * nb + 4 * (lane & 7);
#pragma unroll
    for (int i = 0; i < 8; ++i) v[i] = __builtin_nontemporal_load((const f32x4*)(p + (size_t)(8 * i) * w.N));
}
__device__ __forceinline__ void witem_finish(const WItem& w, const f32x4 (&v)[8], LAS float* scr, int lane) {
    const int nblk = w.N / 32, kb = w.item / nblk, nb = w.item % nblk, k0 = 64 * kb, n0 = 32 * nb;
#pragma unroll
    for (int i = 0; i < 8; ++i) { LAS float* d = scr + (8 * i + (lane >> 3)) * 33 + 4 * (lane & 7); d[0] = v[i].x; d[1] = v[i].y; d[2] = v[i].z; d[3] = v[i].w; }
    asm volatile("s_waitcnt lgkmcnt(0)" ::: "memory");
    const int c = lane & 7;
    f32x4 g0 = (f32x4){1.f, 1.f, 1.f, 1.f}, g1 = g0;
    if (w.kg) { g0 = *(const f32x4*)(w.kg + k0 + 8 * c); g1 = *(const f32x4*)(w.kg + k0 + 8 * c + 4); }
#pragma unroll
    for (int j = 0; j < 4; ++j) { const int n = (lane >> 3) + 8 * j; const LAS float* s = scr + (8 * c) * 33 + n;
        v4u o; o.x = pk2(s[0 * 33] * g0[0], s[1 * 33] * g0[1]); o.y = pk2(s[2 * 33] * g0[2], s[3 * 33] * g0[3]); o.z = pk2(s[4 * 33] * g1[0], s[5 * 33] * g1[1]); o.w = pk2(s[6 * 33] * g1[2], s[7 * 33] * g1[3]);
        *(v4u*)(w.WT + (size_t)dest_row(w.map, n0 + n) * w.K + k0 + 8 * c) = o; }
    asm volatile("s_waitcnt lgkmcnt(0)" ::: "memory");
}

__device__ __forceinline__ void p0_prologue(Frame& F) {
    LAS float* scr = (LAS float*)(F.lds + F.wave * 16384);
    const int gw = F.bid * NWAVES + F.wave, NGW = F.G * NWAVES;
    const int gt = F.bid * NTHREADS + F.tid, NGT = F.G * NTHREADS;
    for (int it = gw; it < I_IN; it += NGW) { const WItem w = witem_in(F, it); f32x4 v[8]; witem_load(w, v, F.lane); witem_finish(w, v, scr, F.lane); }
    { float* rope = (float*)(F.ws + WS_ROPE);
      for (int i = gt; i < SEQ * 64; i += NGT) { const int pos = i >> 6, f = i & 63;
          const float inv = exp2f(-(float)f * (13.287712379549449f / 64.0f));
          const float ang = (float)pos * inv;
          double t = (double)ang * 0.15915494309189535; t -= rint(t); const float rv = (float)t;
          rope[pos * 128 + f] = __builtin_amdgcn_cosf(rv); rope[pos * 128 + 64 + f] = __builtin_amdgcn_sinf(rv); } }
    { float* z = (float*)(F.ws + WS_SSQ1); for (int i = gt; i < 2 * M; i += NGT) z[i] = 0.f; }
    { bf16* XB = (bf16*)(F.ws + WS_XN); float* ssq0 = (float*)(F.ws + WS_SSQ0);
      for (int m0 = gw * 4; m0 < M; m0 += NGW * 4) {
          f32x4 v[4][4]; float s[4];
#pragma unroll
          for (int r = 0; r < 4; ++r) { const f32x4* xr = (const f32x4*)(F.in[0] + (size_t)(m0 + r) * DM) + F.lane;
#pragma unroll
              for (int j = 0; j < 4; ++j) v[r][j] = __builtin_nontemporal_load(xr + 64 * j); }
#pragma unroll
          for (int r = 0; r < 4; ++r) { s[r] = 0.f; v2u* o8 = (v2u*)(XB + (size_t)(m0 + r) * DM) + F.lane;
#pragma unroll
              for (int j = 0; j < 4; ++j) { const f32x4 y = v[r][j]; s[r] += (y.x * y.x + y.y * y.y) + (y.z * y.z + y.w * y.w); v2u w; w.x = pk2(y.x, y.y); w.y = pk2(y.z, y.w); o8[64 * j] = w; } }
#pragma unroll
          for (int o = 1; o < 64; o <<= 1) {
#pragma unroll
              for (int r = 0; r < 4; ++r) s[r] += __shfl_xor(s[r], o); }
          if (F.lane < 4) ssq0[m0 + F.lane] = F.lane == 0 ? s[0] : F.lane == 1 ? s[1] : F.lane == 2 ? s[2] : s[3]; } }
}

__device__ __forceinline__ void p1_tail(Frame& F) {
    LAS float* scr = (LAS float*)(F.lds + F.wave * 16384);
    const int gw = F.bid * NWAVES + F.wave, NGW = F.G * NWAVES;
    const int gt = F.bid * NTHREADS + F.tid, NGT = F.G * NTHREADS;
    int it = gw; f32x4 v[8];
    if (it < I_TAIL) { const WItem w = witem_tail(F, it); witem_load(w, v, F.lane); }
    while (it < I_TAIL) {
        const int nx = it + NGW; f32x4 vn[8];
#pragma unroll
        for (int i = 0; i < 8; ++i) vn[i] = v[i];
        if (nx < I_TAIL) { const WItem wn = witem_tail(F, nx); witem_load(wn, vn, F.lane); }
        { const WItem w = witem_tail(F, it); witem_finish(w, v, scr, F.lane); }
#pragma unroll
        for (int i = 0; i < 8; ++i) v[i] = vn[i];
        it = nx;
    }
    { const float* w = F.in[6]; bf16* o = (bf16*)(F.ws + WS_SGUW);
      for (int i = gt; i < 4 * 128 * 128; i += NGT) { const int t = (i >> 7) & 127, s = i & 127; o[i] = (bf16)f2bf(s <= t ? w[i] : 0.f); } }
}

typedef short s16x4 __attribute__((ext_vector_type(4)));
struct TileRegs { v4u v[4]; };
__device__ __forceinline__ void tile_fetch(TileRegs& t, const bf16* src, int ld, int tid) {
#pragma unroll
    for (int i = 0; i < 4; ++i) { const int c = tid + NTHREADS * i, row = c >> 4, ch = c & 15; t.v[i] = *(const v4u*)(src + (size_t)row * ld + ch * 8); }
}
template <bool SCALE> __device__ __forceinline__ void tile_stage(LAS unsigned char* dst, TileRegs& t, int tid, float lg) {
#pragma unroll
    for (int i = 0; i < 4; ++i) { const int c = tid + NTHREADS * i, row = c >> 4, ch = c & 15;
        if (SCALE) { const float sc = exp2f(lg * (float)(127 - row));
#pragma unroll
            for (int j = 0; j < 4; ++j) t.v[i][j] = pk2(bflo(t.v[i][j]) * sc, bfhi(t.v[i][j]) * sc); }
        *(LAS v4u*)(dst + row * LP + ch * 16) = t.v[i]; }
}
__device__ __forceinline__ bf16x8 frag_row(const LAS unsigned char* T, int r0, int ks, int fr, int fq) { return *(const LAS bf16x8*)(T + (r0 + fr) * LP + (32 * ks + 8 * fq) * 2); }
__device__ __forceinline__ bf16x8 frag_tr(const LAS unsigned char* T, int c0, int ks, int fr, int fq) {
    const LAS unsigned char* a = T + (32 * ks + 8 * fq + (fr >> 2)) * LP + c0 * 2 + 8 * (fr & 3);
    const s16x4 lo = __builtin_bit_cast(s16x4, __builtin_amdgcn_ds_read_tr16_b64_v4i16((LAS s16x4*)a));
    const s16x4 hi = __builtin_bit_cast(s16x4, __builtin_amdgcn_ds_read_tr16_b64_v4i16((LAS s16x4*)(a + 4 * LP)));
    return __builtin_shufflevector(lo, hi, 0, 1, 2, 3, 4, 5, 6, 7);
}
template <bool XTR, bool YTR> __device__ __forceinline__ void mm16(f32x4 (&acc)[8], const LAS unsigned char* X, const LAS unsigned char* Y, int w, int fr, int fq) {
#pragma unroll
    for (int ks = 0; ks < 4; ++ks) {
        const bf16x8 a = XTR ? frag_tr(X, 16 * w, ks, fr, fq) : frag_row(X, 16 * w, ks, fr, fq);
#pragma unroll
        for (int jh = 0; jh < 8; jh += 4) {
            bf16x8 bfr[4];
#pragma unroll
            for (int j = 0; j < 4; ++j) bfr[j] = YTR ? frag_tr(Y, 16 * (jh + j), ks, fr, fq) : frag_row(Y, 16 * (jh + j), ks, fr, fq);
#pragma unroll
            for (int j = 0; j < 4; ++j) acc[jh + j] = __builtin_amdgcn_mfma_f32_16x16x32_bf16(bfr[j], a, acc[jh + j], 0, 0, 0);
            __builtin_amdgcn_sched_barrier(0);
        }
    }
}
__device__ __forceinline__ float head_log2g(int h) { return log2f(1.0f - exp2f(-5.0f - (float)h)); }

struct KvRegs { TileRegs k, v; };
__device__ __forceinline__ void kv_fetch(Frame& F, KvRegs& r, int it) {
    const int bh = it >> 4, n = it & 15; const size_t tok0 = (size_t)(bh >> 2) * SEQ + 128 * n; const bf16* PROJ = (const bf16*)(F.ws + WS_PROJ);
    tile_fetch(r.k, PROJ + tok0 * PROJ_W + 512 + 128 * (bh & 3), PROJ_W, F.tid); tile_fetch(r.v, PROJ + tok0 * PROJ_W + 1024 + 128 * (bh & 3), PROJ_W, F.tid);
}
__device__ __forceinline__ void kv_stage(Frame& F, KvRegs& r, int it) {
    tile_stage<true>(F.lds, r.k, F.tid, head_log2g((it >> 4) & 3)); tile_stage<false>(F.lds + TILE_LDS, r.v, F.tid, 0.f);
}
__device__ __forceinline__ void kv_compute(Frame& F, int it, f32x4 (&acc)[8], bool first) {
    const int bh = it >> 4, n = it & 15; const int w = F.wave, fr = F.lane & 15, fq = F.lane >> 4;
    const float cd = first ? 0.f : exp2f(head_log2g(bh & 3) * 128.0f);
#pragma unroll
    for (int j = 0; j < 8; ++j) acc[j] = acc[j] * cd;
    mm16<true, true>(acc, F.lds + TILE_LDS, F.lds, w, fr, fq);
    bf16* o = (bf16*)(F.ws + WS_KV) + ((size_t)(bh * NCHUNK + n) * 128 + 16 * w + fr) * 128 + 4 * fq;
#pragma unroll
    for (int j = 0; j < 8; ++j) { v2u wv; wv.x = pk2(acc[j][0], acc[j][1]); wv.y = pk2(acc[j][2], acc[j][3]); *(v2u*)(o + 16 * j) = wv; }
}

struct SguRegs { TileRegs wt; v4u sv[4]; v2u up[8]; float bs; };
__device__ __forceinline__ void sgu_fetch(Frame& F, SguRegs& r, int it) {
    const int b = it >> 6, n = (it >> 2) & 15, g = it & 3; const size_t tok0 = (size_t)b * SEQ + 128 * n; const bf16* PROJ = (const bf16*)(F.ws + WS_PROJ);
    tile_fetch(r.wt, (const bf16*)(F.ws + WS_SGUW) + g * 16384, 128, F.tid);
    { const int t = F.tid >> 2, qd = F.tid & 3; const v4u* p = (const v4u*)(PROJ + (tok0 + t) * PROJ_W + 2560 + 128 * g + 32 * qd);
#pragma unroll
      for (int c = 0; c < 4; ++c) r.sv[c] = p[c]; }
    { const int t = 16 * F.wave + (F.lane & 15); const bf16* up = PROJ + (tok0 + t) * PROJ_W + 2048 + 128 * g + 4 * (F.lane >> 4);
#pragma unroll
      for (int j = 0; j < 8; ++j) r.up[j] = *(const v2u*)(up + 16 * j);
      r.bs = F.in[7][128 * g + t]; }
}
__device__ __forceinline__ void sgu_stage(Frame& F, SguRegs& r, int it) {
    const int g = it & 3; LAS unsigned char* vn = F.lds + TILE_LDS;
    tile_stage<false>(F.lds, r.wt, F.tid, 0.f);
    const int t = F.tid >> 2, qd = F.tid & 3;
    float v[32];
#pragma unroll
    for (int c = 0; c < 4; ++c)
#pragma unroll
        for (int j = 0; j < 4; ++j) { v[8 * c + 2 * j] = bflo(r.sv[c][j]); v[8 * c + 2 * j + 1] = bfhi(r.sv[c][j]); }
    float s = 0.f;
#pragma unroll
    for (int i = 0; i < 32; ++i) s += v[i];
    s += __shfl_xor(s, 1); s += __shfl_xor(s, 2);
    const float mu = s * (1.0f / 128.0f); float q = 0.f;
#pragma unroll
    for (int i = 0; i < 32; ++i) { v[i] -= mu; q += v[i] * v[i]; }
    q += __shfl_xor(q, 1); q += __shfl_xor(q, 2);
    const float rstd = 1.0f / sqrtf(q * (1.0f / 128.0f) + EPS);
    const f32x4* lng = (const f32x4*)(F.in[4] + 128 * g + 32 * qd); const f32x4* lnb = (const f32x4*)(F.in[5] + 128 * g + 32 * qd);
#pragma unroll
    for (int c = 0; c < 4; ++c) { const f32x4 g0 = lng[2 * c], g1 = lng[2 * c + 1], b0 = lnb[2 * c], b1 = lnb[2 * c + 1]; v4u o;
        o.x = pk2(v[8 * c + 0] * rstd * g0[0] + b0[0], v[8 * c + 1] * rstd * g0[1] + b0[1]); o.y = pk2(v[8 * c + 2] * rstd * g0[2] + b0[2], v[8 * c + 3] * rstd * g0[3] + b0[3]);
        o.z = pk2(v[8 * c + 4] * rstd * g1[0] + b1[0], v[8 * c + 5] * rstd * g1[1] + b1[1]); o.w = pk2(v[8 * c + 6] * rstd * g1[2] + b1[2], v[8 * c + 7] * rstd * g1[3] + b1[3]);
        *(LAS v4u*)(vn + t * LP + qd * 64 + c * 16) = o; }
}
__device__ __forceinline__ void sgu_compute(Frame& F, const v2u (&upv)[8], float bs, int it) {
    const int b = it >> 6, n = (it >> 2) & 15, g = it & 3; const size_t tok0 = (size_t)b * SEQ + 128 * n;
    const int w = F.wave, fr = F.lane & 15, fq = F.lane >> 4;
    f32x4 acc[8];
#pragma unroll
    for (int j = 0; j < 8; ++j) acc[j] = (f32x4){0.f, 0.f, 0.f, 0.f};
    mm16<false, true>(acc, F.lds, F.lds + TILE_LDS, w, fr, fq);
    const int t = 16 * w + fr;
    bf16* o = (bf16*)(F.ws + WS_MIX) + (tok0 + t) * DM + 512 + 128 * g + 4 * fq;
#pragma unroll
    for (int j = 0; j < 8; ++j) { const v2u uu = upv[j];
        v2u wv; wv.x = pk2(bflo(uu.x) * (acc[j][0] + bs), bfhi(uu.x) * (acc[j][1] + bs)); wv.y = pk2(bflo(uu.y) * (acc[j][2] + bs), bfhi(uu.y) * (acc[j][3] + bs));
        *(v2u*)(o + 16 * j) = wv; }
}
__device__ __forceinline__ void p2_phase(Frame& F) {
    const int k0 = 2 * F.bid, k1 = 2 * F.bid + 1, s0 = F.bid, s1 = F.bid + 256;
    KvRegs kr; SguRegs sr; f32x4 kacc[8];
#pragma unroll
    for (int j = 0; j < 8; ++j) kacc[j] = (f32x4){0.f, 0.f, 0.f, 0.f};
    kv_fetch(F, kr, k0);
    __syncthreads(); kv_stage(F, kr, k0); kv_fetch(F, kr, k1); __syncthreads(); kv_compute(F, k0, kacc, true);
    __syncthreads(); kv_stage(F, kr, k1); sgu_fetch(F, sr, s0); __syncthreads(); kv_compute(F, k1, kacc, false);
    v2u upv[8]; float bs;
    __syncthreads(); sgu_stage(F, sr, s0);
#pragma unroll
    for (int j = 0; j < 8; ++j) upv[j] = sr.up[j];
    bs = sr.bs; sgu_fetch(F, sr, s1); __syncthreads(); sgu_compute(F, upv, bs, s0);
    __syncthreads(); sgu_stage(F, sr, s1); __syncthreads(); sgu_compute(F, sr.up, sr.bs, s1);
}

template <int NB> __device__ __forceinline__ void kv_horner(float (&s)[4][8], const bf16* kv, int slot0, int cnt, float f) {
#pragma unroll 1
    for (int jc = 0; jc < cnt; jc += NB) {
        const bf16* kp = kv + (size_t)(slot0 + 2 * jc) * 16384;
        v4u x[NB][4];
#pragma unroll
        for (int u = 0; u < NB; ++u) if (jc + u < cnt) {
#pragma unroll
            for (int i = 0; i < 4; ++i) x[u][i] = *(const v4u*)(kp + (size_t)u * 32768 + (size_t)(NTHREADS * i) * 8); }
#pragma unroll
        for (int u = 0; u < NB; ++u) if (jc + u < cnt) {
#pragma unroll
            for (int i = 0; i < 4; ++i)
#pragma unroll
                for (int j = 0; j < 4; ++j) { s[i][2 * j] = s[i][2 * j] * f + bflo(x[u][i][j]); s[i][2 * j + 1] = s[i][2 * j + 1] * f + bfhi(x[u][i][j]); } }
    }
}
__device__ __forceinline__ void kv_step1(float (&s)[4][8], const bf16* kv, int slot, bool take, float f) {
    v4u x[4];
#pragma unroll
    for (int i = 0; i < 4; ++i) x[i] = (v4u){0u, 0u, 0u, 0u};
    if (take) {
#pragma unroll
        for (int i = 0; i < 4; ++i) x[i] = *(const v4u*)(kv + (size_t)slot * 16384 + (size_t)(NTHREADS * i) * 8); }
#pragma unroll
    for (int i = 0; i < 4; ++i)
#pragma unroll
        for (int j = 0; j < 4; ++j) { s[i][2 * j] = s[i][2 * j] * f + bflo(x[i][j]); s[i][2 * j + 1] = s[i][2 * j + 1] * f + bfhi(x[i][j]); }
}
__device__ __forceinline__ void ret_pair(Frame& F, int bh, int n_small) {
    const int b = bh >> 2, h = bh & 3;
    const bf16* PROJ = (const bf16*)(F.ws + WS_PROJ);
    LAS unsigned char* Qs = F.lds; LAS unsigned char* Ks = F.lds + TILE_LDS; LAS unsigned char* Vs = F.lds + 2 * TILE_LDS; LAS unsigned char* St = F.lds + 3 * TILE_LDS;
    const float lg = head_log2g(h); const float cd = exp2f(lg * 128.0f);
    const int w = F.wave, fr = F.lane & 15, fq = F.lane >> 4; const int q = 16 * w + fr;
    const int n_big = 15 - n_small;
    v4u sb[4]; TileRegs tq, tk, tv;
    { const size_t tok0 = (size_t)b * SEQ + 128 * n_small;
      tile_fetch(tq, PROJ + tok0 * PROJ_W + 128 * h, PROJ_W, F.tid); tile_fetch(tk, PROJ + tok0 * PROJ_W + 512 + 128 * h, PROJ_W, F.tid); tile_fetch(tv, PROJ + tok0 * PROJ_W + 1024 + 128 * h, PROJ_W, F.tid); }
    __syncthreads();
    { const bf16* kv = (const bf16*)(F.ws + WS_KV) + (size_t)bh * NCHUNK * 16384 + (size_t)F.tid * 8;
      float s[4][8];
#pragma unroll
      for (int i = 0; i < 4; ++i)
#pragma unroll
          for (int j = 0; j < 8; ++j) s[i][j] = 0.f;
      const int a = n_small >> 1; const bool odd = (n_small & 1) != 0; const float cd2 = cd * cd;
      kv_horner<4>(s, kv, 1, a, cd2);
      { v4u x[4];
#pragma unroll
        for (int i = 0; i < 4; ++i) x[i] = (v4u){0u, 0u, 0u, 0u};
        if (odd) {
#pragma unroll
            for (int i = 0; i < 4; ++i) x[i] = *(const v4u*)(kv + (size_t)(2 * a) * 16384 + (size_t)(NTHREADS * i) * 8); }
        const float f1 = odd ? cd : 1.0f;
        if (n_small > 0) {
#pragma unroll
            for (int i = 0; i < 4; ++i) { const int c = F.tid + NTHREADS * i, e = c >> 4, ch = c & 15; v4u o;
#pragma unroll
                for (int j = 0; j < 4; ++j) o[j] = pk2(s[i][2 * j] * f1 + bflo(x[i][j]), s[i][2 * j + 1] * f1 + bfhi(x[i][j]));
                *(LAS v4u*)(St + e * LP + ch * 16) = o; } } }
      kv_horner<4>(s, kv, 2 * a + 1, 7 - 2 * a, cd2);
      kv_step1(s, kv, 14 - 2 * a, !odd, odd ? 1.0f : cd);
#pragma unroll
      for (int i = 0; i < 4; ++i) { sb[i].x = pk2(s[i][0], s[i][1]); sb[i].y = pk2(s[i][2], s[i][3]); sb[i].z = pk2(s[i][4], s[i][5]); sb[i].w = pk2(s[i][6], s[i][7]); }
    }
#pragma unroll 1
    for (int pass = 0; pass < 2; ++pass) {
        const int n = pass == 0 ? n_small : n_big; const size_t tok0 = (size_t)b * SEQ + 128 * n;
        int opq = 0; asm volatile("" : "+v"(opq));
        if (pass == 1) { __syncthreads();
#pragma unroll
            for (int i = 0; i < 4; ++i) { const int c = F.tid + NTHREADS * i, e = c >> 4, ch = c & 15; *(LAS v4u*)(St + e * LP + ch * 16) = sb[i]; } }
        if (pass == 1) { tile_fetch(tq, PROJ + tok0 * PROJ_W + 128 * h, PROJ_W, F.tid); tile_fetch(tk, PROJ + tok0 * PROJ_W + 512 + 128 * h, PROJ_W, F.tid); tile_fetch(tv, PROJ + tok0 * PROJ_W + 1024 + 128 * h, PROJ_W, F.tid); }
        tile_stage<false>(Qs, tq, F.tid, 0.f); tile_stage<false>(Ks, tk, F.tid, 0.f); tile_stage<false>(Vs, tv, F.tid, 0.f);
        v2u gg[8]; const bf16* gp = PROJ + (tok0 + q) * PROJ_W + 1536 + 128 * h + 4 * fq;
#pragma unroll
        for (int j = 0; j < 8; ++j) gg[j] = *(const v2u*)(gp + 16 * j);
        __syncthreads();
        f32x4 sc[8], oc[8];
#pragma unroll
        for (int j = 0; j < 8; ++j) { sc[j] = (f32x4){0.f, 0.f, 0.f, 0.f}; oc[j] = (f32x4){0.f, 0.f, 0.f, 0.f}; }
        mm16<false, false>(sc, Qs, Ks, w, fr, fq);
        if (n > 0) { mm16<false, false>(oc, Qs, St, w, fr, fq); const float qd = exp2f(lg * (float)(q + 1 + opq));
#pragma unroll
            for (int j = 0; j < 8; ++j) oc[j] = oc[j] * qd; }
#pragma unroll
        for (int j = 0; j < 8; ++j) { float pv[4];
#pragma unroll
            for (int i = 0; i < 4; ++i) { const int k = 16 * j + 4 * fq + i; pv[i] = (q >= k) ? sc[j][i] * exp2f(lg * (float)(q - k + opq)) : 0.f; }
            v2u wv; wv.x = pk2(pv[0], pv[1]); wv.y = pk2(pv[2], pv[3]); *(LAS v2u*)(Qs + q * LP + (16 * j + 4 * fq) * 2) = wv; }
        asm volatile("s_waitcnt lgkmcnt(0)" ::: "memory");
        mm16<false, true>(oc, Qs, Vs, w, fr, fq);
        float ss = 0.f;
#pragma unroll
        for (int j = 0; j < 8; ++j) ss += (oc[j][0] * oc[j][0] + oc[j][1] * oc[j][1]) + (oc[j][2] * oc[j][2] + oc[j][3] * oc[j][3]);
        ss += __shfl_xor(ss, 16); ss += __shfl_xor(ss, 32);
        const float rstd = 1.0f / sqrtf(ss * (1.0f / 128.0f) + EPS);
        const float* rg = F.in[3] + 128 * h + 4 * fq + opq;
        bf16* o = (bf16*)(F.ws + WS_MIX) + (tok0 + q) * DM + 128 * h + 4 * fq;
#pragma unroll
        for (int j = 0; j < 8; ++j) { const f32x4 rgv = *(const f32x4*)(rg + 16 * j);
            v2u wv; wv.x = pk2(oc[j][0] * rstd * rgv[0] * bflo(gg[j].x), oc[j][1] * rstd * rgv[1] * bfhi(gg[j].x));
            wv.y = pk2(oc[j][2] * rstd * rgv[2] * bflo(gg[j].y), oc[j][3] * rstd * rgv[3] * bfhi(gg[j].y));
            *(v2u*)(o + 16 * j) = wv; }
    }
}

#define XB_TMO      128
#define XB_XCNT(j)  (256  + 64 * (j))
#define XB_XSUB(j)  (1280 + 64 * (j))
#define XB_XGEN(j)  (2304 + 64 * (j))
#define XB_TOP      3328
#define XB_TOPGEN   3392
#define XCD_BAR_WORDS 3456
#define XB_SPIN_CAP (1u << 18)
__device__ __forceinline__ unsigned xb_ld(unsigned* p)              { return __hip_atomic_load(p, __ATOMIC_RELAXED, __HIP_MEMORY_SCOPE_AGENT); }
__device__ __forceinline__ unsigned xb_add(unsigned* p, unsigned v) { return __hip_atomic_fetch_add(p, v, __ATOMIC_RELAXED, __HIP_MEMORY_SCOPE_AGENT); }
__device__ __forceinline__ unsigned xb_xcc_id() { return (unsigned)__builtin_amdgcn_s_getreg((3 << 11) | 20) & 0xFu; }
#define XB_SPIN(cond, bar) do { unsigned _sp = 0; while (cond) { __builtin_amdgcn_s_sleep(1); \
    if ((++_sp & 255u) == 0u) { if (xb_ld(&(bar)[XB_TMO])) break; if (_sp > XB_SPIN_CAP) { atomicAdd(&(bar)[XB_TMO], 1u); break; } } } } while (0)
struct XcdBarrier { unsigned* bar; unsigned x; volatile LAS unsigned* st; };
__device__ __forceinline__ XcdBarrier xcd_barrier_post(unsigned* bar, volatile LAS unsigned* st) {
    XcdBarrier b; b.bar = bar; b.x = xb_xcc_id(); b.st = st;
    if (threadIdx.x == 0) (void)xb_add(&bar[XB_XCNT(b.x)], 1u);
    return b;
}
__device__ __forceinline__ void xcd_barrier_complete(unsigned* bar, unsigned x, unsigned& nloc, unsigned& nx) {
    const unsigned G = gridDim.x * gridDim.y * gridDim.z;
    unsigned sum, cnt, mine, sp = 0u;
    for (;;) {
        sum = 0u; cnt = 0u; mine = 0u;
#pragma unroll
        for (unsigned j = 0; j < 16; ++j) { const unsigned c = xb_ld(&bar[XB_XCNT(j)]); sum += c; cnt += (c > 0u) ? 1u : 0u; mine = (j == x) ? c : mine; }
        if (sum == G) break;
        __builtin_amdgcn_s_sleep(1);
        if ((++sp & 255u) == 0u) { if (xb_ld(&bar[XB_TMO])) break; if (sp > XB_SPIN_CAP) { atomicAdd(&bar[XB_TMO], 1u); break; } }
    }
    nloc = mine > 0u ? mine : 1u; nx = cnt > 0u ? cnt : 1u;
}
__device__ __forceinline__ void xcd_barrier(const XcdBarrier& b) {
    asm volatile("s_waitcnt vmcnt(0)" ::: "memory");
    __syncthreads();
    if (threadIdx.x == 0) {
        unsigned* bar = b.bar;
        __builtin_amdgcn_s_waitcnt(0);
        unsigned nloc = b.st[0], nx = b.st[1];
        if (nloc == 0u) { xcd_barrier_complete(bar, b.x, nloc, nx); b.st[0] = nloc; b.st[1] = nx; }
        const unsigned old = xb_add(&bar[XB_XSUB(b.x)], 1u);
        const unsigned gen = old / nloc;
        if (old + 1u == (gen + 1u) * nloc) {
            __builtin_amdgcn_fence(__ATOMIC_RELEASE, "agent");
            asm volatile("s_waitcnt vmcnt(0)" ::: "memory");
            const unsigned og = xb_add(&bar[XB_TOP], 1u);
            const unsigned tg = og / nx;
            if (og + 1u == (tg + 1u) * nx) xb_add(&bar[XB_TOPGEN], 1u);
            else XB_SPIN(xb_ld(&bar[XB_TOPGEN]) == tg, bar);
            __builtin_amdgcn_fence(__ATOMIC_ACQUIRE, "agent");
            xb_add(&bar[XB_XGEN(b.x)], 1u);
            asm volatile("s_waitcnt vmcnt(0)" ::: "memory");
        } else {
            XB_SPIN(xb_ld(&bar[XB_XGEN(b.x)]) == gen, bar);
            __builtin_amdgcn_fence(__ATOMIC_ACQUIRE, "agent");
            asm volatile("s_waitcnt vmcnt(0)" ::: "memory");
        }
    }
    __syncthreads();
}

struct Args { const float* in[15]; float* out; unsigned char* ws; int ph_lo, ph_hi; };
constexpr int NPHASE = 7;
__global__ void __launch_bounds__(NTHREADS, 2) fwd_megakernel(Args args) {
    extern __shared__ __attribute__((aligned(16))) unsigned char lds[];
    Frame F;
    F.lds = (LAS unsigned char*)lds; F.ws = args.ws;
    F.tid = threadIdx.x; F.lane = F.tid & 63; F.wave = __builtin_amdgcn_readfirstlane(F.tid >> 6);
    F.G = gridDim.x; F.bid = blockIdx.x;
#pragma unroll
    for (int i = 0; i < 15; ++i) F.in[i] = args.in[i];
    F.out = args.out;
    const int lo = args.ph_lo, hi = args.ph_hi;
    volatile LAS unsigned* MISC = (volatile LAS unsigned*)(F.lds + MISC_OFF);
    if (F.tid < 16) MISC[F.tid] = 0u;
    __syncthreads();
    XcdBarrier bar; bar.bar = (unsigned*)(F.ws + WS_BAR); bar.x = 0; bar.st = nullptr;
    if (hi - lo > 1) bar = xcd_barrier_post((unsigned*)(F.ws + WS_BAR), MISC);
    if (lo < 0) cg::this_grid().sync();
#define IN(k) (lo <= (k) && (k) < hi)
#if MK_CGSYNC
#define SEAM(k) do { if (IN(k) && IN((k) + 1)) cg::this_grid().sync(); } while (0)
#else
#define SEAM(k) do { if (IN(k) && IN((k) + 1)) xcd_barrier(bar); } while (0)
#endif
#if MK_SPIN >= 0
    unsigned long long t0_ = 0;
#define PH_BEGIN(k) do { if ((k) == MK_SPIN) t0_ = __builtin_amdgcn_s_memrealtime(); } while (0)
#define PH_END(k) do { if ((k) == MK_SPIN) { asm volatile("s_waitcnt vmcnt(0)" ::: "memory"); const unsigned long long t1_ = __builtin_amdgcn_s_memrealtime(); while (__builtin_amdgcn_s_memrealtime() - t1_ < (t1_ - t0_)) __builtin_amdgcn_s_sleep(8); } } while (0)
#else
#define PH_BEGIN(k) do {} while (0)
#define PH_END(k) do {} while (0)
#endif

    PH_BEGIN(0);
    if (IN(0)) p0_prologue(F);
    PH_END(0);
    SEAM(0);
    PH_BEGIN(1);
    if (IN(1)) {
        pg8::Gemm g{(const bf16*)(F.ws + WS_XN), (const bf16*)(F.ws + WS_WIN), M, PROJ_W, DM}; pg8::StaticOrder S; S.init(M, PROJ_W, F.G, F.bid);
        pg8::EpiProj E{(bf16*)(F.ws + WS_PROJ), (const float*)(F.ws + WS_ROPE), (const float*)(F.ws + WS_SSQ0)};
        pg8::gemm_phase<pg8::EpiProj, pg8::StaticOrder, true, true>(F.lds, g, S, E);
        p1_tail(F);
    }
    PH_END(1);
    SEAM(1);
    PH_BEGIN(2);
    if (IN(2)) p2_phase(F);
    PH_END(2);
    SEAM(2);
    PH_BEGIN(3);
    if (IN(3)) {
        for (int it = F.bid; it < 256; it += F.G) ret_pair(F, it >> 3, it & 7);
        __syncthreads();
    }
    PH_END(3);
    SEAM(3);
    PH_BEGIN(4);
    if (IN(4)) {
        pg8::Gemm g{(const bf16*)(F.ws + WS_MIX), (const bf16*)(F.ws + WS_WOUT), M, DM, DM}; pg8::StaticOrder S; S.init(M, DM, F.G, F.bid);
        pg8::EpiRes<true> E{(const bf16*)(F.ws + WS_XN), F.out, (bf16*)(F.ws + WS_XN), F.in[9], (float*)(F.ws + WS_SSQ1)};
        pg8::gemm_phase<pg8::EpiRes<true>, pg8::StaticOrder, false, true>(F.lds, g, S, E);
    }
    PH_END(4);
    SEAM(4);
    PH_BEGIN(5);
    if (IN(5)) {
        pg8::Gemm g{(const bf16*)(F.ws + WS_XN), (const bf16*)(F.ws + WS_WUP), M, UPW, DM}; pg8::StaticOrder S; S.init(M, UPW, F.G, F.bid);
        pg8::EpiConv E{(const float*)(F.ws + WS_SSQ1), F.in[11], F.in[12], (bf16*)(F.ws + WS_ACT), (float*)(F.ws + WS_EDGE)};
        pg8::gemm_phase<pg8::EpiConv, pg8::StaticOrder, true, true>(F.lds, g, S, E);
        if (2 * F.bid >= F.G) { LAS float* scr = (LAS float*)(F.lds + F.wave * 16384); const int hw = (F.bid - F.G / 2) * NWAVES + F.wave, NHW = (F.G - F.G / 2) * NWAVES;
            for (int it = hw; it < I_DN; it += NHW) { const WItem w = witem_down(F, it); f32x4 v[8]; witem_load(w, v, F.lane); witem_finish(w, v, scr, F.lane); } }
    }
    PH_END(5);
    SEAM(5);
    PH_BEGIN(6);
    if (IN(6)) {
        pg8::Gemm g{(const bf16*)(F.ws + WS_ACT), (const bf16*)(F.ws + WS_WDOWN), M, DM, DFF}; pg8::StaticOrder S; S.init(M, DM, F.G, F.bid);
        pg8::Unit u0;
        if (S.next(0, u0)) {
            const float* edge = (const float*)(F.ws + WS_EDGE); const float* cw = F.in[11]; const float* cb = F.in[12]; bf16* act = (bf16*)(F.ws + WS_ACT);
            for (int i = F.tid; i < 2 * (DFF / 4); i += NTHREADS) { const int rl = i >= (DFF / 4) ? 1 : 0; const int run = 2 * u0.pm + rl, c = 4 * (i - rl * (DFF / 4));
                const float* e = edge + (size_t)run * 4 * UPW; const bool first = (run & 15) == 0;
                f32x4 y0[2], y1[2];
#pragma unroll
                for (int hb = 0; hb < 2; ++hb) { const int cc = c + hb * DFF; const f32x4 z = (f32x4){0.f, 0.f, 0.f, 0.f};
                    const f32x4 f0 = *(const f32x4*)(e + cc), f1 = *(const f32x4*)(e + UPW + cc);
                    const f32x4 p2 = first ? z : *(const f32x4*)(e + cc - 2 * UPW), p1 = first ? z : *(const f32x4*)(e + cc - UPW);
                    const f32x4 w0 = *(const f32x4*)(cw + cc), w1 = *(const f32x4*)(cw + UPW + cc), w2 = *(const f32x4*)(cw + 2 * UPW + cc), bb = *(const f32x4*)(cb + cc);
                    y0[hb] = w2 * f0 + w1 * p1 + w0 * p2 + bb; y1[hb] = w2 * f1 + w1 * f0 + w0 * p1 + bb; }
                *(v2u*)(act + (size_t)(128 * run) * DFF + c) = (v2u){pk2(pg8::silu_f(y0[0][0]) * y0[1][0], pg8::silu_f(y0[0][1]) * y0[1][1]), pk2(pg8::silu_f(y0[0][2]) * y0[1][2], pg8::silu_f(y0[0][3]) * y0[1][3])};
                *(v2u*)(act + (size_t)(128 * run + 1) * DFF + c) = (v2u){pk2(pg8::silu_f(y1[0][0]) * y1[1][0], pg8::silu_f(y1[0][1]) * y1[1][1]), pk2(pg8::silu_f(y1[0][2]) * y1[1][2], pg8::silu_f(y1[0][3]) * y1[1][3])}; }
            asm volatile("s_waitcnt vmcnt(0)" ::: "memory");
            __syncthreads();
        }
        pg8::EpiFinal E{(const bf16*)(F.ws + WS_XN), F.in[9], F.out, F.in[14], (float*)(F.ws + WS_SSQ2), (unsigned*)(F.ws + WS_PCNT)};
        pg8::gemm_phase<pg8::EpiFinal, pg8::StaticOrder, true, true>(F.lds, g, S, E);
    }
    PH_END(6);
#undef IN
#undef SEAM
}

extern "C" void kernel_launch(void* const* d_in, const int* in_sizes, int n_in, void* d_out, int out_size, void* d_ws, size_t ws_size, hipStream_t stream) {
    static int grid = 0;
    if (grid == 0) {
        if (n_in != 15 || out_size != M * DM || ws_size < WS_END) { fprintf(stderr, "kernel_launch: unexpected shapes (n_in %d out %d ws %zu)\n", n_in, out_size, ws_size); grid = -1; return; }
        if (hipFuncSetAttribute((const void*)fwd_megakernel, hipFuncAttributeMaxDynamicSharedMemorySize, LDS_BYTES) != hipSuccess) { fprintf(stderr, "kernel_launch: hipFuncSetAttribute failed\n"); grid = -1; return; }
        int dev = 0, cus = 0, per_cu = 0;
        (void)hipGetDevice(&dev); (void)hipDeviceGetAttribute(&cus, hipDeviceAttributeMultiprocessorCount, dev);
        (void)hipOccupancyMaxActiveBlocksPerMultiprocessor(&per_cu, (const void*)fwd_megakernel, NTHREADS, LDS_BYTES);
        (void)hipGetLastError();
        if (per_cu < 1) per_cu = 1;
        grid = cus > 0 ? cus : 256;
    }
    if (grid < 0) return;
    Args a{};
    for (int i = 0; i < 15; ++i) a.in[i] = (const float*)d_in[i];
    a.out = (float*)d_out; a.ws = (unsigned char*)d_ws;
    if (hipMemsetAsync((char*)d_ws + WS_BAR, 0, WS_BAR_BYTES, stream) != hipSuccess) { fprintf(stderr, "kernel_launch: memset failed\n"); return; }
#if MK_MULTI
    for (int p = 0; p < NPHASE; ++p) { a.ph_lo = p; a.ph_hi = p + 1; const int reps = ((MK_REPMASK >> p) & 1) ? 2 : 1;
        for (int r = 0; r < reps; ++r) hipLaunchKernelGGL(fwd_megakernel, dim3(grid), dim3(NTHREADS), LDS_BYTES, stream, a); }
#else
    a.ph_lo = 0; a.ph_hi = NPHASE;
    void* kargs[] = {&a};
    hipError_t e = hipLaunchCooperativeKernel((const void*)fwd_megakernel, dim3(grid), dim3(NTHREADS), kargs, LDS_BYTES, stream);
    if (e != hipSuccess) fprintf(stderr, "cooperative launch failed: %s (grid %d)\n", hipGetErrorString(e), grid);
#endif
}
```
